# Optimizing an MI355X kernel written in HIP

```python
import math
import jax
import jax.numpy as jnp
from jax import lax
import numpy as np


D_MODEL = 1024
BATCH = 4
SEQ = 4096
DEPTH = 4

A_HEADS = 8
A_HEAD_DIM = 128
IDX_HEADS = 8
IDX_DIM = 64
TOPK_MAX = 256
Q_BLOCK = 128
REL_BUCKETS = 32
REL_MAX_DIST = 128
B_HEADS = 8
B_HEAD_DIM = D_MODEL // B_HEADS
B_CHUNK = 64
C_HEADS = 4
C_QK_DIM = 256
C_V_DIM = 512
C_CHUNK = 128
N_GROUPS = 4
EXPERTS_PER_GROUP = 8
N_EXPERTS = N_GROUPS * EXPERTS_PER_GROUP
EXPERT_TOPK = 2
D_EXPERT = 512
EPS = 1e-6

A_WIDTH = A_HEADS * A_HEAD_DIM
B_WIDTH = B_HEADS * B_HEAD_DIM
C_QK_WIDTH = C_HEADS * C_QK_DIM
C_V_WIDTH = C_HEADS * C_V_DIM
IN_SPLITS = (A_WIDTH, A_WIDTH, A_WIDTH, IDX_HEADS * IDX_DIM, IDX_DIM, IDX_HEADS,
             B_WIDTH, B_WIDTH, B_WIDTH, B_WIDTH,
             C_QK_WIDTH, C_QK_WIDTH, C_V_WIDTH, C_V_WIDTH,
             D_MODEL, D_MODEL, D_MODEL)
N_IN = sum(IN_SPLITS)

kernel_name = 'hybrid_dsa_hgrn2_retnet_hmoe'


def rmsnorm(x, g=None):
    xf = x.astype(jnp.float32)
    y = xf * lax.rsqrt(jnp.mean(xf * xf, axis=-1, keepdims=True) + EPS)
    if g is not None:
        y = y * g.astype(jnp.float32)
    return y.astype(x.dtype)


def t5_bucket(rel):
    max_exact = REL_BUCKETS // 2
    relf = jnp.maximum(rel, 1).astype(jnp.float32)
    large = max_exact + (jnp.log(relf / max_exact) / math.log(REL_MAX_DIST / max_exact)
                         * (REL_BUCKETS - max_exact)).astype(jnp.int32)
    large = jnp.minimum(large, REL_BUCKETS - 1)
    return jnp.where(rel < max_exact, rel, large)


def split_cols(proj):
    offs = np.cumsum(np.array(IN_SPLITS))[:-1].tolist()
    return jnp.split(proj, offs, axis=-1)


def dsa_attention(q, k, v, q_idx, k_idx, w_idx, rel_bias):
    bsz, seq = q.shape[0], q.shape[1]
    top_k = min(TOPK_MAX, seq // 4)
    n_blk = seq // Q_BLOCK
    s_pos = jnp.arange(seq, dtype=jnp.int32)
    k_idx32 = k_idx.astype(jnp.float32)
    idx_scale = (IDX_HEADS * IDX_DIM) ** -0.5

    def to_blocks(a):
        return jnp.moveaxis(a.reshape((bsz, n_blk, Q_BLOCK) + a.shape[2:]), 1, 0)

    def one_block(args):
        qb, qib, wb, t0 = args
        t_pos = t0 + jnp.arange(Q_BLOCK, dtype=jnp.int32)
        rel = jax.nn.relu(jnp.einsum('bqhd,bsd->bqhs', qib.astype(jnp.float32), k_idx32))
        score = jnp.einsum('bqhs,bqh->bqs', rel, wb.astype(jnp.float32) * idx_scale)
        causal = s_pos[None, :] <= t_pos[:, None]
        score = jnp.where(causal[None], score, -jnp.inf)
        _, sel = lax.top_k(score, top_k)
        valid = sel <= t_pos[None, :, None]
        k_sel = jax.vmap(lambda kb, ib: kb[ib])(k, sel)
        v_sel = jax.vmap(lambda vb, ib: vb[ib])(v, sel)
        logits = jnp.einsum('bqhd,bqkhd->bqhk', qb, k_sel).astype(jnp.float32) * (A_HEAD_DIM ** -0.5)
        bucket = t5_bucket(jnp.maximum(t_pos[None, :, None] - sel, 0))
        logits = logits + jnp.transpose(rel_bias[bucket], (0, 1, 3, 2)).astype(jnp.float32)
        logits = jnp.where(valid[:, :, None, :], logits, -jnp.inf)
        p = jax.nn.softmax(logits, axis=-1).astype(v.dtype)
        return jnp.einsum('bqhk,bqkhd->bqhd', p, v_sel)

    t0s = jnp.arange(n_blk, dtype=jnp.int32) * Q_BLOCK
    out = lax.map(one_block, (to_blocks(q), to_blocks(q_idx), to_blocks(w_idx), t0s))
    return jnp.moveaxis(out, 0, 1).reshape(bsz, seq, A_WIDTH)


def hgrn2(q, f_pre, i, g_out, lb, norm_g):
    bsz, seq = q.shape[0], q.shape[1]
    nc = seq // B_CHUNK
    lb = lb.reshape(B_HEADS, B_HEAD_DIM).astype(jnp.float32)
    f = lb + (1.0 - lb) * jax.nn.sigmoid(f_pre.astype(jnp.float32))
    log_f = jnp.log(f)
    kk = 1.0 - f

    def chunks(a):
        return jnp.transpose(a.reshape(bsz, nc, B_CHUNK, B_HEADS, -1), (1, 0, 3, 2, 4))

    causal = jnp.tril(jnp.ones((B_CHUNK, B_CHUNK), dtype=bool))

    def step(state, inp):
        qt, kt, vt, gt = inp
        b = jnp.cumsum(gt, axis=2)
        diff = b[:, :, :, None, :] - b[:, :, None, :, :]
        decay = jnp.exp(jnp.where(causal[None, None, :, :, None], diff, -jnp.inf))
        attn = jnp.einsum('bhtd,bhsd,bhtsd->bhts', qt, kt, decay)
        o = (jnp.einsum('bhts,bhsv->bhtv', attn, vt)
             + jnp.einsum('bhtd,bhdv->bhtv', qt * jnp.exp(b), state))
        b_last = b[:, :, -1:, :]
        state = (jnp.exp(b_last[:, :, 0, :, None]) * state
                 + jnp.einsum('bhsd,bhsv->bhdv', kt * jnp.exp(b_last - b), vt))
        return state, o

    s0 = jnp.zeros((bsz, B_HEADS, B_HEAD_DIM, B_HEAD_DIM), jnp.float32)
    _, o = lax.scan(step, s0, (chunks(q.astype(jnp.float32)), chunks(kk),
                               chunks(i.astype(jnp.float32)), chunks(log_f)))
    o = jnp.transpose(o, (1, 0, 3, 2, 4)).reshape(bsz, seq, B_HEADS, B_HEAD_DIM)
    o = rmsnorm(o, norm_g) * jax.nn.silu(g_out.astype(jnp.float32))
    return o.reshape(bsz, seq, B_WIDTH).astype(q.dtype)


def retention(q, k, v, g):
    bsz, seq = q.shape[0], q.shape[1]
    nc = seq // C_CHUNK
    pos = jnp.arange(seq, dtype=jnp.float32)
    theta = jnp.repeat(1.0 / (10000.0 ** jnp.linspace(0.0, 1.0, C_QK_DIM // 2)), 2)
    ang = pos[:, None] * theta[None, :]
    sin = jnp.sin(ang)[None, :, None, :]
    cos = jnp.cos(ang)[None, :, None, :]

    def rot(a):
        a2 = jnp.stack([-a[..., 1::2], a[..., 0::2]], axis=-1).reshape(a.shape)
        return a * cos + a2 * sin

    qr = rot(q.astype(jnp.float32))
    kr = rot(k.astype(jnp.float32)) * (C_QK_DIM ** -0.5)
    log_gamma = jnp.log(1.0 - 2.0 ** (-5.0 - jnp.arange(C_HEADS, dtype=jnp.float32)))
    idx = jnp.arange(C_CHUNK, dtype=jnp.float32)
    causal = idx[:, None] >= idx[None, :]
    intra_decay = jnp.exp(jnp.where(causal[None], (idx[:, None] - idx[None, :])[None] * log_gamma[:, None, None], -jnp.inf))
    q_decay = jnp.exp((idx + 1.0)[None, :] * log_gamma[:, None])[..., None]
    k_decay = jnp.exp((C_CHUNK - 1.0 - idx)[None, :] * log_gamma[:, None])[..., None]
    chunk_decay = jnp.exp(C_CHUNK * log_gamma)[:, None, None]

    def chunks(a):
        return jnp.transpose(a.reshape(bsz, nc, C_CHUNK, C_HEADS, -1), (1, 0, 3, 2, 4))

    def step(state, inp):
        qt, kt, vt = inp
        attn = jnp.einsum('bhtd,bhsd->bhts', qt, kt) * intra_decay
        o = (jnp.einsum('bhts,bhsv->bhtv', attn, vt)
             + jnp.einsum('bhtd,bhdv->bhtv', qt * q_decay, state))
        state = chunk_decay * state + jnp.einsum('bhsd,bhsv->bhdv', kt * k_decay, vt)
        return state, o

    s0 = jnp.zeros((bsz, C_HEADS, C_QK_DIM, C_V_DIM), jnp.float32)
    _, o = lax.scan(step, s0, (chunks(qr), chunks(kr), chunks(v.astype(jnp.float32))))
    o = jnp.transpose(o, (1, 0, 3, 2, 4)).reshape(bsz, seq, C_HEADS, C_V_DIM)
    o = rmsnorm(o).reshape(bsz, seq, C_V_WIDTH)
    return (jax.nn.silu(g.astype(jnp.float32)) * o).astype(q.dtype)


def hier_moe(h, rg_w, rg_b, re_w, re_b, w_gate, w_up, w_down):
    bsz, seq, dm = h.shape
    x = h.reshape(-1, dm)
    group_logits = (x @ rg_w + rg_b).astype(jnp.float32)
    group_p = jax.nn.softmax(group_logits, axis=-1)
    g_sel = jnp.argmax(group_logits, axis=-1)
    g_prob = jnp.take_along_axis(group_p, g_sel[:, None], axis=-1)
    exp_logits = (x @ re_w + re_b).astype(jnp.float32).reshape(-1, N_GROUPS, EXPERTS_PER_GROUP)
    in_group = jnp.take_along_axis(exp_logits, g_sel[:, None, None], axis=1)[:, 0]
    top_v, top_i = lax.top_k(in_group, EXPERT_TOPK)
    top_w = jax.nn.softmax(top_v, axis=-1) * g_prob
    w_group = jnp.sum(jax.nn.one_hot(top_i, EXPERTS_PER_GROUP, dtype=jnp.float32) * top_w[..., None], axis=1)
    gates = (jax.nn.one_hot(g_sel, N_GROUPS, dtype=jnp.float32)[:, :, None] * w_group[:, None, :]).astype(x.dtype)
    wg = w_gate.reshape(N_GROUPS, EXPERTS_PER_GROUP, dm, D_EXPERT)
    wu = w_up.reshape(N_GROUPS, EXPERTS_PER_GROUP, dm, D_EXPERT)
    wd = w_down.reshape(N_GROUPS, EXPERTS_PER_GROUP, D_EXPERT, dm)
    y = jnp.zeros_like(x)
    for gi in range(N_GROUPS):
        hg = jax.nn.silu(jnp.einsum('nd,edf->nef', x, wg[gi])) * jnp.einsum('nd,edf->nef', x, wu[gi])
        y = y + jnp.einsum('nef,efd->nd', hg * gates[:, gi, :, None], wd[gi])
    return y.reshape(bsz, seq, dm)


def hybrid_layer(x, c, lb, rel_bias, norm1_g, norm2_g, ada_w, ada_b, w_in, hgrn_norm_g,
                 w_branch_a, w_branch_b, w_branch_c, w_out, rg_w, rg_b, re_w, re_b,
                 e_gate, e_up, e_down):
    bsz, seq, _ = x.shape
    mod = (jax.nn.silu(c) @ ada_w + ada_b)[:, None, :]
    sh1, sc1, gt1, sh2, sc2, gt2 = jnp.split(mod, 6, axis=-1)
    h = rmsnorm(x, norm1_g) * (1.0 + sc1) + sh1
    (aq, ak, av, iq, ik, iw, bq, bf, bi, bg, cq, ck, cv, cg, ga, gb, gc) = split_cols(h @ w_in)
    o_a = dsa_attention(aq.reshape(bsz, seq, A_HEADS, A_HEAD_DIM),
                        ak.reshape(bsz, seq, A_HEADS, A_HEAD_DIM),
                        av.reshape(bsz, seq, A_HEADS, A_HEAD_DIM),
                        iq.reshape(bsz, seq, IDX_HEADS, IDX_DIM), ik, iw, rel_bias)
    hs = (bsz, seq, B_HEADS, B_HEAD_DIM)
    o_b = hgrn2(bq.reshape(hs), bf.reshape(hs), bi.reshape(hs), bg.reshape(hs), lb, hgrn_norm_g)
    o_c = retention(cq.reshape(bsz, seq, C_HEADS, C_QK_DIM), ck.reshape(bsz, seq, C_HEADS, C_QK_DIM),
                    cv.reshape(bsz, seq, C_HEADS, C_V_DIM), cg)
    merged = (jax.nn.sigmoid(ga) * (o_a @ w_branch_a)
              + jax.nn.sigmoid(gb) * (o_b @ w_branch_b)
              + jax.nn.sigmoid(gc) * (o_c @ w_branch_c))
    x = x + gt1 * (merged @ w_out)
    h2 = rmsnorm(x, norm2_g) * (1.0 + sc2) + sh2
    x = x + gt2 * hier_moe(h2, rg_w, rg_b, re_w, re_b, e_gate, e_up, e_down)
    return x


def setup_inputs(seed: int = 0) -> dict:
    key = jax.random.key(seed)
    ks = jax.random.split(key, 22)
    D = D_MODEL

    def nrm(k, shape, scale):
        return jax.random.normal(k, shape, jnp.float32) * scale

    return {
        'x': nrm(ks[0], (BATCH, SEQ, D), 1.0),
        'c': nrm(ks[1], (BATCH, D), 1.0),
        'rel_bias': nrm(ks[2], (REL_BUCKETS, A_HEADS), 0.5),
        'hgrn_lb_raw': nrm(ks[3], (DEPTH, B_WIDTH), 0.5),
        'norm1_g': 1.0 + nrm(ks[4], (DEPTH, D), 0.05),
        'norm2_g': 1.0 + nrm(ks[5], (DEPTH, D), 0.05),
        'ada_w': nrm(ks[6], (DEPTH, D, 6 * D), 0.5 * D ** -0.5),
        'ada_b': nrm(ks[7], (DEPTH, 6 * D), 0.02),
        'w_in': nrm(ks[8], (DEPTH, D, N_IN), D ** -0.5),
        'hgrn_norm_g': 1.0 + nrm(ks[9], (DEPTH, B_HEAD_DIM), 0.05),
        'w_branch_a': nrm(ks[10], (DEPTH, A_WIDTH, D), A_WIDTH ** -0.5),
        'w_branch_b': nrm(ks[11], (DEPTH, B_WIDTH, D), B_WIDTH ** -0.5),
        'w_branch_c': nrm(ks[12], (DEPTH, C_V_WIDTH, D), C_V_WIDTH ** -0.5),
        'w_out': nrm(ks[13], (DEPTH, D, D), D ** -0.5),
        'router_group_w': nrm(ks[14], (DEPTH, D, N_GROUPS), D ** -0.5),
        'router_group_b': nrm(ks[15], (DEPTH, N_GROUPS), 0.01),
        'router_expert_w': nrm(ks[16], (DEPTH, D, N_EXPERTS), D ** -0.5),
        'router_expert_b': nrm(ks[17], (DEPTH, N_EXPERTS), 0.01),
        'expert_w_gate': nrm(ks[18], (DEPTH, N_EXPERTS, D, D_EXPERT), D ** -0.5),
        'expert_w_up': nrm(ks[19], (DEPTH, N_EXPERTS, D, D_EXPERT), D ** -0.5),
        'expert_w_down': nrm(ks[20], (DEPTH, N_EXPERTS, D_EXPERT, D), D_EXPERT ** -0.5),
        'final_norm_g': 1.0 + nrm(ks[21], (D,), 0.05),
    }


def reference(x, c, rel_bias, hgrn_lb_raw, norm1_g, norm2_g, ada_w, ada_b, w_in, hgrn_norm_g,
              w_branch_a, w_branch_b, w_branch_c, w_out, router_group_w, router_group_b,
              router_expert_w, router_expert_b, expert_w_gate, expert_w_up, expert_w_down,
              final_norm_g):
    lb_soft = jax.nn.softmax(hgrn_lb_raw.astype(jnp.float32), axis=0)
    lb_all = jnp.cumsum(lb_soft, axis=0) - lb_soft[0:1]
    for l in range(DEPTH):
        x = hybrid_layer(x, c, lb_all[l], rel_bias, norm1_g[l], norm2_g[l], ada_w[l], ada_b[l],
                         w_in[l], hgrn_norm_g[l], w_branch_a[l], w_branch_b[l], w_branch_c[l],
                         w_out[l], router_group_w[l], router_group_b[l], router_expert_w[l],
                         router_expert_b[l], expert_w_gate[l], expert_w_up[l], expert_w_down[l])
    return rmsnorm(x, final_norm_g)
```

```cpp
#include <hip/hip_runtime.h>
#include <cstdio>
#include <cstdint>

constexpr int D = 1024, BATCH = 4, SEQ = 4096, DEPTH = 4, M = BATCH * SEQ;
constexpr int A_HEADS = 8, A_HD = 128, IDX_HEADS = 8, IDX_DIM = 64, TOPK = 256;
constexpr int B_HEADS = 8, B_HD = 128;
constexpr int C_HEADS = 4, C_QK = 256, C_V = 512;
constexpr int NG = 4, EPG = 8, NE = 32, DEXP = 512;
constexpr int N_IN = 16968;
constexpr float EPS = 1e-6f;
constexpr int O_AQ = 0, O_AK = 1024, O_AV = 2048, O_IQ = 3072, O_IK = 3584, O_IW = 3648, O_BQ = 3656, O_BF = 4680, O_BI = 5704, O_BG = 6728,
              O_CQ = 7752, O_CK = 8776, O_CV = 9800, O_CG = 11848, O_GA = 13896, O_GB = 14920, O_GC = 15944;
static_assert(O_GC + 1024 == N_IN, "splits");

namespace naive {
__device__ __forceinline__ float sigmoidf_(float x) { return 1.f / (1.f + expf(-x)); }
__device__ __forceinline__ float siluf_(float x) { return x / (1.f + expf(-x)); }

__global__ void k_mod(const float* c, const float* ada_w, const float* ada_b, float* mod) {
    const int j = blockIdx.x * 256 + threadIdx.x, b = blockIdx.y, l = blockIdx.z;
    __shared__ float sc[D];
    for (int k = threadIdx.x; k < D; k += 256) sc[k] = siluf_(c[b * D + k]);
    __syncthreads();
    const float* w = ada_w + (size_t)l * D * 6 * D;
    float acc = 0.f;
    for (int k = 0; k < D; ++k) acc += sc[k] * w[(size_t)k * 6 * D + j];
    mod[((size_t)l * BATCH + b) * 6 * D + j] = acc + ada_b[l * 6 * D + j];
}
__global__ void k_lb(const float* raw, float* lb) {
    const int d = blockIdx.x * 256 + threadIdx.x;
    float v[DEPTH], mx = -1e30f;
#pragma unroll
    for (int l = 0; l < DEPTH; ++l) { v[l] = raw[l * D + d]; mx = fmaxf(mx, v[l]); }
    float s = 0.f;
#pragma unroll
    for (int l = 0; l < DEPTH; ++l) { v[l] = expf(v[l] - mx); s += v[l]; }
    float cum = 0.f; const float s0 = v[0] / s;
#pragma unroll
    for (int l = 0; l < DEPTH; ++l) { cum += v[l] / s; lb[l * D + d] = cum - s0; }
}
__global__ void k_rot(float2* tab) {
    const int idx = blockIdx.x * 256 + threadIdx.x; const int t = idx >> 7, i = idx & 127;
    const double th = pow(10000.0, -(double)i / 127.0), a = (double)t * th;
    tab[idx] = make_float2((float)cos(a), (float)sin(a));
}
__global__ void k_norm(const float* x, const float* add, const float* gt, float* xout, const float* g, const float* sc, const float* sh, float* y, int rows_per_batch) {
    const int row = blockIdx.x, b = row / rows_per_batch, t = threadIdx.x;
    float v[4]; float ss = 0.f;
    for (int j = 0; j < 4; ++j) { const int c = t + 256 * j; float a = x[(size_t)row * D + c]; if (add) a += gt[b * 6 * D + c] * add[(size_t)row * D + c]; v[j] = a; ss += a * a; }
    __shared__ float red[256]; red[t] = ss; __syncthreads();
    for (int o = 128; o > 0; o >>= 1) { if (t < o) red[t] += red[t + o]; __syncthreads(); }
    const float r = rsqrtf(red[0] / D + EPS);
    for (int j = 0; j < 4; ++j) { const int c = t + 256 * j; if (xout) xout[(size_t)row * D + c] = v[j];
        float o = v[j] * r * g[c]; if (sc) o = o * (1.f + sc[b * 6 * D + c]) + sh[b * 6 * D + c]; y[(size_t)row * D + c] = o; }
}
__global__ void __launch_bounds__(256) k_gemm(const float* A, int lda, const float* B, int ldb, float* C, int ldc, int N, int K, int accum) {
    __shared__ float As[16][65], Bs[16][65];
    const int tx = threadIdx.x & 15, ty = threadIdx.x >> 4, m0 = blockIdx.y * 64, n0 = blockIdx.x * 64;
    float acc[4][4] = {};
    for (int k0 = 0; k0 < K; k0 += 16) {
        for (int i = threadIdx.x; i < 1024; i += 256) { const int r = i >> 4, c = i & 15; As[c][r] = A[(size_t)(m0 + r) * lda + k0 + c]; }
        for (int i = threadIdx.x; i < 1024; i += 256) { const int r = i >> 6, c = i & 63; Bs[r][c] = (n0 + c < N) ? B[(size_t)(k0 + r) * ldb + n0 + c] : 0.f; }
        __syncthreads();
#pragma unroll
        for (int k = 0; k < 16; ++k) { float a[4], b[4];
#pragma unroll
            for (int i = 0; i < 4; ++i) { a[i] = As[k][ty * 4 + i]; b[i] = Bs[k][tx * 4 + i]; }
#pragma unroll
            for (int i = 0; i < 4; ++i)
#pragma unroll
                for (int j = 0; j < 4; ++j) acc[i][j] += a[i] * b[j]; }
        __syncthreads();
    }
    for (int i = 0; i < 4; ++i) for (int j = 0; j < 4; ++j) { const int n = n0 + tx * 4 + j; if (n < N) { float* p = C + (size_t)(m0 + ty * 4 + i) * ldc + n; *p = accum ? *p + acc[i][j] : acc[i][j]; } }
}
__device__ __forceinline__ unsigned fkey(float f) { const unsigned u = __float_as_uint(f); return (u & 0x80000000u) ? ~u : (u | 0x80000000u); }
__device__ __forceinline__ int t5_bucket(int rel) {
    if (rel < 16) return rel;
    int large = 16 + (int)(logf((float)rel / 16.f) / logf(8.f) * 16.f);
    return large < 31 ? large : 31;
}
__global__ void __launch_bounds__(256) k_dsa(const float* proj, const float* rel_bias, float* oa) {
    const int t = blockIdx.x, tid = threadIdx.x;
    __shared__ float qi[512], wv[8], sc[SEQ], qh[128], red[256], pk[256];
    __shared__ unsigned cnt_s; __shared__ int sel[256]; __shared__ int nsel_s; __shared__ int pre[257];
    const float* row = proj + (size_t)t * N_IN;
    for (int i = tid; i < 512; i += 256) qi[i] = row[O_IQ + i];
    if (tid < 8) wv[tid] = row[O_IW + tid] * 0.04419417382415922f;
    __syncthreads();
    const int n = t + 1;
    for (int s = tid; s < SEQ; s += 256) {
        float v = -__builtin_inff();
        if (s <= t) { const float* kr = proj + (size_t)s * N_IN + O_IK; float kk[64];
#pragma unroll
            for (int d = 0; d < 64; ++d) kk[d] = kr[d];
            float acc = 0.f;
#pragma unroll
            for (int h = 0; h < 8; ++h) { float dp = 0.f;
#pragma unroll
                for (int d = 0; d < 64; ++d) dp += qi[h * 64 + d] * kk[d];
                acc += wv[h] * fmaxf(dp, 0.f); }
            v = acc; }
        sc[s] = v;
    }
    __syncthreads();
    int my_cnt = 0;
    unsigned T = 0; int need_eq = 0;
    if (n > TOPK) {
        unsigned prefix = 0;
        for (int bit = 31; bit >= 0; --bit) {
            const unsigned cand = prefix | (1u << bit);
            if (tid == 0) cnt_s = 0; __syncthreads();
            unsigned c = 0; for (int s = tid; s < n; s += 256) c += (fkey(sc[s]) >= cand) ? 1u : 0u;
            atomicAdd(&cnt_s, c); __syncthreads();
            if (cnt_s >= (unsigned)TOPK) prefix = cand;
            __syncthreads();
        }
        T = prefix;
        if (tid == 0) cnt_s = 0; __syncthreads();
        unsigned c = 0; for (int s = tid; s < n; s += 256) c += (fkey(sc[s]) > T) ? 1u : 0u;
        atomicAdd(&cnt_s, c); __syncthreads();
        need_eq = TOPK - (int)cnt_s;
    }
    int eqc = 0;
    for (int j = 0; j < 16; ++j) { const int s = tid * 16 + j; if (s < n && n > TOPK && fkey(sc[s]) == T) ++eqc; }
    pre[tid + 1] = eqc; if (tid == 0) pre[0] = 0; __syncthreads();
    if (tid == 0) { for (int i = 1; i <= 256; ++i) pre[i] += pre[i - 1]; } __syncthreads();
    int eq_rank = pre[tid];
    int flags = 0;
    for (int j = 0; j < 16; ++j) { const int s = tid * 16 + j; bool take = false;
        if (s < n) { if (n <= TOPK) take = true; else { const unsigned k = fkey(sc[s]); if (k > T) take = true; else if (k == T) { take = (eq_rank < need_eq); ++eq_rank; } } }
        if (take) { flags |= 1 << j; ++my_cnt; } }
    __syncthreads();
    pre[tid + 1] = my_cnt; if (tid == 0) pre[0] = 0; __syncthreads();
    if (tid == 0) { for (int i = 1; i <= 256; ++i) pre[i] += pre[i - 1]; nsel_s = pre[256]; } __syncthreads();
    { int p = pre[tid]; for (int j = 0; j < 16; ++j) if (flags & (1 << j)) sel[p++] = tid * 16 + j; }
    __syncthreads();
    const int nsel = nsel_s;
    for (int h = 0; h < A_HEADS; ++h) {
        if (tid < 128) qh[tid] = row[O_AQ + h * 128 + tid];
        __syncthreads();
        float lg = -__builtin_inff();
        if (tid < nsel) { const int s = sel[tid]; const float* kr = proj + (size_t)s * N_IN + O_AK + h * 128; float dp = 0.f;
            for (int d = 0; d < 128; ++d) dp += qh[d] * kr[d];
            lg = dp * 0.08838834764831845f + rel_bias[t5_bucket(t - s) * A_HEADS + h]; }
        red[tid] = lg; __syncthreads();
        for (int o = 128; o > 0; o >>= 1) { if (tid < o) red[tid] = fmaxf(red[tid], red[tid + o]); __syncthreads(); }
        const float mx = red[0]; __syncthreads();
        const float p = (tid < nsel) ? expf(lg - mx) : 0.f;
        red[tid] = p; pk[tid] = p; __syncthreads();
        for (int o = 128; o > 0; o >>= 1) { if (tid < o) red[tid] += red[tid + o]; __syncthreads(); }
        const float inv = 1.f / red[0];
        if (tid < 128) { float acc = 0.f; for (int k = 0; k < nsel; ++k) acc += pk[k] * proj[(size_t)sel[k] * N_IN + O_AV + h * 128 + tid];
            oa[(size_t)t * 1024 + h * 128 + tid] = acc * inv; }
        __syncthreads();
    }
}
__global__ void __launch_bounds__(128) k_hgrn(const float* proj, const float* lb, const float* norm_g, float* ob) {
    const int h = blockIdx.x, v = threadIdx.x;
    __shared__ float q[128], f[128], red[128];
    float S[128];
#pragma unroll
    for (int d = 0; d < 128; ++d) S[d] = 0.f;
    const float lbv = lb[h * 128 + v], ng = norm_g[v];
    for (int t = 0; t < SEQ; ++t) {
        const float* row = proj + (size_t)t * N_IN;
        q[v] = row[O_BQ + h * 128 + v];
        f[v] = lbv + (1.f - lbv) * sigmoidf_(row[O_BF + h * 128 + v]);
        const float iv = row[O_BI + h * 128 + v], go = row[O_BG + h * 128 + v];
        __syncthreads();
        float o = 0.f;
#pragma unroll
        for (int d = 0; d < 128; ++d) { const float fd = f[d]; S[d] = fd * S[d] + (1.f - fd) * iv; o += q[d] * S[d]; }
        red[v] = o * o; __syncthreads();
        for (int s = 64; s > 0; s >>= 1) { if (v < s) red[v] += red[v + s]; __syncthreads(); }
        const float r = rsqrtf(red[0] / 128.f + EPS);
        ob[(size_t)t * 1024 + h * 128 + v] = o * r * ng * siluf_(go);
        __syncthreads();
    }
}
__global__ void __launch_bounds__(256) k_ret(const float* proj, const float2* rot, float* oc) {
    const int h = blockIdx.x >> 3, vs = blockIdx.x & 7, tid = threadIdx.x, vc = tid & 63, dq = tid >> 6;
    __shared__ float q[256], k[256], part[256];
    float S[64];
#pragma unroll
    for (int d = 0; d < 64; ++d) S[d] = 0.f;
    const float gamma = 1.f - exp2f(-5.f - (float)h);
    for (int t = 0; t < SEQ; ++t) {
        const float* row = proj + (size_t)t * N_IN;
        { const int i = tid >> 1; const float2 cs = rot[t * 128 + i];
          const float q0 = row[O_CQ + h * 256 + 2 * i], q1 = row[O_CQ + h * 256 + 2 * i + 1], k0 = row[O_CK + h * 256 + 2 * i], k1 = row[O_CK + h * 256 + 2 * i + 1];
          if ((tid & 1) == 0) { q[tid] = q0 * cs.x - q1 * cs.y; k[tid] = (k0 * cs.x - k1 * cs.y) * 0.0625f; }
          else { q[tid] = q1 * cs.x + q0 * cs.y; k[tid] = (k1 * cs.x + k0 * cs.y) * 0.0625f; } }
        const float v = row[O_CV + h * 512 + vs * 64 + vc];
        __syncthreads();
        float o = 0.f;
#pragma unroll
        for (int d = 0; d < 64; ++d) { S[d] = gamma * S[d] + k[dq * 64 + d] * v; o += q[dq * 64 + d] * S[d]; }
        part[tid] = o; __syncthreads();
        if (dq == 0) oc[(size_t)t * 2048 + h * 512 + vs * 64 + vc] = part[vc] + part[64 + vc] + part[128 + vc] + part[192 + vc];
        __syncthreads();
    }
}
__global__ void k_retnorm(const float* proj, float* oc) {
    const int t = blockIdx.x, tid = threadIdx.x;
    __shared__ float red[256];
    for (int h = 0; h < 4; ++h) {
        const float a = oc[(size_t)t * 2048 + h * 512 + tid], b = oc[(size_t)t * 2048 + h * 512 + 256 + tid];
        red[tid] = a * a + b * b; __syncthreads();
        for (int o = 128; o > 0; o >>= 1) { if (tid < o) red[tid] += red[tid + o]; __syncthreads(); }
        const float r = rsqrtf(red[0] / 512.f + EPS); __syncthreads();
        const float* row = proj + (size_t)t * N_IN + O_CG + h * 512;
        oc[(size_t)t * 2048 + h * 512 + tid] = a * r * siluf_(row[tid]);
        oc[(size_t)t * 2048 + h * 512 + 256 + tid] = b * r * siluf_(row[256 + tid]);
    }
}
__global__ void k_merge(const float* proj, const float* ya, const float* yb, const float* yc, float* mg) {
    const size_t i = (size_t)blockIdx.x * 256 + threadIdx.x; const size_t t = i >> 10; const int c = (int)(i & 1023);
    const float* row = proj + t * N_IN;
    mg[i] = sigmoidf_(row[O_GA + c]) * ya[i] + sigmoidf_(row[O_GB + c]) * yb[i] + sigmoidf_(row[O_GC + c]) * yc[i];
}
__global__ void k_resadd(float* x, const float* y, const float* gt, int rows_per_batch, int row0) {
    const size_t i = (size_t)blockIdx.x * 256 + threadIdx.x; const int r = (int)(i >> 10), c = (int)(i & 1023); const int b = (row0 + r) / rows_per_batch;
    x[(size_t)(row0 + r) * D + c] += gt[b * 6 * D + c] * y[i];
}
__global__ void k_route(const float* gl, const float* gb, const float* el, const float* eb, float* gates) {
    const int n = blockIdx.x * 256 + threadIdx.x;
    float mx = -1e30f; int gs = 0; float s = 0.f;
#pragma unroll
    for (int i = 0; i < 4; ++i) { const float g = gl[n * 4 + i] + gb[i]; if (g > mx) { mx = g; gs = i; } }
#pragma unroll
    for (int i = 0; i < 4; ++i) { const float g = gl[n * 4 + i] + gb[i]; s += expf(g - mx); }
    const float gp = 1.f / s;
    float v0 = -1e30f, v1 = -1e30f; int i0 = 0, i1 = 0;
#pragma unroll
    for (int i = 0; i < 8; ++i) { const float e = el[n * 32 + gs * 8 + i] + eb[gs * 8 + i];
        if (e > v0) { v1 = v0; i1 = i0; v0 = e; i0 = i; } else if (e > v1) { v1 = e; i1 = i; } }
    const float w1 = expf(v1 - v0), den = 1.f + w1;
#pragma unroll
    for (int i = 0; i < 32; ++i) gates[n * 32 + i] = 0.f;
    gates[n * 32 + gs * 8 + i0] = gp / den; gates[n * 32 + gs * 8 + i1] = gp * w1 / den;
}
__global__ void k_act(const float* G, const float* U, const float* gates, int e, float* H) {
    const size_t i = (size_t)blockIdx.x * 256 + threadIdx.x; const size_t n = i >> 9;
    H[i] = siluf_(G[i]) * U[i] * gates[n * 32 + e];
}
__global__ void k_zero(float* p, size_t n) { const size_t i = (size_t)blockIdx.x * 256 + threadIdx.x; if (i < n) p[i] = 0.f; }
}

static void gemm(hipStream_t st, const float* A, int lda, const float* B, int ldb, float* C, int ldc, int Mr, int N, int K, int accum) {
    hipLaunchKernelGGL(naive::k_gemm, dim3((N + 63) / 64, Mr / 64), dim3(256), 0, st, A, lda, B, ldb, C, ldc, N, K, accum);
}

extern "C" void kernel_launch(void* const* d_in, const int* in_sizes, int n_in, void* d_out, int out_size, void* d_ws, size_t ws_size, hipStream_t st) {
    const float* x_in = (const float*)d_in[0]; const float* c = (const float*)d_in[1]; const float* rel_bias = (const float*)d_in[2]; const float* lb_raw = (const float*)d_in[3];
    const float* norm1_g = (const float*)d_in[4]; const float* norm2_g = (const float*)d_in[5]; const float* ada_w = (const float*)d_in[6]; const float* ada_b = (const float*)d_in[7];
    const float* w_in = (const float*)d_in[8]; const float* hgrn_ng = (const float*)d_in[9]; const float* w_ba = (const float*)d_in[10]; const float* w_bb = (const float*)d_in[11];
    const float* w_bc = (const float*)d_in[12]; const float* w_out = (const float*)d_in[13]; const float* rg_w = (const float*)d_in[14]; const float* rg_b = (const float*)d_in[15];
    const float* re_w = (const float*)d_in[16]; const float* re_b = (const float*)d_in[17]; const float* e_gate = (const float*)d_in[18]; const float* e_up = (const float*)d_in[19];
    const float* e_down = (const float*)d_in[20]; const float* fin_g = (const float*)d_in[21];
    float* out = (float*)d_out;
    float* w = (float*)d_ws; size_t o = 0;
    auto take = [&](size_t n) { float* p = w + o; o += (n + 63) & ~(size_t)63; return p; };
    float* mod = take((size_t)DEPTH * BATCH * 6 * D); float* lb = take(DEPTH * D); float2* rot = (float2*)take((size_t)SEQ * 128 * 2);
    float* x = take((size_t)M * D); float* h = take((size_t)M * D); float* proj = take((size_t)SEQ * N_IN);
    float* oa = take((size_t)SEQ * 1024); float* ob = take((size_t)SEQ * 1024); float* oc = take((size_t)SEQ * 2048);
    float* ya = take((size_t)SEQ * 1024); float* yb = take((size_t)SEQ * 1024); float* yc = take((size_t)SEQ * 1024); float* mg = take((size_t)SEQ * 1024); float* tmp = take((size_t)SEQ * 1024);
    float* gl = take((size_t)M * 4); float* el = take((size_t)M * 32); float* gates = take((size_t)M * 32);
    float* G = take((size_t)M * DEXP); float* U = take((size_t)M * DEXP); float* Y = take((size_t)M * D);
    if (o * 4 > ws_size) { fprintf(stderr, "ws too small: need %zu have %zu\n", o * 4, ws_size); return; }

    hipLaunchKernelGGL(naive::k_mod, dim3(6 * D / 256, BATCH, DEPTH), dim3(256), 0, st, c, ada_w, ada_b, mod);
    hipLaunchKernelGGL(naive::k_lb, dim3(D / 256), dim3(256), 0, st, lb_raw, lb);
    hipLaunchKernelGGL(naive::k_rot, dim3(SEQ * 128 / 256), dim3(256), 0, st, rot);
    hipMemcpyAsync(x, x_in, (size_t)M * D * 4, hipMemcpyDeviceToDevice, st);
    for (int l = 0; l < DEPTH; ++l) {
        const float* md = mod + (size_t)l * BATCH * 6 * D;
        hipLaunchKernelGGL(naive::k_norm, dim3(M), dim3(256), 0, st, x, (const float*)nullptr, (const float*)nullptr, (float*)nullptr, norm1_g + l * D, md + 1 * D, md + 0 * D, h, SEQ);
        for (int b = 0; b < BATCH; ++b) {
            gemm(st, h + (size_t)b * SEQ * D, D, w_in + (size_t)l * D * N_IN, N_IN, proj, N_IN, SEQ, N_IN, D, 0);
            hipLaunchKernelGGL(naive::k_dsa, dim3(SEQ), dim3(256), 0, st, proj, rel_bias, oa);
            hipLaunchKernelGGL(naive::k_hgrn, dim3(B_HEADS), dim3(128), 0, st, proj, lb + l * D, hgrn_ng + l * B_HD, ob);
            hipLaunchKernelGGL(naive::k_ret, dim3(C_HEADS * 8), dim3(256), 0, st, proj, rot, oc);
            hipLaunchKernelGGL(naive::k_retnorm, dim3(SEQ), dim3(256), 0, st, proj, oc);
            gemm(st, oa, 1024, w_ba + (size_t)l * 1024 * D, D, ya, D, SEQ, D, 1024, 0);
            gemm(st, ob, 1024, w_bb + (size_t)l * 1024 * D, D, yb, D, SEQ, D, 1024, 0);
            gemm(st, oc, 2048, w_bc + (size_t)l * 2048 * D, D, yc, D, SEQ, D, 2048, 0);
            hipLaunchKernelGGL(naive::k_merge, dim3(SEQ * 1024 / 256), dim3(256), 0, st, proj, ya, yb, yc, mg);
            gemm(st, mg, D, w_out + (size_t)l * D * D, D, tmp, D, SEQ, D, D, 0);
            hipLaunchKernelGGL(naive::k_resadd, dim3(SEQ * 1024 / 256), dim3(256), 0, st, x, tmp, md + 2 * D, SEQ, b * SEQ);
        }
        hipLaunchKernelGGL(naive::k_norm, dim3(M), dim3(256), 0, st, x, (const float*)nullptr, (const float*)nullptr, (float*)nullptr, norm2_g + l * D, md + 4 * D, md + 3 * D, h, SEQ);
        gemm(st, h, D, rg_w + (size_t)l * D * NG, NG, gl, NG, M, NG, D, 0);
        gemm(st, h, D, re_w + (size_t)l * D * NE, NE, el, NE, M, NE, D, 0);
        hipLaunchKernelGGL(naive::k_route, dim3(M / 256), dim3(256), 0, st, gl, rg_b + l * NG, el, re_b + l * NE, gates);
        hipLaunchKernelGGL(naive::k_zero, dim3((unsigned)(((size_t)M * D + 255) / 256)), dim3(256), 0, st, Y, (size_t)M * D);
        for (int e = 0; e < NE; ++e) {
            gemm(st, h, D, e_gate + ((size_t)l * NE + e) * D * DEXP, DEXP, G, DEXP, M, DEXP, D, 0);
            gemm(st, h, D, e_up + ((size_t)l * NE + e) * D * DEXP, DEXP, U, DEXP, M, DEXP, D, 0);
            hipLaunchKernelGGL(naive::k_act, dim3((unsigned)((size_t)M * DEXP / 256)), dim3(256), 0, st, G, U, gates, e, G);
            gemm(st, G, DEXP, e_down + ((size_t)l * NE + e) * DEXP * D, D, Y, D, M, D, DEXP, 1);
        }
        hipLaunchKernelGGL(naive::k_resadd, dim3((unsigned)((size_t)M * 1024 / 256)), dim3(256), 0, st, x, Y, md + 5 * D, SEQ, 0);
    }
    hipLaunchKernelGGL(naive::k_norm, dim3(M), dim3(256), 0, st, x, (const float*)nullptr, (const float*)nullptr, (float*)nullptr, fin_g, (const float*)nullptr, (const float*)nullptr, out, SEQ);
}
```

```cpp
#include <hip/hip_runtime.h>
#include <cstdio>
#include <cstdint>

constexpr int D = 1024, BATCH = 4, SEQ = 4096, DEPTH = 4, M = BATCH * SEQ;
constexpr int A_HEADS = 8, TOPK = 256;
constexpr int NE = 32, DEXP = 512;
constexpr int N_IN = 16968, NP = 17152;
constexpr float EPS = 1e-6f;
constexpr int O_AQ = 0, O_AK = 1024, O_AV = 2048, O_IQ = 3072, O_IK = 3584, O_IW = 3648, O_BQ = 3656, O_BF = 4680, O_BI = 5704, O_BG = 6728,
              O_CQ = 7752, O_CK = 8776, O_CV = 9800, O_CG = 11848, O_GA = 13896, O_GB = 14920, O_GC = 15944;

#define LAS __attribute__((address_space(3)))
#define GAS __attribute__((address_space(1)))
typedef unsigned short bf16_t;
typedef short bf16x8 __attribute__((ext_vector_type(8)));
typedef short s16x4 __attribute__((ext_vector_type(4)));
typedef float f32x4 __attribute__((ext_vector_type(4)));
typedef float f32x2 __attribute__((ext_vector_type(2)));
typedef unsigned u32x4 __attribute__((ext_vector_type(4)));
typedef unsigned u32x2 __attribute__((ext_vector_type(2)));
typedef unsigned long long u64;

constexpr size_t MiB = 1u << 20;
constexpr size_t WS_CTL = 0, CTL_ZERO_BYTES = 1 * MiB;
constexpr size_t WS_MOD = 1 * MiB;
constexpr size_t WS_LB = WS_MOD + 512 * 1024;
constexpr size_t WS_TB = WS_LB + 16 * 1024;
constexpr size_t WS_ROT = 2 * MiB;
constexpr size_t WS_RW = 6 * MiB;
constexpr size_t WS_X = 8 * MiB;
constexpr size_t WS_H = 72 * MiB;
constexpr size_t WS_W = 104 * MiB;
constexpr size_t W_IN = 0, W_BA = 34 * MiB, W_BB = 36 * MiB, W_BC = 38 * MiB, W_OUT = 42 * MiB, W_E1 = 44 * MiB, W_E2 = 108 * MiB;
constexpr size_t WS_P = 244 * MiB;
constexpr size_t P_QA = 0, P_KA = 32 * MiB, P_VA = 64 * MiB, P_IQ = 96 * MiB, P_IK = 112 * MiB, P_IW = 114 * MiB,
                 P_BQ = 116 * MiB, P_BG = 148 * MiB, P_BV = 180 * MiB, P_BO = 212 * MiB, P_CQ = 244 * MiB, P_CK = 276 * MiB,
                 P_CV = 308 * MiB, P_CG = 372 * MiB, P_GA = 436 * MiB, P_GB = 468 * MiB, P_GC = 500 * MiB;
constexpr size_t WS_MASK = 776 * MiB;
constexpr size_t WS_OA = 784 * MiB;
constexpr size_t WS_HA = 816 * MiB;
constexpr size_t WS_HDEC = 832 * MiB;
constexpr size_t WS_RA = 834 * MiB;
constexpr size_t WS_OB = 850 * MiB;
constexpr size_t WS_OC = 882 * MiB;
constexpr size_t WS_MG = 946 * MiB;
constexpr size_t WS_MGB = 1010 * MiB;
constexpr size_t WS_END = 1042 * MiB;
constexpr int XG_ROWS = 40960;
constexpr size_t WS_XG = WS_P, WS_ACT = WS_P + 80 * MiB, WS_YS = WS_P + 120 * MiB, WS_RINFO = WS_P + 184 * MiB, WS_TOK = WS_P + 186 * MiB, WS_T2E = WS_P + 190 * MiB;
constexpr int CW_BAR = 4096;
constexpr int CW_ECNT = 16384;

typedef __bf16 bf16x2_n __attribute__((ext_vector_type(2)));
__device__ __forceinline__ unsigned cvt_pk_bf16(float lo, float hi) { const f32x2 v = {lo, hi}; const bf16x2_n r = __builtin_convertvector(v, bf16x2_n); return __builtin_bit_cast(unsigned, r); }
__device__ __forceinline__ float bf2f(unsigned short b) { return __uint_as_float(((unsigned)b) << 16); }
__device__ __forceinline__ float bflo(unsigned w) { return __uint_as_float(w << 16); }
__device__ __forceinline__ float bfhi(unsigned w) { return __uint_as_float(w & 0xffff0000u); }
__device__ __forceinline__ float sigmoid_f(float x) { return __builtin_amdgcn_rcpf(1.f + __expf(-x)); }
__device__ __forceinline__ float silu_f(float x) { return x * sigmoid_f(x); }
__device__ __forceinline__ float wave_sum(float v) {
#pragma unroll
    for (int o = 1; o < 64; o <<= 1) v += __shfl_xor(v, o);
    return v;
}
#define LDS_WAIT() asm volatile("s_waitcnt lgkmcnt(0)" ::: "memory")
#define VM_WAIT() asm volatile("s_waitcnt vmcnt(0)" ::: "memory")
constexpr int NWAVES = 8, NTHR = 512;
constexpr int RING_BYTES = 131072;
constexpr int MISC_OFF = RING_BYTES;
constexpr int LDS_BYTES = 147456;
struct Frame {
    LAS unsigned char* lds;
    volatile LAS unsigned* MISC;
    unsigned* ctl;
    unsigned char* ws;
    int tid, lane, wave, G, bid;
    float* out;
    __device__ __forceinline__ const float* in(int i) const { const LAS unsigned* p = (const LAS unsigned*)(lds + MISC_OFF + 512) + 2 * i;
        const unsigned lo = __builtin_amdgcn_readfirstlane(p[0]), hi = __builtin_amdgcn_readfirstlane(p[1]); return (const float*)(((u64)hi << 32) | lo); }
};
struct Args { const float* in[22]; float* out; unsigned char* ws; int lay_lo, lay_hi, ph_lo, ph_hi; };

__device__ __forceinline__ int t5_bucket(int rel) {
    if (rel < 16) return rel;
    int large = 16 + (int)(logf((float)rel / 16.f) / logf(8.f) * 16.f);
    return large < 31 ? large : 31;
}
__device__ __forceinline__ void ph_prologue(Frame& F) {
    const float* c = F.in(1); const float* rel_bias = F.in(2); const float* lb_raw = F.in(3); const float* ada_w = F.in(6); const float* ada_b = F.in(7);
    const float* rg_w = F.in(14); const float* re_w = F.in(16);
    float* mod = (float*)(F.ws + WS_MOD); float* lb = (float*)(F.ws + WS_LB); float* tb = (float*)(F.ws + WS_TB); float2* rot = (float2*)(F.ws + WS_ROT); bf16_t* rw = (bf16_t*)(F.ws + WS_RW);
    LAS float* sc = (LAS float*)F.lds;
    LAS float* red = (LAS float*)(F.lds + 16384);
    for (int i = F.tid; i < BATCH * D; i += NTHR) { const float v = c[i]; sc[i] = v / (1.f + __expf(-v)); }
    __syncthreads();
    for (int it = F.bid; it < DEPTH * 48; it += F.G) {
        const int l = it / 48, j0 = (it % 48) * 128, jj = F.tid & 127, kp = F.tid >> 7;
        const float* w = ada_w + (size_t)l * D * 6 * D + j0 + jj;
        float a0 = 0.f, a1 = 0.f, a2 = 0.f, a3 = 0.f;
        for (int k = kp * 256; k < kp * 256 + 256; ++k) { const float wv = w[(size_t)k * 6 * D]; a0 += sc[k] * wv; a1 += sc[D + k] * wv; a2 += sc[2 * D + k] * wv; a3 += sc[3 * D + k] * wv; }
        red[(kp * 128 + jj) * 4 + 0] = a0; red[(kp * 128 + jj) * 4 + 1] = a1; red[(kp * 128 + jj) * 4 + 2] = a2; red[(kp * 128 + jj) * 4 + 3] = a3;
        __syncthreads();
        { const int b = F.tid >> 7;
          const float s = red[(0 * 128 + jj) * 4 + b] + red[(1 * 128 + jj) * 4 + b] + red[(2 * 128 + jj) * 4 + b] + red[(3 * 128 + jj) * 4 + b];
          mod[((size_t)l * BATCH + b) * 6 * D + j0 + jj] = s + ada_b[l * 6 * D + j0 + jj]; }
        __syncthreads();
    }
    const int gt = F.bid * NTHR + F.tid, NT = F.G * NTHR;
    for (int d = gt; d < D; d += NT) {
        float v0 = lb_raw[d], v1 = lb_raw[D + d], v2 = lb_raw[2 * D + d], v3 = lb_raw[3 * D + d];
        const float mx = fmaxf(fmaxf(v0, v1), fmaxf(v2, v3));
        v0 = expf(v0 - mx); v1 = expf(v1 - mx); v2 = expf(v2 - mx); v3 = expf(v3 - mx);
        const float s = v0 + v1 + v2 + v3;
        lb[d] = 0.f; lb[D + d] = v1 / s; lb[2 * D + d] = (v1 + v2) / s; lb[3 * D + d] = (v1 + v2 + v3) / s;
    }
    for (int idx = gt; idx < SEQ * 128; idx += NT) { const int t = idx >> 7, i = idx & 127;
        const double th = exp(-(double)i / 127.0 * 9.210340371976184), a = (double)t * th;
        rot[idx] = make_float2((float)cos(a), (float)sin(a)); }
    for (int idx = gt; idx < 8 * 128; idx += NT) { const int h = idx >> 7, rel = idx & 127;
        tb[idx] = (rel_bias[t5_bucket(rel) * A_HEADS + h] - rel_bias[31 * A_HEADS + h]) * 11.313708498984761f; }
    for (int idx = gt; idx < DEPTH * 48 * D; idx += NT) { const int l = idx / (48 * D), r = idx % (48 * D), n = r >> 10, k = r & 1023;
        float v = 0.f; if (n < 4) v = rg_w[((size_t)l * D + k) * 4 + n]; else if (n < 36) v = re_w[((size_t)l * D + k) * 32 + (n - 4)];
        rw[idx] = (bf16_t)(cvt_pk_bf16(v, 0.f) & 0xffffu); }
}

__device__ __forceinline__ void conv_tile(const float* W, int ldw, int nvalid, bf16_t* dst, int K, int k0, LAS float* scr, int lane) {
    const bool ok = (lane & 31) < nvalid;
#pragma unroll 8
    for (int i = 0; i < 32; ++i) { const int kk = 2 * i + (lane >> 5); scr[kk * 33 + (lane & 31)] = ok ? W[(size_t)(k0 + kk) * ldw + (lane & 31)] : 0.f; }
    LDS_WAIT(); asm volatile("" ::: "memory");
    const int c = lane & 7;
#pragma unroll
    for (int j = 0; j < 4; ++j) { const int n = (lane >> 3) + 8 * j; const LAS float* s = scr + (8 * c) * 33 + n;
        u32x4 o; o.x = cvt_pk_bf16(s[0 * 33], s[1 * 33]); o.y = cvt_pk_bf16(s[2 * 33], s[3 * 33]); o.z = cvt_pk_bf16(s[4 * 33], s[5 * 33]); o.w = cvt_pk_bf16(s[6 * 33], s[7 * 33]);
        *(u32x4*)(dst + (size_t)n * K + k0 + 8 * c) = o; }
    LDS_WAIT(); asm volatile("" ::: "memory");
}
__device__ __forceinline__ void ph_conv(Frame& F, int l) {
    LAS float* scr = (LAS float*)(F.lds + F.wave * 16384);
    const int gw = F.bid * NWAVES + F.wave, NGW = F.G * NWAVES;
    unsigned char* wb = F.ws + WS_W;
    constexpr int I_IN = 536 * 16, I_B = 32 * 16, I_C = 32 * 32, I_E1 = 32 * 32 * 16, I_E2 = 32 * 32 * 8;
    constexpr int NITEMS = I_IN + 3 * I_B + I_C + I_E1 + I_E2;
    for (int it = gw; it < NITEMS; it += NGW) {
        int r = it;
        if (r < I_IN) { const int nb = r >> 4, kb = r & 15, n0 = nb * 32; int c0, nv;
            if (n0 + 32 <= 3656) { c0 = n0; nv = 32; } else if (n0 < 3656) { c0 = n0; nv = 3656 - n0; } else if (n0 < 3840) { c0 = 0; nv = 0; } else { c0 = n0 - 184; nv = 32; }
            conv_tile(F.in(8) + (size_t)l * D * N_IN + c0, N_IN, nv, (bf16_t*)(wb + W_IN) + (size_t)n0 * D, D, kb * 64, scr, F.lane); continue; }
        r -= I_IN;
        if (r < I_B) { conv_tile(F.in(10) + (size_t)l * 1024 * D + (r >> 4) * 32, D, 32, (bf16_t*)(wb + W_BA) + (size_t)(r >> 4) * 32 * 1024, 1024, (r & 15) * 64, scr, F.lane); continue; }
        r -= I_B;
        if (r < I_B) { conv_tile(F.in(11) + (size_t)l * 1024 * D + (r >> 4) * 32, D, 32, (bf16_t*)(wb + W_BB) + (size_t)(r >> 4) * 32 * 1024, 1024, (r & 15) * 64, scr, F.lane); continue; }
        r -= I_B;
        if (r < I_C) { conv_tile(F.in(12) + (size_t)l * 2048 * D + (r >> 5) * 32, D, 32, (bf16_t*)(wb + W_BC) + (size_t)(r >> 5) * 32 * 2048, 2048, (r & 31) * 64, scr, F.lane); continue; }
        r -= I_C;
        if (r < I_B) { conv_tile(F.in(13) + (size_t)l * D * D + (r >> 4) * 32, D, 32, (bf16_t*)(wb + W_OUT) + (size_t)(r >> 4) * 32 * 1024, 1024, (r & 15) * 64, scr, F.lane); continue; }
        r -= I_B;
        if (r < I_E1) { const int e = r >> 9, q = r & 511, nb = q >> 4, kb = q & 15, n0 = nb * 32;
            const int pn = n0 >> 8, bj = (n0 >> 7) & 1, j0 = n0 & 127;
            const float* src = (bj ? F.in(19) : F.in(18)) + ((size_t)l * NE + e) * D * DEXP + 128 * pn + j0;
            conv_tile(src, DEXP, 32, (bf16_t*)(wb + W_E1) + ((size_t)e * 1024 + n0) * 1024, 1024, kb * 64, scr, F.lane); continue; }
        r -= I_E1;
        { const int e = r >> 8, q = r & 255, nb = q >> 3, kb = q & 7;
          conv_tile(F.in(20) + ((size_t)l * NE + e) * DEXP * D + nb * 32, D, 32, (bf16_t*)(wb + W_E2) + ((size_t)e * 1024 + nb * 32) * 512, 512, kb * 64, scr, F.lane); }
    }
}

__device__ __forceinline__ void ph_norm(Frame& F, const float* xs, const bf16_t* ys, const float* gt2, float* xd, const float* g, const float* sc, const float* sh, bf16_t* hout, float* fout) {
    const int gw = F.bid * NWAVES + F.wave, NGW = F.G * NWAVES;
    for (int row = gw; row < M; row += NGW) {
        const int b = row >> 12;
        f32x4 v[4]; float ss = 0.f;
#pragma unroll
        for (int j = 0; j < 4; ++j) { const int c = 4 * F.lane + 256 * j; v[j] = *(const f32x4*)(xs + (size_t)row * D + c);
            if (ys) { const u32x2 y0 = *(const u32x2*)(ys + ((size_t)row * 2) * D + c), y1 = *(const u32x2*)(ys + ((size_t)row * 2 + 1) * D + c); const f32x4 gg = *(const f32x4*)(gt2 + b * 6 * D + c);
                v[j][0] += gg[0] * (bflo(y0.x) + bflo(y1.x)); v[j][1] += gg[1] * (bfhi(y0.x) + bfhi(y1.x)); v[j][2] += gg[2] * (bflo(y0.y) + bflo(y1.y)); v[j][3] += gg[3] * (bfhi(y0.y) + bfhi(y1.y)); }
            ss += (v[j][0] * v[j][0] + v[j][1] * v[j][1]) + (v[j][2] * v[j][2] + v[j][3] * v[j][3]); }
        const float r = rsqrtf(wave_sum(ss) * (1.f / D) + EPS);
#pragma unroll
        for (int j = 0; j < 4; ++j) { const int c = 4 * F.lane + 256 * j;
            if (xd) *(f32x4*)(xd + (size_t)row * D + c) = v[j];
            f32x4 o = v[j] * r * *(const f32x4*)(g + c);
            if (sc) o = o * (1.f + *(const f32x4*)(sc + b * 6 * D + c)) + *(const f32x4*)(sh + b * 6 * D + c);
            if (hout) { u32x2 w; w.x = cvt_pk_bf16(o[0], o[1]); w.y = cvt_pk_bf16(o[2], o[3]); *(u32x2*)(hout + (size_t)row * D + c) = w; }
            else *(f32x4*)(fout + (size_t)row * D + c) = o; }
    }
}
namespace pg8 {
#define PG8_LAS __attribute__((address_space(3)))
typedef unsigned short bf16_t;
typedef short bf16x8 __attribute__((ext_vector_type(8)));
typedef float f32x4 __attribute__((ext_vector_type(4)));
typedef unsigned u32x4 __attribute__((ext_vector_type(4)));
constexpr int BM = 256, BK = 64, HALF = 128, HTB = HALF * BK * 2  , STAGE_BYTES = 8 * HTB, NXCD = 8, WGM = 8;

__host__ __device__ __forceinline__ int lds_byte(int r, int c) { const int st = (r >> 4) * 2 + (c >> 5), rr = r & 15, cc = c & 31, ob = rr * 64 + cc * 2; return st * 1024 + (ob ^ (((ob >> 9) & 1) << 5)); }
__host__ __device__ __forceinline__ void stage_rc(int b, int& R, int& C) { const int st = b / 1024, sb = b % 1024, swz = sb ^ (((sb >> 9) & 1) << 5); R = (st >> 1) * 16 + swz / 64; C = (st & 1) * 32 + (swz % 64) / 2; }
__host__ __device__ __forceinline__ int perm32(int rho) { const int n = rho >> 4, i = rho & 15; return 8 * (i >> 2) + 4 * n + (i & 3); }

struct Unit { int pm, pn; };
struct Gemm { const bf16_t* A; const bf16_t* Bt; int M, N, K; };

struct StaticOrder {
    int nM, nN, nwg, G, c;
    __host__ __device__ void init(int M, int N, int G_, int c_) { nM = M / BM; nN = N / BM; nwg = nM * nN; G = G_; c = c_; }
    __host__ __device__ bool next(int i, Unit& u) const {
        const long L = (long)i * G + c; if (L >= nwg) return false;
        int wgid = (int)L; { const int q = nwg / NXCD, r = nwg % NXCD, xcd = wgid % NXCD, off = wgid / NXCD; wgid = (xcd < r ? xcd * (q + 1) : r * (q + 1) + (xcd - r) * q) + off; }
        const int nig = WGM * nN, gid = wgid / nig, fm = gid * WGM, gsz = (nM - fm) < WGM ? (nM - fm) : WGM;
        u.pm = fm + ((wgid % nig) % gsz); u.pn = (wgid % nig) / gsz; return true;
    }
    __device__ __forceinline__ void a_ready(const Unit&) const {}
    __device__ __forceinline__ void done(const Unit&) const {}
};


__device__ __forceinline__ void st8(bf16_t* p, const float* x) { u32x4 w; w.x = cvt_pk_bf16(x[0], x[1]); w.y = cvt_pk_bf16(x[2], x[3]); w.z = cvt_pk_bf16(x[4], x[5]); w.w = cvt_pk_bf16(x[6], x[7]); *(u32x4*)p = w; }
enum { K_PLAIN = 0, K_LOGF = 1, K_SILU = 2, K_SIGM = 3, K_ROTQ = 4, K_ROTK = 5, K_IDX = 6 };
struct EpiProj {
    static constexpr bool PERM = true, AFTER_DRAIN = false;
    unsigned char* pb;
    const float* lb;
    const float2* rot;
    __device__ __forceinline__ void operator()(const f32x4 (&acc)[2][2][4][2], const Unit& u, int wr, int wc, int fr, int fq) const {
        const int pn = u.pn; size_t off; int ld, cb, kind, hd = 0;
        if (pn < 12) { off = P_QA + (size_t)(pn >> 2) * 32 * MiB; ld = 1024; cb = (pn & 3) * 256; kind = K_PLAIN; }
        else if (pn < 14) { off = P_IQ; ld = 512; cb = (pn - 12) * 256; kind = K_PLAIN; }
        else if (pn == 14) { off = P_IK; ld = 64; cb = 0; kind = K_IDX; }
        else if (pn < 31) { const int q = pn - 15, t = q >> 2; off = P_BQ + (size_t)t * 32 * MiB; ld = 1024; cb = (q & 3) * 256; kind = (t == 1) ? K_LOGF : (t == 3) ? K_SILU : K_PLAIN; }
        else if (pn < 39) { const int q = pn - 31, t = q >> 2; off = P_CQ + (size_t)t * 32 * MiB; ld = 1024; cb = (q & 3) * 256; kind = t ? K_ROTK : K_ROTQ; hd = q & 3; }
        else if (pn < 55) { const int q = pn - 39, t = q >> 3; off = P_CV + (size_t)t * 64 * MiB; ld = 2048; cb = (q & 7) * 256; kind = t ? K_SILU : K_PLAIN; }
        else { const int q = pn - 55, t = q >> 2; off = P_GA + (size_t)t * 32 * MiB; ld = 1024; cb = (q & 3) * 256; kind = K_SIGM; }
        bf16_t* base = (bf16_t*)(pb + off);
        const int row0 = u.pm * BM + wr * 64 + fr, cl0 = wc * 32 + 8 * fq;
        if (kind == K_IDX) {
            float* iw = (float*)(pb + P_IW);
#pragma unroll
            for (int ai = 0; ai < 2; ++ai)
#pragma unroll
                for (int m = 0; m < 4; ++m) { const int row = row0 + ai * HALF + m * 16;
                    if (cl0 < 64) { float x[8] = {acc[ai][0][m][0][0], acc[ai][0][m][0][1], acc[ai][0][m][0][2], acc[ai][0][m][0][3], acc[ai][0][m][1][0], acc[ai][0][m][1][1], acc[ai][0][m][1][2], acc[ai][0][m][1][3]};
                        st8(base + (size_t)row * 64 + cl0, x); }
                    else if (cl0 == 64) { *(f32x4*)(iw + (size_t)row * 8) = acc[ai][0][m][0]; *(f32x4*)(iw + (size_t)row * 8 + 4) = acc[ai][0][m][1]; } }
            return;
        }
        const float l2g = __log2f(1.f - exp2f(-5.f - (float)hd));
#pragma unroll
        for (int ai = 0; ai < 2; ++ai)
#pragma unroll
            for (int m = 0; m < 4; ++m) { const int row = row0 + ai * HALF + m * 16; bf16_t* rowp = base + (size_t)row * ld + cb + cl0;
#pragma unroll
                for (int bj = 0; bj < 2; ++bj) {
                    float x[8] = {acc[ai][bj][m][0][0], acc[ai][bj][m][0][1], acc[ai][bj][m][0][2], acc[ai][bj][m][0][3], acc[ai][bj][m][1][0], acc[ai][bj][m][1][1], acc[ai][bj][m][1][2], acc[ai][bj][m][1][3]};
                    if (kind == K_LOGF) {
#pragma unroll
                        for (int j = 0; j < 8; ++j) { const float lv = lb[cb + bj * HALF + cl0 + j]; x[j] = __logf(lv + (1.f - lv) * sigmoid_f(x[j])); } }
                    else if (kind == K_SILU) {
#pragma unroll
                        for (int j = 0; j < 8; ++j) x[j] = silu_f(x[j]); }
                    else if (kind == K_SIGM) {
#pragma unroll
                        for (int j = 0; j < 8; ++j) x[j] = sigmoid_f(x[j]); }
                    else if (kind == K_ROTQ || kind == K_ROTK) {
                        const int pos = row & (SEQ - 1), e = pos & 127, i0 = (bj * HALF + cl0) >> 1;
                        const f32x4 r0 = *(const f32x4*)(rot + (size_t)pos * 128 + i0), r1 = *(const f32x4*)(rot + (size_t)pos * 128 + i0 + 2);
                        const float s = (kind == K_ROTQ) ? exp2f((float)(e + 1) * l2g) : 0.0625f * exp2f((float)(127 - e) * l2g);
                        const float cs[8] = {r0[0], r0[1], r0[2], r0[3], r1[0], r1[1], r1[2], r1[3]};
#pragma unroll
                        for (int j = 0; j < 4; ++j) { const float a = x[2 * j], b = x[2 * j + 1], c = cs[2 * j], sn = cs[2 * j + 1]; x[2 * j] = (a * c - b * sn) * s; x[2 * j + 1] = (b * c + a * sn) * s; } }
                    st8(rowp + bj * HALF, x); } }
    }
};
template <int STEP> struct EpiMerge {
    static constexpr bool PERM = false, AFTER_DRAIN = false;
    const bf16_t* gate; float* mg; bf16_t* mgb;
    __device__ __forceinline__ void operator()(const f32x4 (&acc)[2][2][4][2], const Unit& u, int wr, int wc, int fr, int fq) const {
        const int row0 = u.pm * BM + wr * 64 + fr, col0 = u.pn * BM + wc * 32 + 4 * fq;
#pragma unroll
        for (int ai = 0; ai < 2; ++ai)
#pragma unroll
            for (int m = 0; m < 4; ++m) { const size_t ro = (size_t)(row0 + ai * HALF + m * 16) * 1024 + col0;
#pragma unroll
                for (int bj = 0; bj < 2; ++bj)
#pragma unroll
                    for (int n = 0; n < 2; ++n) { const size_t o = ro + bj * HALF + n * 16; const u32x2 gw = *(const u32x2*)(gate + o);
                        f32x4 v = acc[ai][bj][m][n] * (f32x4){bflo(gw.x), bfhi(gw.x), bflo(gw.y), bfhi(gw.y)};
                        if (STEP > 0) v += *(const f32x4*)(mg + o);
                        if (STEP < 2) *(f32x4*)(mg + o) = v;
                        else { u32x2 w; w.x = cvt_pk_bf16(v[0], v[1]); w.y = cvt_pk_bf16(v[2], v[3]); *(u32x2*)(mgb + o) = w; } } }
    }
};
struct EpiRes {
    static constexpr bool PERM = false, AFTER_DRAIN = false;
    const float* xs; float* xd; const float* gt;
    __device__ __forceinline__ void operator()(const f32x4 (&acc)[2][2][4][2], const Unit& u, int wr, int wc, int fr, int fq) const {
        const int row0 = u.pm * BM + wr * 64 + fr, col0 = u.pn * BM + wc * 32 + 4 * fq; const int b = (u.pm * BM) >> 12;
#pragma unroll
        for (int ai = 0; ai < 2; ++ai)
#pragma unroll
            for (int m = 0; m < 4; ++m) { const size_t ro = (size_t)(row0 + ai * HALF + m * 16) * 1024 + col0;
#pragma unroll
                for (int bj = 0; bj < 2; ++bj)
#pragma unroll
                    for (int n = 0; n < 2; ++n) { const size_t o = ro + bj * HALF + n * 16; const f32x4 g = *(const f32x4*)(gt + b * 6 * D + col0 + bj * HALF + n * 16);
                        *(f32x4*)(xd + o) = *(const f32x4*)(xs + o) + g * acc[ai][bj][m][n]; } }
    }
};
struct EpiExpUp {
    static constexpr bool PERM = true, AFTER_DRAIN = false;
    bf16_t* act;
    __device__ __forceinline__ void operator()(const f32x4 (&acc)[2][2][4][2], const Unit& u, int wr, int wc, int fr, int fq) const {
        const int row0 = u.pm * BM + wr * 64 + fr, col0 = (u.pn & 3) * 128 + wc * 32 + 8 * fq;
#pragma unroll
        for (int ai = 0; ai < 2; ++ai)
#pragma unroll
            for (int m = 0; m < 4; ++m) { float x[8];
#pragma unroll
                for (int n = 0; n < 2; ++n)
#pragma unroll
                    for (int i = 0; i < 4; ++i) x[4 * n + i] = silu_f(acc[ai][0][m][n][i]) * acc[ai][1][m][n][i];
                st8(act + (size_t)(row0 + ai * HALF + m * 16) * DEXP + col0, x); }
    }
};
struct EpiExpDown {
    static constexpr bool PERM = true, AFTER_DRAIN = false;
    const int2* rinfo; bf16_t* ys;
    __device__ __forceinline__ void operator()(const f32x4 (&acc)[2][2][4][2], const Unit& u, int wr, int wc, int fr, int fq) const {
        const int row0 = u.pm * BM + wr * 64 + fr, col0 = (u.pn & 3) * 256 + wc * 32 + 8 * fq;
#pragma unroll
        for (int ai = 0; ai < 2; ++ai)
#pragma unroll
            for (int m = 0; m < 4; ++m) { const int2 ri = rinfo[row0 + ai * HALF + m * 16];
                if (ri.x >= 0) { const float w = __int_as_float(ri.y);
#pragma unroll
                    for (int bj = 0; bj < 2; ++bj) { float x[8];
#pragma unroll
                        for (int n = 0; n < 2; ++n)
#pragma unroll
                            for (int i = 0; i < 4; ++i) x[4 * n + i] = w * acc[ai][bj][m][n][i];
                        st8(ys + (size_t)ri.x * D + col0 + bj * HALF, x); } } }
    }
};
struct ListOrder {
    const LAS int* tab; int n;
    __device__ __forceinline__ bool next(int i, Unit& u) const { if (i >= n) return false; const int v = tab[i]; u.pm = v >> 8; u.pn = v & 255; return true; }
    __device__ __forceinline__ void a_ready(const Unit&) const {}
    __device__ __forceinline__ void done(const Unit&) const {}
};

template <class Epi, class Sched, bool ALIGN_EPI = false, bool SP2 = false>
__device__ __forceinline__ void gemm_phase(PG8_LAS unsigned char* lds, const Gemm g, const Sched& S, const Epi& E) {
    int tid_ = threadIdx.x; asm volatile("" : "+v"(tid_));
    const int tid = tid_, wid = __builtin_amdgcn_readfirstlane(tid >> 6), lane = tid & 63, wr = wid >> 2, wc = wid & 3, fr = lane & 15, fq = lane >> 4;
    const int K = g.K, nt = K / BK;
    unsigned voffA[2], voffB[2];
#pragma unroll
    for (int i = 0; i < 2; ++i) { int R, C; stage_rc(tid * 16 + i * 8192, R, C); const int Rb = Epi::PERM ? ((R & ~31) + perm32(R & 31)) : R;
        voffA[i] = (unsigned)(R * K + C) * 2u; voffB[i] = (unsigned)(Rb * K + C) * 2u; }
    const size_t kstep = (size_t)(BK * 2);
    const size_t hstep = (size_t)HALF * K * 2;
    const size_t tstep = 2 * hstep;
    const unsigned ldsw = (unsigned)wid * 1024u;
    const int aoff = lds_byte(wr * 64 + fr, fq * 8), boff = lds_byte(wc * 32 + fr, fq * 8);
#define PG8_SA(b, h) (((b) * 2 + (h)) * HTB)
#define PG8_SB(b, h) ((4 + (b) * 2 + (h)) * HTB)
#define PG8_STAGE(bufoff, gbase, voff) do { _Pragma("unroll") for (int _i = 0; _i < 2; ++_i) \
        __builtin_amdgcn_global_load_lds((const unsigned*)((const char*)(gbase) + (voff)[_i]), (PG8_LAS unsigned*)(lds + (bufoff) + ldsw + _i * 8192), 16, 0, 0); } while (0)
#define PG8_LDA(dst, b, h) do { _Pragma("unroll") for (int m = 0; m < 4; ++m) _Pragma("unroll") for (int k = 0; k < 2; ++k) dst[m][k] = *(const PG8_LAS bf16x8*)(lds + PG8_SA(b, h) + aoff + m * 2048 + k * 1024); } while (0)
#define PG8_LDB(dst, b, h) do { _Pragma("unroll") for (int n = 0; n < 2; ++n) _Pragma("unroll") for (int k = 0; k < 2; ++k) dst[n][k] = *(const PG8_LAS bf16x8*)(lds + PG8_SB(b, h) + boff + n * 2048 + k * 1024); } while (0)
#define PG8_MMA(ai, bj, At, Bt) do { __builtin_amdgcn_s_setprio(1); _Pragma("unroll") for (int m = 0; m < 4; ++m) _Pragma("unroll") for (int n = 0; n < 2; ++n) _Pragma("unroll") for (int k = 0; k < 2; ++k) \
        acc[ai][bj][m][n] = __builtin_amdgcn_mfma_f32_16x16x32_bf16(Bt[n][k], At[m][k], acc[ai][bj][m][n], 0, 0, 0); __builtin_amdgcn_s_setprio(0); } while (0)
#define PG8_WAIT_V(n) asm volatile("s_waitcnt vmcnt(" #n ")" ::: "memory")
#define PG8_WAIT_L(n) asm volatile("s_waitcnt lgkmcnt(" #n ")" ::: "memory")
#define PG8_BAR __builtin_amdgcn_s_barrier()
#define PG8_SCHED __builtin_amdgcn_sched_barrier(0)
    Unit cur, nxt; int ui = 0;
    if (!S.next(0, cur)) return;
    f32x4 acc[2][2][4][2];
#pragma unroll
    for (int a = 0; a < 2; ++a)
#pragma unroll
        for (int b = 0; b < 2; ++b)
#pragma unroll
            for (int m = 0; m < 4; ++m)
#pragma unroll
                for (int n = 0; n < 2; ++n) acc[a][b][m][n] = (f32x4){0.f, 0.f, 0.f, 0.f};
    bf16x8 At[4][2], B0[2][2], B1[2][2];
    const char* cA = (const char*)g.A + (size_t)cur.pm * tstep; const char* cB = (const char*)g.Bt + (size_t)cur.pn * tstep;
    S.a_ready(cur);
    if constexpr (SP2) {
        PG8_STAGE(PG8_SB(0, 0), cB, voffB); PG8_STAGE(PG8_SB(0, 1), cB + hstep, voffB); PG8_STAGE(PG8_SA(0, 0), cA, voffA); PG8_STAGE(PG8_SA(0, 1), cA + hstep, voffA);
        if (wr == 1) PG8_BAR;
        PG8_WAIT_V(2); PG8_BAR;
        PG8_STAGE(PG8_SB(1, 0), cB + kstep, voffB); PG8_STAGE(PG8_SA(1, 0), cA + kstep, voffA); PG8_STAGE(PG8_SB(1, 1), cB + hstep + kstep, voffB);
        PG8_WAIT_V(6); PG8_BAR;
    } else {
        PG8_STAGE(PG8_SB(0, 0), cB, voffB); PG8_STAGE(PG8_SA(0, 0), cA, voffA); PG8_STAGE(PG8_SB(0, 1), cB + hstep, voffB); PG8_STAGE(PG8_SA(0, 1), cA + hstep, voffA);
        if (wr == 1) PG8_BAR;
        PG8_WAIT_V(4); PG8_BAR;
        PG8_STAGE(PG8_SB(1, 0), cB + kstep, voffB); PG8_STAGE(PG8_SA(1, 0), cA + kstep, voffA); PG8_STAGE(PG8_SB(1, 1), cB + hstep + kstep, voffB);
        PG8_WAIT_V(6); PG8_BAR;
    }
    for (;;) {
        const bool has_next = S.next(ui + 1, nxt);
        const char* nA = has_next ? (const char*)g.A + (size_t)nxt.pm * tstep : cA; const char* nB = has_next ? (const char*)g.Bt + (size_t)nxt.pn * tstep : cB;
        for (int t = 0; t < nt; t += 2) {
            const bool last = (t == nt - 2);
            const char* a1 = cA + (size_t)(t + 1) * kstep;
            const char* a2 = last ? nA : cA + (size_t)(t + 2) * kstep; const char* b2 = last ? nB : cB + (size_t)(t + 2) * kstep;
            const char* a3 = a2 + kstep; const char* b3 = b2 + kstep;
            if (last && has_next) S.a_ready(nxt);
            if constexpr (SP2) {
            PG8_LDB(B0, 0, 0); PG8_LDB(B1, 0, 1); PG8_SCHED; PG8_LDA(At, 0, 0); PG8_STAGE(PG8_SA(1, 1), a1 + hstep, voffA);
            PG8_WAIT_V(8); PG8_WAIT_L(0); PG8_BAR; PG8_MMA(0, 0, At, B0); PG8_MMA(0, 1, At, B1); PG8_BAR; PG8_SCHED;
            PG8_LDA(At, 0, 1); PG8_STAGE(PG8_SB(0, 0), b2, voffB); PG8_STAGE(PG8_SB(0, 1), b2 + hstep, voffB); PG8_STAGE(PG8_SA(0, 0), a2, voffA);
            PG8_WAIT_V(8); PG8_WAIT_L(0); PG8_BAR; PG8_MMA(1, 0, At, B0); PG8_MMA(1, 1, At, B1); PG8_BAR; PG8_SCHED;
            PG8_LDB(B0, 1, 0); PG8_LDB(B1, 1, 1); PG8_SCHED; PG8_LDA(At, 1, 0); PG8_STAGE(PG8_SA(0, 1), a2 + hstep, voffA);
            PG8_WAIT_V(8); PG8_WAIT_L(0); PG8_BAR; PG8_MMA(0, 0, At, B0); PG8_MMA(0, 1, At, B1); PG8_BAR; PG8_SCHED;
            PG8_LDA(At, 1, 1); PG8_STAGE(PG8_SB(1, 0), b3, voffB); PG8_STAGE(PG8_SB(1, 1), b3 + hstep, voffB); PG8_STAGE(PG8_SA(1, 0), a3, voffA);
            PG8_WAIT_V(8); PG8_WAIT_L(0); PG8_BAR; PG8_MMA(1, 0, At, B0); PG8_MMA(1, 1, At, B1); PG8_BAR; PG8_SCHED;
            } else {
            PG8_LDB(B0, 0, 0); PG8_SCHED; PG8_LDA(At, 0, 0); PG8_STAGE(PG8_SA(1, 1), a1 + hstep, voffA);
            PG8_WAIT_L(8); PG8_BAR; PG8_WAIT_L(0); PG8_MMA(0, 0, At, B0); PG8_BAR; PG8_SCHED;
            PG8_LDB(B1, 0, 1); PG8_STAGE(PG8_SB(0, 0), b2, voffB);
            PG8_BAR; PG8_WAIT_L(0); PG8_MMA(0, 1, At, B1); PG8_BAR;
            PG8_LDA(At, 0, 1); PG8_STAGE(PG8_SA(0, 0), a2, voffA);
            PG8_BAR; PG8_WAIT_L(0); PG8_MMA(1, 0, At, B0); PG8_BAR; PG8_SCHED;
            PG8_STAGE(PG8_SB(0, 1), b2 + hstep, voffB);
            PG8_WAIT_V(6); PG8_BAR; PG8_MMA(1, 1, At, B1); PG8_BAR;
            PG8_LDB(B0, 1, 0); PG8_SCHED; PG8_LDA(At, 1, 0); PG8_STAGE(PG8_SA(0, 1), a2 + hstep, voffA);
            PG8_WAIT_L(8); PG8_BAR; PG8_WAIT_L(0); PG8_MMA(0, 0, At, B0); PG8_BAR; PG8_SCHED;
            PG8_LDB(B1, 1, 1); PG8_STAGE(PG8_SB(1, 0), b3, voffB);
            PG8_BAR; PG8_WAIT_L(0); PG8_MMA(0, 1, At, B1); PG8_BAR;
            PG8_LDA(At, 1, 1); PG8_STAGE(PG8_SA(1, 0), a3, voffA);
            PG8_BAR; PG8_WAIT_L(0); PG8_MMA(1, 0, At, B0); PG8_BAR; PG8_SCHED;
            PG8_STAGE(PG8_SB(1, 1), b3 + hstep, voffB);
            PG8_WAIT_V(6); PG8_BAR; PG8_MMA(1, 1, At, B1); PG8_BAR;
            }
        }
        if constexpr (ALIGN_EPI) { if (wr == 0) PG8_BAR; }
        if constexpr (!Epi::AFTER_DRAIN) { E(acc, cur, wr, wc, fr, fq); S.done(cur); }
        if (!has_next) break;
#pragma unroll
        for (int a = 0; a < 2; ++a)
#pragma unroll
            for (int b = 0; b < 2; ++b)
#pragma unroll
                for (int m = 0; m < 4; ++m)
#pragma unroll
                    for (int n = 0; n < 2; ++n) acc[a][b][m][n] = (f32x4){0.f, 0.f, 0.f, 0.f};
        cur = nxt; cA = nA; cB = nB; ++ui;
        if constexpr (ALIGN_EPI) { if (wr == 1) PG8_BAR; }
    }
    PG8_WAIT_V(0);
    if constexpr (!ALIGN_EPI) { if (wr == 0) PG8_BAR; }
    PG8_BAR;
    if constexpr (Epi::AFTER_DRAIN) { E.fused(acc, cur, wr, wc, fr, fq, lds, wid, lane); S.done(cur); }
#undef PG8_SA
#undef PG8_SB
#undef PG8_STAGE
#undef PG8_LDA
#undef PG8_LDB
#undef PG8_MMA
#undef PG8_WAIT_V
#undef PG8_WAIT_L
#undef PG8_BAR
#undef PG8_SCHED
}
}

#define XB_TMO      128
#define XB_XCNT(j)  (256  + 64 * (j))
#define XB_XSUB(j)  (1280 + 64 * (j))
#define XB_XGEN(j)  (2304 + 64 * (j))
#define XB_TOP      3328
#define XB_TOPGEN   3392
#define XCD_BAR_WORDS 3456
#define XB_SPIN_CAP (1u << 18)

__device__ __forceinline__ unsigned xb_ld(unsigned* p)              { return __hip_atomic_load(p, __ATOMIC_RELAXED, __HIP_MEMORY_SCOPE_AGENT); }
__device__ __forceinline__ unsigned xb_add(unsigned* p, unsigned v) { return __hip_atomic_fetch_add(p, v, __ATOMIC_RELAXED, __HIP_MEMORY_SCOPE_AGENT); }
__device__ __forceinline__ unsigned xb_xcc_id() { return (unsigned)__builtin_amdgcn_s_getreg((3 << 11) | 20) & 0xFu; }
#define XB_SPIN(cond, bar) do { unsigned _sp = 0; while (cond) { __builtin_amdgcn_s_sleep(1); \
    if ((++_sp & 255u) == 0u) { if (xb_ld(&(bar)[XB_TMO])) break; if (_sp > XB_SPIN_CAP) { atomicAdd(&(bar)[XB_TMO], 1u); break; } } } } while (0)

struct XcdBarrier {
    unsigned* bar; unsigned x;
    volatile LAS unsigned* st;
};

__device__ __forceinline__ XcdBarrier xcd_barrier_post(unsigned* bar, volatile LAS unsigned* st) {
    XcdBarrier b; b.bar = bar; b.x = xb_xcc_id(); b.st = st;
    if (threadIdx.x == 0) (void)xb_add(&bar[XB_XCNT(b.x)], 1u);
    return b;
}
__device__ __forceinline__ void xcd_barrier_complete(unsigned* bar, unsigned x, unsigned& nloc, unsigned& nx) {
    const unsigned G = gridDim.x * gridDim.y * gridDim.z;
    unsigned sum, cnt, mine, sp = 0u;
    for (;;) {
        sum = 0u; cnt = 0u; mine = 0u;
#pragma unroll
        for (unsigned j = 0; j < 16; ++j) { const unsigned c = xb_ld(&bar[XB_XCNT(j)]); sum += c; cnt += (c > 0u) ? 1u : 0u; mine = (j == x) ? c : mine; }
        if (sum == G) break;
        __builtin_amdgcn_s_sleep(1);
        if ((++sp & 255u) == 0u) { if (xb_ld(&bar[XB_TMO])) break; if (sp > XB_SPIN_CAP) { atomicAdd(&bar[XB_TMO], 1u); break; } }
    }
    nloc = mine > 0u ? mine : 1u; nx = cnt > 0u ? cnt : 1u;
}

__device__ __forceinline__ void xcd_barrier(const XcdBarrier& b) {
    asm volatile("s_waitcnt vmcnt(0)" ::: "memory");
    __syncthreads();
    if (threadIdx.x == 0) {
        unsigned* bar = b.bar;
        __builtin_amdgcn_s_waitcnt(0);
        unsigned nloc = b.st[0], nx = b.st[1];
        if (nloc == 0u) { xcd_barrier_complete(bar, b.x, nloc, nx); b.st[0] = nloc; b.st[1] = nx; }
        const unsigned old = xb_add(&bar[XB_XSUB(b.x)], 1u);
        const unsigned gen = old / nloc;
        if (old + 1u == (gen + 1u) * nloc) {
            __builtin_amdgcn_fence(__ATOMIC_RELEASE, "agent");
            asm volatile("s_waitcnt vmcnt(0)" ::: "memory");
            const unsigned og = xb_add(&bar[XB_TOP], 1u);
            const unsigned tg = og / nx;
            if (og + 1u == (tg + 1u) * nx) xb_add(&bar[XB_TOPGEN], 1u);
            else XB_SPIN(xb_ld(&bar[XB_TOPGEN]) == tg, bar);
            __builtin_amdgcn_fence(__ATOMIC_ACQUIRE, "agent");
            xb_add(&bar[XB_XGEN(b.x)], 1u);
            asm volatile("s_waitcnt vmcnt(0)" ::: "memory");
        } else {
            XB_SPIN(xb_ld(&bar[XB_XGEN(b.x)]) == gen, bar);
            __builtin_amdgcn_fence(__ATOMIC_ACQUIRE, "agent");
            asm volatile("s_waitcnt vmcnt(0)" ::: "memory");
        }
    }
    __syncthreads();
}
__device__ __forceinline__ unsigned fkey(float f) { const unsigned u = __float_as_uint(f); return (u & 0x80000000u) ? ~u : (u | 0x80000000u); }
__device__ __forceinline__ void idx_item(Frame& F, int b, int rg) {
    const bf16_t* IQ = (const bf16_t*)(F.ws + WS_P + P_IQ); const bf16_t* IK = (const bf16_t*)(F.ws + WS_P + P_IK); const float* IW = (const float*)(F.ws + WS_P + P_IW);
    u64* maskT = (u64*)(F.ws + WS_MASK);
    LAS unsigned* cnt = (LAS unsigned*)F.lds;
    LAS unsigned* mgt = (LAS unsigned*)(F.lds + 1024);
    LAS unsigned* meq = (LAS unsigned*)(F.lds + 1024 + 8192);
    const int t0 = rg * 16, wid = F.wave, lane = F.lane, qj = lane & 15, g4 = lane >> 4;
    const int n64 = ((t0 >> 8) + 1) * 4;
    if (rg < 16) {
        for (int idx = F.tid; idx < 16 * n64; idx += NTHR) { const int row = idx & 15, j64 = idx >> 4, t = t0 + row; const int rel = t - 64 * j64;
            const u64 mk = rel >= 63 ? ~0ull : (rel < 0 ? 0ull : ((1ull << (rel + 1)) - 1ull));
            maskT[((size_t)b * 64 + j64) * SEQ + t] = mk; }
        return;
    }
    for (int i = F.tid; i < 4096; i += NTHR) mgt[i] = 0u;
    const size_t qrow = (size_t)b * SEQ + t0 + qj;
    float wq[8];
    { const f32x4 w0 = *(const f32x4*)(IW + qrow * 8), w1 = *(const f32x4*)(IW + qrow * 8 + 4); const float sc = 0.04419417382415922f;
      wq[0] = w0[0] * sc; wq[1] = w0[1] * sc; wq[2] = w0[2] * sc; wq[3] = w0[3] * sc; wq[4] = w1[0] * sc; wq[5] = w1[1] * sc; wq[6] = w1[2] * sc; wq[7] = w1[3] * sc; }
    const int ntile = rg + 1;
    const char* kbase = (const char*)IK + ((size_t)b * SEQ + wid * 16) * 128; const unsigned loff = (unsigned)(qj * 128 + g4 * 16);
    unsigned sc[32][4];
#pragma unroll
    for (int hp = 0; hp < 2; ++hp) {
        bf16x8 Bq[4][2];
#pragma unroll
        for (int h = 0; h < 4; ++h)
#pragma unroll
            for (int ks = 0; ks < 2; ++ks) Bq[h][ks] = *(const bf16x8*)(IQ + qrow * 512 + (4 * hp + h) * 64 + ks * 32 + g4 * 8);
#pragma unroll
        for (int j = 0; j < 32; ++j) {
            const int tile = wid + 8 * j;
            if (tile < ntile) {
                const char* kp = kbase + (size_t)j * 16384;
                const bf16x8 A0 = *(const bf16x8*)(kp + loff), A1 = *(const bf16x8*)(kp + loff + 64);
                f32x4 s = {0.f, 0.f, 0.f, 0.f};
                if (hp) {
#pragma unroll
                    for (int i = 0; i < 4; ++i) s[i] = __uint_as_float(sc[j][i]); }
#pragma unroll
                for (int h = 0; h < 4; ++h) { f32x4 a = __builtin_amdgcn_mfma_f32_16x16x32_bf16(A0, Bq[h][0], (f32x4){0.f, 0.f, 0.f, 0.f}, 0, 0, 0);
                    a = __builtin_amdgcn_mfma_f32_16x16x32_bf16(A1, Bq[h][1], a, 0, 0, 0);
#pragma unroll
                    for (int i = 0; i < 4; ++i) s[i] += wq[4 * hp + h] * fmaxf(a[i], 0.f); }
                if (hp == 1) {
                    if (tile == rg) {
#pragma unroll
                        for (int i = 0; i < 4; ++i) if (4 * g4 + i > qj) s[i] = -__builtin_inff(); }
#pragma unroll
                    for (int i = 0; i < 4; ++i) sc[j][i] = fkey(s[i]);
                } else {
#pragma unroll
                    for (int i = 0; i < 4; ++i) sc[j][i] = __float_as_uint(s[i]);
                }
            } else {
#pragma unroll
                for (int i = 0; i < 4; ++i) sc[j][i] = 0u;
            }
            asm volatile("" ::: "memory");
        }
    }
    unsigned prefix = 0u;
    for (int bit = 31; bit >= 0; --bit) {
        const unsigned cand = prefix | (1u << bit); unsigned c = 0u;
#pragma unroll
        for (int j = 0; j < 32; ++j)
#pragma unroll
            for (int i = 0; i < 4; ++i) c += (sc[j][i] >= cand) ? 1u : 0u;
        c += __shfl_xor(c, 16); c += __shfl_xor(c, 32);
        if (lane < 16) cnt[(bit & 1) * 128 + wid * 16 + lane] = c;
        __syncthreads();
        unsigned tot = 0u;
#pragma unroll
        for (int w = 0; w < 8; ++w) tot += cnt[(bit & 1) * 128 + w * 16 + qj];
        if (tot >= (unsigned)TOPK) prefix = cand;
    }
    const unsigned T = prefix;
    unsigned cg = 0u;
#pragma unroll
    for (int j = 0; j < 32; ++j)
#pragma unroll
        for (int i = 0; i < 4; ++i) cg += (sc[j][i] > T) ? 1u : 0u;
    cg += __shfl_xor(cg, 16); cg += __shfl_xor(cg, 32);
    __syncthreads();
    if (lane < 16) cnt[wid * 16 + lane] = cg;
    LAS unsigned* mbase = mgt + qj * 128 + (wid >> 1); const int sh0 = (wid & 1) * 16 + 4 * g4;
#pragma unroll
    for (int j = 0; j < 32; ++j) {
        const int tile = wid + 8 * j;
        if (tile < ntile) {
            unsigned g = 0u, e = 0u;
#pragma unroll
            for (int i = 0; i < 4; ++i) { g |= (sc[j][i] > T ? 1u : 0u) << i; e |= (sc[j][i] == T ? 1u : 0u) << i; }
            if (g) __hip_atomic_fetch_or(mbase + 4 * j, g << sh0, __ATOMIC_RELAXED, __HIP_MEMORY_SCOPE_WORKGROUP);
            if (e) __hip_atomic_fetch_or(mbase + 2048 + 4 * j, e << sh0, __ATOMIC_RELAXED, __HIP_MEMORY_SCOPE_WORKGROUP);
        }
    }
    __syncthreads();
    if (wid == 0 && lane < 16) {
        unsigned gt = 0u;
#pragma unroll
        for (int w = 0; w < 8; ++w) gt += cnt[w * 16 + lane];
        int need = TOPK - (int)gt, taken = 0; const int nw = (t0 + 16 + 31) >> 5;
        for (int wd = 0; wd < nw; ++wd) { unsigned e = meq[lane * 128 + wd]; if (!e) continue; int c = __popc(e);
            if (taken + c > need) { unsigned keep = 0u; int rem = need - taken; while (rem > 0) { const unsigned low = e & (0u - e); keep |= low; e ^= low; --rem; } e = keep; c = __popc(keep); }
            taken += c; mgt[lane * 128 + wd] |= e; }
    }
    __syncthreads();
    for (int idx = F.tid; idx < 16 * n64; idx += NTHR) { const int row = idx & 15, j64 = idx >> 4;
        const u64 mk = (u64)mgt[row * 128 + 2 * j64] | ((u64)mgt[row * 128 + 2 * j64 + 1] << 32);
        maskT[((size_t)b * 64 + j64) * SEQ + t0 + row] = mk; }
    __syncthreads();
}
__device__ __forceinline__ void ph_idx(Frame& F) {
    for (int c = F.bid; c < 256; c += F.G) { const int b = c & 3, base = c >> 2;
        idx_item(F, b, 255 - base); idx_item(F, b, 128 + base); idx_item(F, b, 127 - base); idx_item(F, b, base); }
}
namespace att {
constexpr int HD = 128, RS = 1024;
constexpr float SCALE = 0.08838834764831845f, THR = 8.f;
constexpr int NW = 8, QBLK = 32, KVBLK = 64, QB = NW * QBLK;
constexpr int SHM_V = KVBLK * HD * 2, SHM_K = KVBLK * HD * 2;
constexpr int LDS_ATT = 2 * SHM_V + 2 * SHM_K + NW * 64 * 4;
constexpr int LDS_TB = LDS_ATT;
typedef float f32x16 __attribute__((ext_vector_type(16)));
#define KSWZ(row, colB) ((row) * 256 + ((colB) ^ (((row) & 7) << 4)))
#define SBAR() __builtin_amdgcn_sched_barrier(0)
__device__ __forceinline__ int v_st(int k, int c) { const int kk = (k & ~0xC) | ((k & 4) << 1) | ((k & 8) >> 1); return ((kk >> 3) * 4 + (c >> 5)) * 512 + ((kk & 7) * 32 + (c & 31)) * 2; }
__device__ __forceinline__ int v_rd_base(int lane) { return ((lane & 3) << 3) | (((lane >> 2) & 3) << 6) | (((lane >> 4) & 1) << 5) | (((lane >> 5) & 1) << 8); }
constexpr int v_rd_off(int d0, int ks, int half) { return d0 * 512 + ks * 4096 + half * 2048; }
__device__ __forceinline__ int crow(int r, int hi) { return (r & 3) + 8 * (r >> 2) + 4 * hi; }
__device__ __forceinline__ bf16x8 load8(const bf16_t* p) { return *reinterpret_cast<const bf16x8*>(p); }
__device__ __forceinline__ void mask_bits(f32x16& p0, f32x16& p1, u64 mk, int hi) {
    const unsigned lo = (unsigned)mk >> (4 * hi), hh = (unsigned)(mk >> 32) >> (4 * hi);
#pragma unroll
    for (int r = 0; r < 16; ++r) { const int c = (r & 3) + 8 * (r >> 2);
        const unsigned m0 = (unsigned)((int)(lo << (31 - c)) >> 31), m1 = (unsigned)((int)(hh << (31 - c)) >> 31);
        p0[r] = __uint_as_float((__float_as_uint(p0[r]) & m0) | (0xff800000u & ~m0));
        p1[r] = __uint_as_float((__float_as_uint(p1[r]) & m1) | (0xff800000u & ~m1)); }
}
__device__ __forceinline__ void add_bias(f32x16& p0, f32x16& p1, const LAS float* tbq) {
#pragma unroll
    for (int r = 0; r < 16; ++r) { const int c = (r & 3) + 8 * (r >> 2); p0[r] += tbq[-c]; p1[r] += tbq[-c - 32]; }
}
__device__ __forceinline__ void partialSM(f32x16& p0, f32x16& p1, float& m_reg, float& mn, float& alpha) {
    float pmax = p0[0]; for (int r = 1; r < 16; ++r) pmax = fmaxf(pmax, p0[r]); for (int r = 0; r < 16; ++r) pmax = fmaxf(pmax, p1[r]);
    { auto rr = __builtin_amdgcn_permlane32_swap(__float_as_uint(pmax), __float_as_uint(pmax), false, false);
      pmax = fmaxf(__uint_as_float(rr[0]), __uint_as_float(rr[1])); }
    constexpr float C2 = 1.4426950408889634f * SCALE;
    if (__builtin_expect(__all((pmax - m_reg) * SCALE <= THR), 1)) { mn = m_reg; alpha = 1.f; }
    else { mn = fmaxf(m_reg, pmax); alpha = __builtin_amdgcn_exp2f((m_reg - mn) * C2); m_reg = mn; }
    const float mnL = -mn * C2;
    for (int r = 0; r < 16; ++r) p0[r] = fmaf(p0[r], C2, mnL); for (int r = 0; r < 16; ++r) p1[r] = fmaf(p1[r], C2, mnL);
    for (int r = 0; r < 16; ++r) p0[r] = __builtin_amdgcn_exp2f(p0[r]);
}
__device__ __forceinline__ void finishSM(f32x16& p0, f32x16& p1, float alpha, float& l_reg, bf16x8& pa0, bf16x8& pa1, bf16x8& pa2, bf16x8& pa3) {
    for (int r = 0; r < 16; ++r) p1[r] = __builtin_amdgcn_exp2f(p1[r]);
    float ps = 0; for (int r = 0; r < 16; ++r) ps += p0[r]; for (int r = 0; r < 16; ++r) ps += p1[r];
    { auto rr = __builtin_amdgcn_permlane32_swap(__float_as_uint(ps), __float_as_uint(ps), false, false);
      ps = __uint_as_float(rr[0]) + __uint_as_float(rr[1]); }
    l_reg = l_reg * alpha + ps;
#define PK4(P, B_, OUT) do { unsigned a0 = cvt_pk_bf16(P[B_+0], P[B_+1]), a1 = cvt_pk_bf16(P[B_+2], P[B_+3]);                          \
        unsigned b0 = cvt_pk_bf16(P[B_+4], P[B_+5]), b1 = cvt_pk_bf16(P[B_+6], P[B_+7]);                                             \
        auto r0 = __builtin_amdgcn_permlane32_swap(a0, b0, false, false); auto r1 = __builtin_amdgcn_permlane32_swap(a1, b1, false, false); \
        u32x4 w = {r0[0], r1[0], r0[1], r1[1]}; OUT = *reinterpret_cast<bf16x8*>(&w); } while (0)
    PK4(p0, 0, pa0); PK4(p0, 8, pa1); PK4(p1, 0, pa2); PK4(p1, 8, pa3);
#undef PK4
}
template <int KB>
__device__ __forceinline__ void qkt(f32x16& p0, f32x16& p1, const char* K_lds, int r32, int hi, const bf16x8* qr) {
    p0 = f32x16{}; p1 = f32x16{};
    const char* kb[4];
#pragma unroll
    for (int dd = 0; dd < 4; ++dd) kb[dd] = K_lds + KB * SHM_K + KSWZ(r32, (dd * 16 + hi * 8) * 2);
#pragma unroll
    for (int d0 = 0; d0 < 8; ++d0) { const char* a = kb[d0 & 3] + (d0 >> 2) * 128;
        bf16x8 b0 = *reinterpret_cast<const bf16x8*>(a);
        bf16x8 b1 = *reinterpret_cast<const bf16x8*>(a + 32 * 256);
        p0 = __builtin_amdgcn_mfma_f32_32x32x16_bf16(b0, qr[d0], p0, 0, 0, 0);
        p1 = __builtin_amdgcn_mfma_f32_32x32x16_bf16(b1, qr[d0], p1, 0, 0, 0); }
}
template <int VB>
__device__ __forceinline__ void pv_tile(f32x16* o, int vb0, bf16x8 pa0, bf16x8 pa1, bf16x8 pa2, bf16x8 pa3) {
#define TRRD(dst, off) asm volatile("ds_read_b64_tr_b16 %0, %1 offset:%2" : "=&v"(dst) : "v"(vb0), "i"(off) : "memory")
#define PV_D0(d0) do { s16x4 l0, l1, h0, h1; constexpr int b_ = VB * SHM_V + v_rd_off(d0, 0, 0); \
        TRRD(l0, b_); TRRD(h0, b_ + 2048); TRRD(l1, b_ + 4096); TRRD(h1, b_ + 6144); \
        asm volatile("s_waitcnt lgkmcnt(0)" ::: "memory"); SBAR();   \
        o[d0] = __builtin_amdgcn_mfma_f32_32x32x16_bf16(pa0, (bf16x8){l0[0], l0[1], l0[2], l0[3], h0[0], h0[1], h0[2], h0[3]}, o[d0], 0, 0, 0);   \
        o[d0] = __builtin_amdgcn_mfma_f32_32x32x16_bf16(pa1, (bf16x8){l1[0], l1[1], l1[2], l1[3], h1[0], h1[1], h1[2], h1[3]}, o[d0], 0, 0, 0);   \
        SBAR(); TRRD(l0, b_ + 8192); TRRD(h0, b_ + 10240); TRRD(l1, b_ + 12288); TRRD(h1, b_ + 14336); \
        asm volatile("s_waitcnt lgkmcnt(0)" ::: "memory"); SBAR();   \
        o[d0] = __builtin_amdgcn_mfma_f32_32x32x16_bf16(pa2, (bf16x8){l0[0], l0[1], l0[2], l0[3], h0[0], h0[1], h0[2], h0[3]}, o[d0], 0, 0, 0);   \
        o[d0] = __builtin_amdgcn_mfma_f32_32x32x16_bf16(pa3, (bf16x8){l1[0], l1[1], l1[2], l1[3], h1[0], h1[1], h1[2], h1[3]}, o[d0], 0, 0, 0); } while (0)
    PV_D0(0); PV_D0(1); PV_D0(2); PV_D0(3);
#undef PV_D0
#undef TRRD
}
struct BlockRef { const bf16_t* Q; const bf16_t* K; const bf16_t* V; bf16_t* O; const u64* MK; int P0; int h; };
struct Seam { bf16x8 qr[8]; bf16x8 st_v0, st_v1, st_k0, st_k1; };
#define LD16U(base, off) (*(const bf16x8*)((const char*)(base) + (off)))
#define VMW() asm volatile("s_waitcnt vmcnt(0)" ::: "memory")
#define TIDL() ({ int t__ = threadIdx.x; asm volatile("" : "+v"(t__)); t__; })
#define SLOAD_H(Kp, Vp, k0) do { const int t_ = TIDL(); const unsigned klo_ = (unsigned)((t_ >> 4) * RS + (t_ & 15) * 8) * 2u;   \
        const char* kb_ = (const char*)(Kp) + (size_t)(k0) * (RS * 2); const char* vb_ = (const char*)(Vp) + (size_t)(k0) * (RS * 2);   \
        S.st_v0 = LD16U(vb_, klo_); S.st_v1 = LD16U(vb_ + 32 * RS * 2, klo_); S.st_k0 = LD16U(kb_, klo_); S.st_k1 = LD16U(kb_ + 32 * RS * 2, klo_); } while (0)
#define SWRITE_HK(bf) do { const int t_ = TIDL(); const int kws_ = KSWZ(t_ >> 4, (t_ & 15) * 16); *(bf16x8*)(K_lds + (bf) * SHM_K + kws_) = S.st_k0; *(bf16x8*)(K_lds + (bf) * SHM_K + kws_ + 32 * 256) = S.st_k1; } while (0)
#define SWRITE_HV(bf) do { const int t_ = TIDL(); const int sr_ = t_ >> 4, sc_ = (t_ & 15) * 8; *(bf16x8*)(V_lds + (bf) * SHM_V + v_st(sr_, sc_)) = S.st_v0; *(bf16x8*)(V_lds + (bf) * SHM_V + v_st(32 + sr_, sc_)) = S.st_v1; } while (0)
#define SWRITE_H(bf) do { SWRITE_HV(bf); SWRITE_HK(bf); } while (0)
#define QLOAD(Qp) do { const int t_ = TIDL(); const unsigned qlo_ = (unsigned)((t_ & 31) * RS + ((t_ >> 5) & 1) * 8) * 2u; const char* qb_ = (const char*)(Qp) + (size_t)(wid * QBLK) * (RS * 2); \
        _Pragma("unroll") for (int d0 = 0; d0 < 8; ++d0) S.qr[d0] = LD16U(qb_ + d0 * 32, qlo_); } while (0)
__device__ __forceinline__ void att_prime(const BlockRef& cur, char* lds, Seam& S) {
    const int tid = threadIdx.x, wid = __builtin_amdgcn_readfirstlane(tid >> 6); char* K_lds = lds + 2 * SHM_V;
    QLOAD(cur.Q);
    SLOAD_H(cur.K, cur.V, 0); VMW(); SWRITE_HK(0);
    __syncthreads();
}
__device__ __forceinline__ void att_block(const BlockRef& cur, const BlockRef& nxt, char* lds, const LAS float* tbl, Seam& S) {
    const int tid = threadIdx.x, wid = __builtin_amdgcn_readfirstlane(tid >> 6), lane = tid & 63, r32 = lane & 31, hi = lane >> 5;
    const int NT = cur.P0 / KVBLK + 4;
    const int qlo = cur.P0 + wid * QBLK, qm = qlo + r32 - 4 * hi;
    char* V_lds = lds; char* K_lds = lds + 2 * SHM_V;
    float* ws = (float*)(lds + 2 * SHM_V + 2 * SHM_K) + wid * 64; float* li_l = ws, * al_l = ws + 32;
    float m_reg = -1e30f, l_reg = 0; f32x16 o[4] = {};
    const int vb0 = (int)(uintptr_t)V_lds + v_rd_base(lane);
    const bf16_t* Kh = cur.K; const bf16_t* Vh = cur.V;
    const char* mkb = (const char*)(cur.MK + qlo);
#define LDMK(j) (*(const u64*)(mkb + (size_t)(j) * (SEQ * 8) + (unsigned)(TIDL() & 31) * 8u))
#define RESC(a) do { if (__any((a) < 1.f)) { if (hi == 0) al_l[r32] = (a); asm volatile("s_waitcnt lgkmcnt(0)" ::: "memory");              \
                     for (int d_ = 0; d_ < 4; ++d_) for (int r = 0; r < 16; ++r) o[d_][r] *= al_l[crow(r, hi)]; } } while (0)
#define KBASE(t) ((t) * KVBLK)
#define MASKT(P0_, P1_, t, MK_) do { const int kb_ = KBASE(t); if (kb_ + 176 > qlo) add_bias(P0_, P1_, tbl + cur.h * 512 + 256 + (qm - kb_)); mask_bits(P0_, P1_, MK_, hi); } while (0)
#define VMWN8() asm volatile("s_waitcnt vmcnt(8)" ::: "memory")
#define SEAM_K0() do { VMWN8(); SWRITE_HK(0); SBAR(); } while (0)
    f32x16 pA0, pA1, pB0, pB1; float mnA, mnB, alA, alB; bf16x8 pa0, pa1, pa2, pa3;
    u64 mk_ = LDMK(0);
    SWRITE_HV(0); SBAR();
    SLOAD_H(Kh, Vh, KBASE(1));
    SBAR(); qkt<0>(pA0, pA1, K_lds, r32, hi, S.qr);
    MASKT(pA0, pA1, 0, mk_); partialSM(pA0, pA1, m_reg, mnA, alA);
    VMW(); SWRITE_H(1);
    __syncthreads();
#define HALF_STEP(PX0, PX1, mnX, alX, PY0, PY1, alY, t, KB, VB, SB) do {                                                      \
        mk_ = LDMK(t); SBAR(); qkt<KB>(PX0, PX1, K_lds, r32, hi, S.qr);                                                                      \
        finishSM(PY0, PY1, alY, l_reg, pa0, pa1, pa2, pa3); SBAR();                                                           \
        if ((t) + 1 < NT) { SLOAD_H(Kh, Vh, KBASE((t) + 1)); SBAR(); }                                                        \
        pv_tile<VB>(o, vb0, pa0, pa1, pa2, pa3); MASKT(PX0, PX1, (t), mk_);                                                   \
        partialSM(PX0, PX1, m_reg, mnX, alX);                                                                                 \
        __syncthreads();                                                                                                      \
        if ((t) + 1 < NT) { VMW(); SWRITE_H(SB); }                                                                            \
        RESC(alX); __syncthreads(); } while (0)
    for (int t = 1; t + 1 < NT; t += 2) {
        HALF_STEP(pB0, pB1, mnB, alB, pA0, pA1, alA, t, 1, 0, 0);
        HALF_STEP(pA0, pA1, mnA, alA, pB0, pB1, alB, t + 1, 0, 1, 1);
    }
    mk_ = LDMK(NT - 1); SBAR(); qkt<1>(pB0, pB1, K_lds, r32, hi, S.qr); SBAR();
    SLOAD_H(nxt.K, nxt.V, 0); SBAR();
    QLOAD(nxt.Q);
    SBAR();
    finishSM(pA0, pA1, alA, l_reg, pa0, pa1, pa2, pa3); SBAR();
    pv_tile<0>(o, vb0, pa0, pa1, pa2, pa3);
    MASKT(pB0, pB1, NT - 1, mk_); partialSM(pB0, pB1, m_reg, mnB, alB); __syncthreads(); RESC(alB);
    finishSM(pB0, pB1, alB, l_reg, pa0, pa1, pa2, pa3); SBAR(); pv_tile<1>(o, vb0, pa0, pa1, pa2, pa3);
    SBAR(); SEAM_K0();
    if (hi == 0) li_l[r32] = l_reg; asm volatile("s_waitcnt lgkmcnt(0)" ::: "memory");
    float rli[16];
#pragma unroll
    for (int r = 0; r < 16; ++r) rli[r] = __builtin_amdgcn_rcpf(li_l[crow(r, hi)]);
    char* Ow = (char*)cur.O + (size_t)(wid * QBLK) * (RS * 2); const unsigned olo = (unsigned)(4 * ((TIDL() >> 5) & 1) * RS + (TIDL() & 31)) * 2u;
#pragma unroll
    for (int r = 0; r < 16; ++r) { const int orow0 = (r & 3) + 8 * (r >> 2);
#pragma unroll
        for (int d0 = 0; d0 < 4; ++d0) { const float v = o[d0][r] * rli[r]; const float vn = __shfl_xor(v, 1);
            if ((r32 & 1) == 0) *(unsigned*)(Ow + (size_t)orow0 * (RS * 2) + d0 * 64 + olo) = cvt_pk_bf16(v, vn); } }
    __syncthreads();
#undef LDMK
#undef RESC
#undef KBASE
#undef MASKT
#undef VMWN8
#undef SEAM_K0
#undef HALF_STEP
}
#undef LD16U
#undef VMW
#undef SLOAD_H
#undef SWRITE_HK
#undef SWRITE_HV
#undef SWRITE_H
#undef QLOAD
#undef TIDL
}
__device__ __forceinline__ void ph_att(Frame& F, char* lds) {
    const bf16_t* QA = (const bf16_t*)(F.ws + WS_P + P_QA); const bf16_t* KA = (const bf16_t*)(F.ws + WS_P + P_KA); const bf16_t* VA = (const bf16_t*)(F.ws + WS_P + P_VA);
    bf16_t* OA = (bf16_t*)(F.ws + WS_OA); const u64* maskT = (const u64*)(F.ws + WS_MASK); const float* tbg = (const float*)(F.ws + WS_TB);
    LAS float* tbl = (LAS float*)(F.lds + att::LDS_TB);
    for (int i = F.tid; i < 8 * 512; i += NTHR) { const int rel = (i & 511) - 256; tbl[i] = (rel >= 0 && rel < 128) ? tbg[(i >> 9) * 128 + rel] : 0.f; }
    __syncthreads();
    for (int c = F.bid; c < 256; c += F.G) {
        const int b = c >> 6, h = (c >> 3) & 7, x = c & 7;
        att::BlockRef r0, r1;
        { const int xb = 15 - x; const size_t ro = ((size_t)b * SEQ + 256 * xb) * 1024 + h * 128;
          r0.Q = QA + ro; r0.O = OA + ro; r0.K = KA + (size_t)b * SEQ * 1024 + h * 128; r0.V = VA + (size_t)b * SEQ * 1024 + h * 128; r0.MK = maskT + (size_t)b * 64 * SEQ; r0.P0 = 256 * xb; r0.h = h; }
        { const int xb = x; const size_t ro = ((size_t)b * SEQ + 256 * xb) * 1024 + h * 128;
          r1 = r0; r1.Q = QA + ro; r1.O = OA + ro; r1.P0 = 256 * xb; }
        att::Seam S;
        att::att_prime(r0, lds, S);
        for (int k = 0; k < 2; ++k) { att::att_block(r0, r1, lds, tbl, S); r0 = r1; }
    }
}
__device__ __forceinline__ f32x4 mfma16(bf16x8 a, bf16x8 b, f32x4 c) { return __builtin_amdgcn_mfma_f32_16x16x32_bf16(a, b, c, 0, 0, 0); }
__device__ __forceinline__ void ph_hprep(Frame& F) {
    bf16_t* BQ = (bf16_t*)(F.ws + WS_P + P_BQ); bf16_t* BG = (bf16_t*)(F.ws + WS_P + P_BG);
    bf16_t* HA = (bf16_t*)(F.ws + WS_HA); float* HDEC = (float*)(F.ws + WS_HDEC);
    LAS float* wsum = (LAS float*)F.lds;
    LAS unsigned char* qt = F.lds + 4096;
    LAS unsigned char* kt = F.lds + 4096 + 64 * 272;
    const int w = F.wave, lane = F.lane, cp = lane;
    for (int it = F.bid; it < 2048; it += F.G) {
        const int bh = it >> 6, ch = it & 63, b = bh >> 3, h = bh & 7;
        const size_t base = ((size_t)b * SEQ + ch * 64 + 8 * w) * 1024 + h * 128 + 2 * cp;
        float g0[8], g1[8], q0[8], q1[8];
#pragma unroll
        for (int r = 0; r < 8; ++r) { const unsigned gw = *(const unsigned*)(BG + base + (size_t)r * 1024), qw = *(const unsigned*)(BQ + base + (size_t)r * 1024);
            g0[r] = bflo(gw); g1[r] = bfhi(gw); q0[r] = bflo(qw); q1[r] = bfhi(qw); }
        float c0 = 0.f, c1 = 0.f, bl0[8], bl1[8];
#pragma unroll
        for (int r = 0; r < 8; ++r) { c0 += g0[r]; c1 += g1[r]; bl0[r] = c0; bl1[r] = c1; }
        wsum[w * 128 + 2 * cp] = c0; wsum[w * 128 + 2 * cp + 1] = c1;
        __syncthreads();
        float off0 = 0.f, off1 = 0.f, mid0 = 0.f, mid1 = 0.f, last0 = 0.f, last1 = 0.f;
#pragma unroll
        for (int ww = 0; ww < 8; ++ww) { const float s0 = wsum[ww * 128 + 2 * cp], s1 = wsum[ww * 128 + 2 * cp + 1];
            if (ww < w) { off0 += s0; off1 += s1; } if (ww < 4) { mid0 += s0; mid1 += s1; } last0 += s0; last1 += s1; }
#pragma unroll
        for (int r = 0; r < 8; ++r) {
            const float b0 = bl0[r] + off0, b1 = bl1[r] + off1;
            const float k0 = 1.f - __expf(g0[r]), k1 = 1.f - __expf(g1[r]);
            *(unsigned*)(BQ + base + (size_t)r * 1024) = cvt_pk_bf16(q0[r] * __expf(b0), q1[r] * __expf(b1));
            *(unsigned*)(BG + base + (size_t)r * 1024) = cvt_pk_bf16(k0 * __expf(last0 - b0), k1 * __expf(last1 - b1));
            *(LAS unsigned*)(qt + (8 * w + r) * 272 + 4 * cp) = cvt_pk_bf16(q0[r] * __expf(b0 - mid0), q1[r] * __expf(b1 - mid1));
            *(LAS unsigned*)(kt + (8 * w + r) * 272 + 4 * cp) = cvt_pk_bf16(k0 * __expf(mid0 - b0), k1 * __expf(mid1 - b1));
        }
        if (w == 0) { HDEC[(size_t)it * 128 + 2 * cp] = __expf(last0); HDEC[(size_t)it * 128 + 2 * cp + 1] = __expf(last1); }
        __syncthreads();
        { const int tt = w & 3, fr = lane & 15, g4 = lane >> 4;
          bf16x8 qf[4];
#pragma unroll
          for (int ks = 0; ks < 4; ++ks) qf[ks] = *(const LAS bf16x8*)(qt + (16 * tt + fr) * 272 + (32 * ks + 8 * g4) * 2);
#pragma unroll
          for (int si = 0; si < 2; ++si) { const int st = 2 * (w >> 2) + si; f32x4 acc = {0.f, 0.f, 0.f, 0.f};
#pragma unroll
              for (int ks = 0; ks < 4; ++ks) { const bf16x8 kf = *(const LAS bf16x8*)(kt + (16 * st + fr) * 272 + (32 * ks + 8 * g4) * 2); acc = mfma16(kf, qf[ks], acc); }
              const int t = 16 * tt + fr, s0 = 16 * st + 4 * g4;
              float x[4];
#pragma unroll
              for (int i = 0; i < 4; ++i) x[i] = (s0 + i <= t) ? acc[i] : 0.f;
              u32x2 o; o.x = cvt_pk_bf16(x[0], x[1]); o.y = cvt_pk_bf16(x[2], x[3]);
              *(u32x2*)(HA + ((size_t)it * 64 + t) * 64 + s0) = o; } }
        __syncthreads();
    }
}
__device__ __forceinline__ void ph_rprep(Frame& F) {
    const bf16_t* CQ = (const bf16_t*)(F.ws + WS_P + P_CQ); const bf16_t* CK = (const bf16_t*)(F.ws + WS_P + P_CK); bf16_t* RA = (bf16_t*)(F.ws + WS_RA);
    const int w = F.wave, lane = F.lane, fr = lane & 15, g4 = lane >> 4;
    for (int it = F.bid; it < 512; it += F.G) {
        const int bh = it >> 5, ch = it & 31, b = bh >> 2, h = bh & 3;
        const size_t base = ((size_t)b * SEQ + ch * 128) * 1024 + h * 256;
        const float gi = exp2f(-128.f * __log2f(1.f - exp2f(-5.f - (float)h)));
        bf16x8 qf[8];
#pragma unroll
        for (int ks = 0; ks < 8; ++ks) qf[ks] = *(const bf16x8*)(CQ + base + (size_t)(16 * w + fr) * 1024 + 32 * ks + 8 * g4);
        for (int st = 0; st < 8; ++st) {
            u32x2 o = {0u, 0u};
            const int t = 16 * w + fr, s0 = 16 * st + 4 * g4;
            if (st <= w) { f32x4 acc = {0.f, 0.f, 0.f, 0.f};
#pragma unroll
                for (int ks = 0; ks < 8; ++ks) { const bf16x8 kf = *(const bf16x8*)(CK + base + (size_t)(16 * st + fr) * 1024 + 32 * ks + 8 * g4); acc = mfma16(kf, qf[ks], acc); }
                float x[4];
#pragma unroll
                for (int i = 0; i < 4; ++i) x[i] = (s0 + i <= t) ? acc[i] * gi : 0.f;
                o.x = cvt_pk_bf16(x[0], x[1]); o.y = cvt_pk_bf16(x[2], x[3]); }
            *(u32x2*)(RA + ((size_t)it * 128 + t) * 128 + s0) = o;
        }
    }
}
template <int OFF> __device__ __forceinline__ s16x4 trrd(unsigned addr) { s16x4 r; asm volatile("ds_read_b64_tr_b16 %0, %1 offset:%2" : "=&v"(r) : "v"(addr), "i"(OFF) : "memory"); return r; }
__device__ __forceinline__ bf16x8 cat8(s16x4 a, s16x4 b) { return (bf16x8){a[0], a[1], a[2], a[3], b[0], b[1], b[2], b[3]}; }
template <int C, int DK, int LDQ, int LDV, bool VEC>
__device__ __forceinline__ void scan_item(LAS unsigned char* lds, int tid, int w, int lane, const bf16_t* Q, const bf16_t* Kt, const bf16_t* V, const bf16_t* A, const float* dec, float cdec, bf16_t* O, int nchunk) {
    constexpr int RSK = DK * 2 + 32, RSV = 72, RST = DK * 2 + 16;
    constexpr int KL = 0, VL = C * RSK, ST0 = VL + C * RSV, STB = 32 * RST;
    constexpr int NPK = C * DK / 8 / NTHR;
    constexpr int NKS_C = C / 32, NKS_D = DK / 32;
    constexpr int NDT = DK / 16 / 8;
    const int fr = lane & 15, g4 = lane >> 4, q4 = fr >> 2, p4 = lane & 3;
    const bool ow = w < C / 16;
    const int rt = ow ? w : 0;
    const unsigned ldsb = (unsigned)(uintptr_t)lds;
    const unsigned vtr = ldsb + VL + (8 * g4 + q4) * RSV + 8 * p4;
    const unsigned ktr = ldsb + KL + (8 * g4 + q4) * RSK + 8 * p4 + w * NDT * 32;
    f32x4 S[NDT][2];
#pragma unroll
    for (int i = 0; i < NDT; ++i) { S[i][0] = (f32x4){0.f, 0.f, 0.f, 0.f}; S[i][1] = (f32x4){0.f, 0.f, 0.f, 0.f}; }
    u32x4 kst[NPK], vst = {0u, 0u, 0u, 0u}; bf16x8 qf[NKS_D], af[NKS_C];
    const int vrow = tid >> 2, vpc = tid & 3;
    const unsigned klo = (unsigned)((tid / (DK / 8)) * LDQ + (tid % (DK / 8)) * 8) * 2u;
    const unsigned vlo = (unsigned)(vrow * LDV + vpc * 8) * 2u, qlo = (unsigned)(fr * LDQ + 8 * g4) * 2u, alo = (unsigned)(fr * C + 8 * g4) * 2u, olo = (unsigned)(fr * LDV + 4 * g4) * 2u;
    const unsigned klds = (unsigned)((tid / (DK / 8)) * RSK + (tid % (DK / 8)) * 16);
    constexpr int KROWS = NTHR / (DK / 8);
#define SC_LOADK(cc) do { const char* kb_ = (const char*)Kt + (size_t)(cc) * (C * LDQ * 2); _Pragma("unroll") for (int i = 0; i < NPK; ++i) kst[i] = *(const u32x4*)(kb_ + (size_t)i * (KROWS * LDQ * 2) + klo); \
        if (vrow < C) vst = *(const u32x4*)((const char*)V + (size_t)(cc) * (C * LDV * 2) + vlo); } while (0)
#define SC_LOADQ(cc) do { const char* qb_ = (const char*)Q + ((size_t)(cc) * C + 16 * rt) * (LDQ * 2); const char* ab_ = (const char*)A + ((size_t)(cc) * C + 16 * rt) * (C * 2); \
        _Pragma("unroll") for (int ks = 0; ks < NKS_D; ++ks) qf[ks] = *(const bf16x8*)(qb_ + ks * 64 + qlo); \
        _Pragma("unroll") for (int ks = 0; ks < NKS_C; ++ks) af[ks] = *(const bf16x8*)(ab_ + ks * 64 + alo); } while (0)
    SC_LOADK(0); SC_LOADQ(0);
    for (int c = 0; c < nchunk; ++c) {
        LAS unsigned char* stb = lds + ST0 + (c & 1) * STB;
#pragma unroll
        for (int i = 0; i < NDT; ++i)
#pragma unroll
            for (int ct = 0; ct < 2; ++ct) { u32x2 o; o.x = cvt_pk_bf16(S[i][ct][0], S[i][ct][1]); o.y = cvt_pk_bf16(S[i][ct][2], S[i][ct][3]);
                *(LAS u32x2*)(stb + (16 * ct + fr) * RST + (16 * (w * NDT + i) + 4 * g4) * 2) = o; }
#pragma unroll
        for (int i = 0; i < NPK; ++i) *(LAS u32x4*)(lds + KL + klds + i * (KROWS * RSK)) = kst[i];
        if (vrow < C) { *(LAS u32x2*)(lds + VL + vrow * RSV + vpc * 16) = (u32x2){vst.x, vst.y}; *(LAS u32x2*)(lds + VL + vrow * RSV + vpc * 16 + 8) = (u32x2){vst.z, vst.w}; }
        f32x4 dv[NDT];
#pragma unroll
        for (int i = 0; i < NDT; ++i) dv[i] = VEC ? *(const f32x4*)(dec + (size_t)c * DK + 16 * (w * NDT + i) + 4 * g4) : (f32x4){cdec, cdec, cdec, cdec};
        __syncthreads();
        if (c + 1 < nchunk) SC_LOADK(c + 1);
        bf16x8 vf0[NKS_C], vf1[NKS_C];
#pragma unroll
        for (int ks = 0; ks < NKS_C; ++ks) { s16x4 a0, a1, b0, b1;
            asm volatile("ds_read_b64_tr_b16 %0, %4 offset:%5\n\tds_read_b64_tr_b16 %1, %4 offset:%6\n\tds_read_b64_tr_b16 %2, %4 offset:%7\n\tds_read_b64_tr_b16 %3, %4 offset:%8\n\ts_waitcnt lgkmcnt(0)"
                         : "=&v"(a0), "=&v"(a1), "=&v"(b0), "=&v"(b1) : "v"(vtr + ks * 32 * RSV), "i"(0), "i"(4 * RSV), "i"(32), "i"(4 * RSV + 32) : "memory");
            vf0[ks] = cat8(a0, a1); vf1[ks] = cat8(b0, b1); }
        if (ow) {
            f32x4 acc0 = {0.f, 0.f, 0.f, 0.f}, acc1 = {0.f, 0.f, 0.f, 0.f};
#pragma unroll
            for (int ks = 0; ks < NKS_C; ++ks) { acc0 = mfma16(vf0[ks], af[ks], acc0); acc1 = mfma16(vf1[ks], af[ks], acc1); }
#pragma unroll
            for (int ks = 0; ks < NKS_D; ++ks) { const bf16x8 s0 = *(const LAS bf16x8*)(stb + fr * RST + (32 * ks + 8 * g4) * 2), s1 = *(const LAS bf16x8*)(stb + (16 + fr) * RST + (32 * ks + 8 * g4) * 2);
                acc0 = mfma16(s0, qf[ks], acc0); acc1 = mfma16(s1, qf[ks], acc1); }
            u32x2 o0, o1; o0.x = cvt_pk_bf16(acc0[0], acc0[1]); o0.y = cvt_pk_bf16(acc0[2], acc0[3]); o1.x = cvt_pk_bf16(acc1[0], acc1[1]); o1.y = cvt_pk_bf16(acc1[2], acc1[3]);
            char* op = (char*)O + ((size_t)c * C + 16 * rt) * (LDV * 2) + olo;
            *(u32x2*)op = o0; *(u32x2*)(op + 32) = o1;
            if (c + 1 < nchunk) SC_LOADQ(c + 1);
        }
#pragma unroll
        for (int i = 0; i < NDT; ++i) { S[i][0] *= dv[i]; S[i][1] *= dv[i];
#pragma unroll
            for (int ks = 0; ks < NKS_C; ++ks) { s16x4 a0, a1;
                asm volatile("ds_read_b64_tr_b16 %0, %2 offset:0\n\tds_read_b64_tr_b16 %1, %2 offset:%3\n\ts_waitcnt lgkmcnt(0)" : "=&v"(a0), "=&v"(a1) : "v"(ktr + ks * 32 * RSK + i * 32), "i"(4 * RSK) : "memory");
                const bf16x8 kf = cat8(a0, a1);
                S[i][0] = mfma16(kf, vf0[ks], S[i][0]); S[i][1] = mfma16(kf, vf1[ks], S[i][1]); } }
        __syncthreads();
    }
#undef SC_LOADK
#undef SC_LOADQ
}
__device__ __forceinline__ void ph_scan_ret(Frame& F) {
    for (int it = F.bid; it < 256; it += F.G) { const int bh = it >> 4, vs = it & 15, b = bh >> 2, h = bh & 3;
        const size_t tok = (size_t)b * SEQ;
        scan_item<128, 256, 1024, 2048, false>(F.lds, F.tid, F.wave, F.lane, (const bf16_t*)(F.ws + WS_P + P_CQ) + tok * 1024 + h * 256, (const bf16_t*)(F.ws + WS_P + P_CK) + tok * 1024 + h * 256,
            (const bf16_t*)(F.ws + WS_P + P_CV) + tok * 2048 + h * 512 + vs * 32, (const bf16_t*)(F.ws + WS_RA) + (size_t)bh * 32 * 128 * 128, nullptr, exp2f(128.f * __log2f(1.f - exp2f(-5.f - (float)h))),
            (bf16_t*)(F.ws + WS_OC) + tok * 2048 + h * 512 + vs * 32, 32); }
}
__device__ __forceinline__ void ph_scan_hgrn(Frame& F) {
    for (int it = F.bid; it < 128; it += F.G) { const int bh = it >> 2, vs = it & 3, b = bh >> 3, h = bh & 7;
        const size_t tok = (size_t)b * SEQ;
        scan_item<64, 128, 1024, 1024, true>(F.lds, F.tid, F.wave, F.lane, (const bf16_t*)(F.ws + WS_P + P_BQ) + tok * 1024 + h * 128, (const bf16_t*)(F.ws + WS_P + P_BG) + tok * 1024 + h * 128,
            (const bf16_t*)(F.ws + WS_P + P_BV) + tok * 1024 + h * 128 + vs * 32, (const bf16_t*)(F.ws + WS_HA) + (size_t)bh * 64 * 64 * 64, (const float*)(F.ws + WS_HDEC) + (size_t)bh * 64 * 128, 0.f,
            (bf16_t*)(F.ws + WS_OB) + tok * 1024 + h * 128 + vs * 32, 64); }
}
__device__ __forceinline__ void ph_post(Frame& F, const float* ng  ) {
    bf16_t* OB = (bf16_t*)(F.ws + WS_OB); bf16_t* OC = (bf16_t*)(F.ws + WS_OC); const bf16_t* BO = (const bf16_t*)(F.ws + WS_P + P_BO); const bf16_t* CG = (const bf16_t*)(F.ws + WS_P + P_CG);
    const int gw = F.bid * NWAVES + F.wave, NGW = F.G * NWAVES, lane = F.lane;
    for (int row = gw; row < M; row += NGW) {
        {
          const u32x4 a0 = *(const u32x4*)(OB + (size_t)row * 1024 + 16 * lane), a1 = *(const u32x4*)(OB + (size_t)row * 1024 + 16 * lane + 8);
          const u32x4 g0 = *(const u32x4*)(BO + (size_t)row * 1024 + 16 * lane), g1 = *(const u32x4*)(BO + (size_t)row * 1024 + 16 * lane + 8);
          float x[16] = {bflo(a0.x), bfhi(a0.x), bflo(a0.y), bfhi(a0.y), bflo(a0.z), bfhi(a0.z), bflo(a0.w), bfhi(a0.w), bflo(a1.x), bfhi(a1.x), bflo(a1.y), bfhi(a1.y), bflo(a1.z), bfhi(a1.z), bflo(a1.w), bfhi(a1.w)};
          const float gg[16] = {bflo(g0.x), bfhi(g0.x), bflo(g0.y), bfhi(g0.y), bflo(g0.z), bfhi(g0.z), bflo(g0.w), bfhi(g0.w), bflo(g1.x), bfhi(g1.x), bflo(g1.y), bfhi(g1.y), bflo(g1.z), bfhi(g1.z), bflo(g1.w), bfhi(g1.w)};
          float ss = 0.f;
#pragma unroll
          for (int j = 0; j < 16; ++j) ss += x[j] * x[j];
          ss += __shfl_xor(ss, 1); ss += __shfl_xor(ss, 2); ss += __shfl_xor(ss, 4);
          const float r = rsqrtf(ss * (1.f / 128.f) + EPS); const int d0 = (16 * lane) & 127;
#pragma unroll
          for (int j = 0; j < 16; ++j) x[j] = x[j] * r * ng[d0 + j] * gg[j];
          pg8::st8(OB + (size_t)row * 1024 + 16 * lane, x); pg8::st8(OB + (size_t)row * 1024 + 16 * lane + 8, x + 8); }
#pragma unroll
        for (int half = 0; half < 2; ++half) {
          const size_t o = (size_t)row * 2048 + 1024 * half + 16 * lane;
          const u32x4 a0 = *(const u32x4*)(OC + o), a1 = *(const u32x4*)(OC + o + 8), g0 = *(const u32x4*)(CG + o), g1 = *(const u32x4*)(CG + o + 8);
          float x[16] = {bflo(a0.x), bfhi(a0.x), bflo(a0.y), bfhi(a0.y), bflo(a0.z), bfhi(a0.z), bflo(a0.w), bfhi(a0.w), bflo(a1.x), bfhi(a1.x), bflo(a1.y), bfhi(a1.y), bflo(a1.z), bfhi(a1.z), bflo(a1.w), bfhi(a1.w)};
          const float gg[16] = {bflo(g0.x), bfhi(g0.x), bflo(g0.y), bfhi(g0.y), bflo(g0.z), bfhi(g0.z), bflo(g0.w), bfhi(g0.w), bflo(g1.x), bfhi(g1.x), bflo(g1.y), bfhi(g1.y), bflo(g1.z), bfhi(g1.z), bflo(g1.w), bfhi(g1.w)};
          float ss = 0.f;
#pragma unroll
          for (int j = 0; j < 16; ++j) ss += x[j] * x[j];
          ss += __shfl_xor(ss, 1); ss += __shfl_xor(ss, 2); ss += __shfl_xor(ss, 4); ss += __shfl_xor(ss, 8); ss += __shfl_xor(ss, 16);
          const float r = rsqrtf(ss * (1.f / 512.f) + EPS);
#pragma unroll
          for (int j = 0; j < 16; ++j) x[j] = x[j] * r * gg[j];
          pg8::st8(OC + o, x); pg8::st8(OC + o + 8, x + 8); }
    }
}
__device__ __forceinline__ void ph_norm2(Frame& F, int l, const float* g, const float* sc, const float* sh) {
    const float* X = (const float*)(F.ws + WS_X); bf16_t* H = (bf16_t*)(F.ws + WS_H); const bf16_t* RW = (const bf16_t*)(F.ws + WS_RW) + (size_t)l * 48 * 1024;
    const float* rgb = F.in(15) + l * 4; const float* reb = F.in(17) + l * 32;
    unsigned* ecnt = F.ctl + CW_ECNT + l * 64;
    int* tok_e = (int*)(F.ws + WS_TOK); int* tok_p = tok_e + 2 * M; float* tok_w = (float*)(tok_p + 2 * M);
    int2* rinfo = (int2*)(F.ws + WS_RINFO);
    LAS float* lg = (LAS float*)(F.lds + F.wave * 4096);
    const int lane = F.lane, fr = lane & 15, g4 = lane >> 4;
    const int gw = F.bid * NWAVES + F.wave, NGW = F.G * NWAVES;
    for (int i = F.bid * NTHR + F.tid; i < XG_ROWS; i += F.G * NTHR) rinfo[i] = make_int2(-1, 0);
    for (int it = gw; it < M / 16; it += NGW) {
        const int row = 16 * it + fr, b = row >> 12; const float* xr = X + (size_t)row * D;
        float ss = 0.f;
        for (int kk = 0; kk < 32; ++kk) { const f32x4 a = *(const f32x4*)(xr + 32 * kk + 8 * g4), c = *(const f32x4*)(xr + 32 * kk + 8 * g4 + 4);
            ss += (a[0] * a[0] + a[1] * a[1]) + (a[2] * a[2] + a[3] * a[3]) + (c[0] * c[0] + c[1] * c[1]) + (c[2] * c[2] + c[3] * c[3]); }
        ss += __shfl_xor(ss, 16); ss += __shfl_xor(ss, 32);
        const float r = rsqrtf(ss * (1.f / D) + EPS);
        f32x4 acc[3] = {{0.f, 0.f, 0.f, 0.f}, {0.f, 0.f, 0.f, 0.f}, {0.f, 0.f, 0.f, 0.f}};
        for (int kk = 0; kk < 32; ++kk) { const int c0 = 32 * kk + 8 * g4;
            float x[8]; { const f32x4 a = *(const f32x4*)(xr + c0), c = *(const f32x4*)(xr + c0 + 4); x[0] = a[0]; x[1] = a[1]; x[2] = a[2]; x[3] = a[3]; x[4] = c[0]; x[5] = c[1]; x[6] = c[2]; x[7] = c[3]; }
            const f32x4 ga = *(const f32x4*)(g + c0), gb = *(const f32x4*)(g + c0 + 4), sa = *(const f32x4*)(sc + b * 6 * D + c0), sb = *(const f32x4*)(sc + b * 6 * D + c0 + 4), ha = *(const f32x4*)(sh + b * 6 * D + c0), hb = *(const f32x4*)(sh + b * 6 * D + c0 + 4);
#pragma unroll
            for (int j = 0; j < 4; ++j) { x[j] = x[j] * r * ga[j] * (1.f + sa[j]) + ha[j]; x[4 + j] = x[4 + j] * r * gb[j] * (1.f + sb[j]) + hb[j]; }
            u32x4 wv; wv.x = cvt_pk_bf16(x[0], x[1]); wv.y = cvt_pk_bf16(x[2], x[3]); wv.z = cvt_pk_bf16(x[4], x[5]); wv.w = cvt_pk_bf16(x[6], x[7]);
            *(u32x4*)(H + (size_t)row * D + c0) = wv;
            const bf16x8 af = *reinterpret_cast<const bf16x8*>(&wv);
#pragma unroll
            for (int nt = 0; nt < 3; ++nt) { const bf16x8 bfm = *(const bf16x8*)(RW + (size_t)(16 * nt + fr) * 1024 + c0); acc[nt] = mfma16(af, bfm, acc[nt]); } }
#pragma unroll
        for (int nt = 0; nt < 3; ++nt)
#pragma unroll
            for (int i = 0; i < 4; ++i) lg[(4 * g4 + i) * 48 + 16 * nt + fr] = acc[nt][i];
        LDS_WAIT(); asm volatile("" ::: "memory");
        if (lane < 16) { const int tk = 16 * it + lane; const LAS float* q = lg + lane * 48;
            float mx = -1e30f; int gs = 0;
#pragma unroll
            for (int i = 0; i < 4; ++i) { const float v = q[i] + rgb[i]; if (v > mx) { mx = v; gs = i; } }
            float s = 0.f;
#pragma unroll
            for (int i = 0; i < 4; ++i) s += __expf(q[i] + rgb[i] - mx);
            const float gp = 1.f / s;
            float v0 = -1e30f, v1 = -1e30f; int i0 = 0, i1 = 0;
            for (int i = 0; i < 8; ++i) { const float e = q[4 + gs * 8 + i] + reb[gs * 8 + i];
                if (e > v0) { v1 = v0; i1 = i0; v0 = e; i0 = i; } else if (e > v1) { v1 = e; i1 = i; } }
            const float w1 = __expf(v1 - v0), den = 1.f / (1.f + w1);
            const int e0 = gs * 8 + i0, e1 = gs * 8 + i1;
            const unsigned p0 = __hip_atomic_fetch_add(ecnt + e0, 1u, __ATOMIC_RELAXED, __HIP_MEMORY_SCOPE_AGENT), p1 = __hip_atomic_fetch_add(ecnt + e1, 1u, __ATOMIC_RELAXED, __HIP_MEMORY_SCOPE_AGENT);
            tok_e[2 * tk] = e0; tok_e[2 * tk + 1] = e1; tok_p[2 * tk] = (int)p0; tok_p[2 * tk + 1] = (int)p1; tok_w[2 * tk] = gp * den; tok_w[2 * tk + 1] = gp * w1 * den; }
        LDS_WAIT(); asm volatile("" ::: "memory");
    }
}
__device__ __forceinline__ void ph_gather(Frame& F, int l) {
    const unsigned* ecnt = F.ctl + CW_ECNT + l * 64;
    const int* tok_e = (const int*)(F.ws + WS_TOK); const int* tok_p = tok_e + 2 * M; const float* tok_w = (const float*)(tok_p + 2 * M);
    int2* rinfo = (int2*)(F.ws + WS_RINFO); int* t2e = (int*)(F.ws + WS_T2E);
    const bf16_t* H = (const bf16_t*)(F.ws + WS_H); bf16_t* XG = (bf16_t*)(F.ws + WS_XG);
    LAS int* offs = (LAS int*)F.lds;
    if (F.tid == 0) { int o = 0; for (int e = 0; e < NE; ++e) { offs[e] = o; const int c = (int)__hip_atomic_load(ecnt + e, __ATOMIC_RELAXED, __HIP_MEMORY_SCOPE_AGENT); o += (c + 255) & ~255; } offs[NE] = o; }
    __syncthreads();
    if (F.bid == 0) { if (F.tid == 0) t2e[0] = offs[NE] >> 8;
        for (int e = F.tid; e < NE; e += NTHR) for (int rt = offs[e] >> 8; rt < (offs[e + 1] >> 8); ++rt) t2e[1 + rt] = e; }
    const int gw = F.bid * NWAVES + F.wave, NGW = F.G * NWAVES, lane = F.lane;
    for (int ts = gw; ts < 2 * M; ts += NGW) {
        const int e = tok_e[ts], p = tok_p[ts]; const int row = offs[e] + p; const int tk = ts >> 1;
        const u32x4 a = *(const u32x4*)(H + (size_t)tk * D + 8 * lane), c = *(const u32x4*)(H + (size_t)tk * D + 512 + 8 * lane);
        *(u32x4*)(XG + (size_t)row * D + 8 * lane) = a; *(u32x4*)(XG + (size_t)row * D + 512 + 8 * lane) = c;
        if (lane == 0) rinfo[row] = make_int2(ts, __float_as_int(tok_w[ts]));
    }
}
__device__ __forceinline__ int build_units(Frame& F, LAS int* tab) {
    const int* t2e = (const int*)(F.ws + WS_T2E); const int NT = t2e[0]; int n = 0;
    for (int i = 0; i < 8; ++i) { const int L = i * F.G + F.bid; if (L < 4 * NT) { const int rt = L >> 2; if (F.tid == 0) tab[i] = (rt << 8) | (t2e[1 + rt] * 4 + (L & 3)); n = i + 1; } }
    __syncthreads();
    return n;
}
#ifndef MK_ONE_LAUNCH
#define MK_ONE_LAUNCH 0
#endif
constexpr int NPHASE = 13;
__global__ void __launch_bounds__(NTHR, 2) mk_fwd(Args a) {
    extern __shared__ __attribute__((aligned(16))) unsigned char lds[];
    Frame F;
    F.lds = (LAS unsigned char*)lds; F.MISC = (volatile LAS unsigned*)(F.lds + MISC_OFF);
    F.tid = threadIdx.x; F.lane = F.tid & 63; F.wave = __builtin_amdgcn_readfirstlane(F.tid >> 6); F.G = gridDim.x; F.bid = blockIdx.x;
    F.ws = a.ws; F.ctl = (unsigned*)(a.ws + WS_CTL); F.out = a.out;
    for (int u = F.tid; u < 1024; u += NTHR) ((LAS unsigned*)(F.lds + MISC_OFF))[u] = 0u;
    __syncthreads();
#pragma unroll
    for (int i = 0; i < 22; ++i) if (F.tid == i) *(LAS u64*)(F.lds + MISC_OFF + 512 + 8 * i) = (u64)a.in[i];
    __syncthreads();
    XcdBarrier bar = xcd_barrier_post(F.ctl + CW_BAR, F.MISC + 8);
    const int lo = a.ph_lo, hi = a.ph_hi;
#ifndef SUB
#define SUB 7
#endif
#ifndef PHSEL
#define PHSEL 0xffff
#endif
#define IN(k) (((PHSEL >> (k)) & 1) && lo <= (k) && (k) < hi)
#define GRID_BAR() do { if (MK_ONE_LAUNCH) xcd_barrier(bar); asm volatile("" : "+v"(F.tid), "+v"(F.lane), "+s"(F.wave) :: "memory"); } while (0)
    unsigned char* ws = a.ws; unsigned char* wb = ws + WS_W; unsigned char* pb = ws + WS_P;
    float* X = (float*)(ws + WS_X); bf16_t* H = (bf16_t*)(ws + WS_H); bf16_t* YS = (bf16_t*)(ws + WS_YS);
    const float* mod = (const float*)(ws + WS_MOD);
    LAS int* utab = (LAS int*)(F.lds + MISC_OFF + 256);

    if (IN(0) && a.lay_lo == 0) { ph_prologue(F); GRID_BAR(); }

    for (int l = a.lay_lo; l < a.lay_hi; ++l) {
        const float* md = mod + (size_t)l * BATCH * 6 * D;
        if (IN(1)) {
            ph_conv(F, l);
            if (l == 0) ph_norm(F, F.in(0), nullptr, nullptr, nullptr, F.in(4) + l * D, md + 1 * D, md + 0 * D, H, nullptr);
            else ph_norm(F, X, YS, md - (size_t)BATCH * 6 * D + 5 * D, X, F.in(4) + l * D, md + 1 * D, md + 0 * D, H, nullptr);
            GRID_BAR();
        }
        if (IN(2)) {
            pg8::Gemm g{H, (const bf16_t*)(wb + W_IN), M, NP, D}; pg8::StaticOrder S; S.init(M, NP, F.G, F.bid);
            pg8::EpiProj E{pb, (const float*)(ws + WS_LB) + l * 1024, (const float2*)(ws + WS_ROT)};
            pg8::gemm_phase<pg8::EpiProj, pg8::StaticOrder, true, true>(F.lds, g, S, E);
            GRID_BAR();
        }
        if (IN(3)) { if (SUB & 1) ph_idx(F); if (SUB & 2) ph_hprep(F); if (SUB & 4) ph_rprep(F); GRID_BAR(); }
        if (IN(4)) { if (SUB & 1) ph_att(F, (char*)lds); if (SUB & 2) ph_scan_ret(F); if (SUB & 4) ph_scan_hgrn(F); GRID_BAR(); }
        if (IN(5)) { ph_post(F, F.in(9) + l * 128); GRID_BAR(); }
        if (IN(6)) {
            if (SUB & 1) { pg8::Gemm g{(const bf16_t*)(ws + WS_OA), (const bf16_t*)(wb + W_BA), M, D, 1024}; pg8::StaticOrder S; S.init(M, D, F.G, F.bid);
              pg8::EpiMerge<0> E{(const bf16_t*)(pb + P_GA), (float*)(ws + WS_MG), (bf16_t*)(ws + WS_MGB)};
              pg8::gemm_phase<pg8::EpiMerge<0>, pg8::StaticOrder, false, true>(F.lds, g, S, E); }
            if (SUB & 2) { pg8::Gemm g{(const bf16_t*)(ws + WS_OB), (const bf16_t*)(wb + W_BB), M, D, 1024}; pg8::StaticOrder S; S.init(M, D, F.G, F.bid);
              pg8::EpiMerge<1> E{(const bf16_t*)(pb + P_GB), (float*)(ws + WS_MG), (bf16_t*)(ws + WS_MGB)};
              pg8::gemm_phase<pg8::EpiMerge<1>, pg8::StaticOrder, false, true>(F.lds, g, S, E); }
            if (SUB & 4) { pg8::Gemm g{(const bf16_t*)(ws + WS_OC), (const bf16_t*)(wb + W_BC), M, D, 2048}; pg8::StaticOrder S; S.init(M, D, F.G, F.bid);
              pg8::EpiMerge<2> E{(const bf16_t*)(pb + P_GC), (float*)(ws + WS_MG), (bf16_t*)(ws + WS_MGB)};
              pg8::gemm_phase<pg8::EpiMerge<2>, pg8::StaticOrder, false, true>(F.lds, g, S, E); }
            GRID_BAR();
        }
        if (IN(7)) {
            pg8::Gemm g{(const bf16_t*)(ws + WS_MGB), (const bf16_t*)(wb + W_OUT), M, D, 1024}; pg8::StaticOrder S; S.init(M, D, F.G, F.bid);
            pg8::EpiRes E{l == 0 ? F.in(0) : (const float*)X, X, md + 2 * D};
            pg8::gemm_phase<pg8::EpiRes, pg8::StaticOrder, false, true>(F.lds, g, S, E);
            GRID_BAR();
        }
        if (IN(8)) { ph_norm2(F, l, F.in(5) + l * D, md + 4 * D, md + 3 * D); GRID_BAR(); }
        if (IN(9)) { ph_gather(F, l); GRID_BAR(); }
        if (IN(10)) {
            pg8::ListOrder S; S.tab = utab; S.n = build_units(F, utab);
            pg8::Gemm g{(const bf16_t*)(ws + WS_XG), (const bf16_t*)(wb + W_E1), XG_ROWS, NE * 1024, 1024};
            pg8::EpiExpUp E{(bf16_t*)(ws + WS_ACT)};
            pg8::gemm_phase<pg8::EpiExpUp, pg8::ListOrder, true, true>(F.lds, g, S, E);
            GRID_BAR();
        }
        if (IN(11)) {
            pg8::ListOrder S; S.tab = utab; S.n = build_units(F, utab);
            pg8::Gemm g{(const bf16_t*)(ws + WS_ACT), (const bf16_t*)(wb + W_E2), XG_ROWS, NE * 1024, 512};
            pg8::EpiExpDown E{(const int2*)(ws + WS_RINFO), YS};
            pg8::gemm_phase<pg8::EpiExpDown, pg8::ListOrder, true, true>(F.lds, g, S, E);
            GRID_BAR();
        }
    }
    if (IN(12) && a.lay_hi == DEPTH) {
        const float* md3 = mod + (size_t)3 * BATCH * 6 * D;
        ph_norm(F, X, YS, md3 + 5 * D, nullptr, F.in(21), nullptr, nullptr, nullptr, F.out);
    }
#undef IN
#undef GRID_BAR
}

#ifdef MK_DIAG
__global__ void k_nonfinite(const void* p, size_t n, int is_f32, unsigned* cnt, int slot) {
    size_t i = (size_t)blockIdx.x * blockDim.x + threadIdx.x; const size_t st = (size_t)gridDim.x * blockDim.x; unsigned c = 0;
    if (is_f32) { const unsigned* q = (const unsigned*)p; for (; i < n; i += st) c += ((q[i] & 0x7f800000u) == 0x7f800000u) ? 1u : 0u; }
    else { const unsigned short* q = (const unsigned short*)p; for (; i < n; i += st) c += ((q[i] & 0x7f80u) == 0x7f80u) ? 1u : 0u; }
    if (c) atomicAdd(cnt + slot, c);
}
__global__ void k_maskcheck(const u64* maskT, unsigned* cnt, int slot) {
    const int idx = blockIdx.x * blockDim.x + threadIdx.x; if (idx >= M) return; const int b = idx >> 12, t = idx & 4095; int pc = 0;
    for (int j = 0; j <= (t >> 6); ++j) pc += __popcll(maskT[((size_t)b * 64 + j) * SEQ + t]);
    const int want = (t + 1 < 256) ? t + 1 : 256;
    if (pc != want) atomicAdd(cnt + slot, 1u);
}
__global__ void k_emit(const float* x, const float* g, const unsigned* cnt, int nslots, float* out) {
    const int row = blockIdx.x, t = threadIdx.x; float v[4], ss = 0.f;
    for (int j = 0; j < 4; ++j) { v[j] = x[(size_t)row * D + t + 256 * j]; ss += v[j] * v[j]; }
    __shared__ float red[256]; red[t] = ss; __syncthreads();
    for (int o = 128; o > 0; o >>= 1) { if (t < o) red[t] += red[t + o]; __syncthreads(); }
    const float r = rsqrtf(red[0] / D + EPS); int code = 0;
    for (int s = nslots - 1; s >= 0; --s) if (cnt[s]) code = s + 1;
    for (int j = 0; j < 4; ++j) out[(size_t)row * D + t + 256 * j] = (1.f + code) * v[j] * r * g[t + 256 * j];
}
#endif
extern "C" void kernel_launch(void* const* d_in, const int* in_sizes, int n_in, void* d_out, int out_size, void* d_ws, size_t ws_size, hipStream_t stream) {
    static int grid = 0;
    if (grid == 0) {
        if (n_in != 22 || ws_size < WS_END) { fprintf(stderr, "kernel_launch: bad n_in %d / ws %zu (need %zu)\n", n_in, ws_size, (size_t)WS_END); grid = -1; return; }
        int dev = 0, cus = 0, per_cu = 0;
        if (hipGetDevice(&dev) != hipSuccess || hipDeviceGetAttribute(&cus, hipDeviceAttributeMultiprocessorCount, dev) != hipSuccess) { grid = -1; return; }
        if (hipFuncSetAttribute((const void*)mk_fwd, hipFuncAttributeMaxDynamicSharedMemorySize, LDS_BYTES) != hipSuccess) { fprintf(stderr, "kernel_launch: hipFuncSetAttribute failed\n"); grid = -1; return; }
        if (hipOccupancyMaxActiveBlocksPerMultiprocessor(&per_cu, (const void*)mk_fwd, NTHR, LDS_BYTES) != hipSuccess || per_cu < 1) fprintf(stderr, "kernel_launch: occupancy query says %d\n", per_cu);
        (void)hipGetLastError();
        grid = cus;
    }
    if (grid < 0) return;
    (void)hipMemsetAsync((char*)d_ws + WS_CTL, 0, CTL_ZERO_BYTES, stream);
    Args a{};
    for (int i = 0; i < 22; ++i) a.in[i] = (const float*)d_in[i];
    a.out = (float*)d_out; a.ws = (unsigned char*)d_ws;
#ifdef MK_DIAG
    {
        unsigned* cnt = (unsigned*)((char*)d_ws + WS_CTL) + 200000;
        a.lay_lo = 0; a.lay_hi = 0; a.ph_lo = 0; a.ph_hi = 1;
        hipLaunchKernelGGL(mk_fwd, dim3(grid), dim3(NTHR), LDS_BYTES, stream, a);
        for (int p = 1; p <= MK_DIAG; ++p) { a.lay_lo = 0; a.lay_hi = 1; a.ph_lo = p; a.ph_hi = p + 1; hipLaunchKernelGGL(mk_fwd, dim3(grid), dim3(NTHR), LDS_BYTES, stream, a); }
        unsigned char* w = (unsigned char*)d_ws; int s = 0;
#define NF(off, n, f32) hipLaunchKernelGGL(k_nonfinite, dim3(1024), dim3(256), 0, stream, (const void*)(w + (off)), (size_t)(n), f32, cnt, s++)
        NF(WS_MOD, DEPTH * BATCH * 6 * D, 1);
        NF(WS_H, (size_t)M * D, 0);
        NF(WS_W + W_IN, (size_t)NP * D, 0);
        NF(WS_P + P_QA, (size_t)M * D * 3, 0);
        NF(WS_P + P_IQ, (size_t)M * 512, 0);
        NF(WS_P + P_IK, (size_t)M * 64, 0);
        NF(WS_P + P_IW, (size_t)M * 8, 1);
        NF(WS_P + P_BQ, (size_t)M * D * 4, 0);
        NF(WS_P + P_CQ, (size_t)M * D * 2, 0);
        NF(WS_P + P_CV, (size_t)M * 2048 * 2, 0);
        NF(WS_P + P_GA, (size_t)M * D * 3, 0);
        hipLaunchKernelGGL(k_maskcheck, dim3(M / 256), dim3(256), 0, stream, (const u64*)(w + WS_MASK), cnt, s++);
        NF(WS_HA, (size_t)2048 * 64 * 64, 0);
        NF(WS_HDEC, (size_t)2048 * 128, 1);
        NF(WS_RA, (size_t)512 * 128 * 128, 0);
        NF(WS_OA, (size_t)M * D, 0);
        NF(WS_OB, (size_t)M * D, 0);
        NF(WS_OC, (size_t)M * 2048, 0);
        NF(WS_MGB, (size_t)M * D, 0);
        NF(WS_X, (size_t)M * D, 1);
        hipLaunchKernelGGL(k_emit, dim3(M), dim3(256), 0, stream, (const float*)d_in[0], (const float*)d_in[21], cnt, s, (float*)d_out);
    }
#elif MK_ONE_LAUNCH
    a.lay_lo = 0; a.lay_hi = DEPTH; a.ph_lo = 0; a.ph_hi = NPHASE;
    hipLaunchKernelGGL(mk_fwd, dim3(grid), dim3(NTHR), LDS_BYTES, stream, a);
#else
    a.lay_lo = 0; a.lay_hi = 0; a.ph_lo = 0; a.ph_hi = 1;
    hipLaunchKernelGGL(mk_fwd, dim3(grid), dim3(NTHR), LDS_BYTES, stream, a);
    for (int l = 0; l < DEPTH; ++l) for (int p = 1; p <= 11; ++p) { a.lay_lo = l; a.lay_hi = l + 1; a.ph_lo = p; a.ph_hi = p + 1; hipLaunchKernelGGL(mk_fwd, dim3(grid), dim3(NTHR), LDS_BYTES, stream, a); }
    a.lay_lo = DEPTH; a.lay_hi = DEPTH; a.ph_lo = 12; a.ph_hi = 13;
    hipLaunchKernelGGL(mk_fwd, dim3(grid), dim3(NTHR), LDS_BYTES, stream, a);
#endif
}
```

```cpp
#include <hip/hip_runtime.h>
#include <cstdio>
#include <cstdint>

constexpr int D = 1024, BATCH = 4, SEQ = 4096, DEPTH = 4, M = BATCH * SEQ;
constexpr int A_HEADS = 8, TOPK = 256;
constexpr int NE = 32, DEXP = 512;
constexpr int N_IN = 16968, NP = 17152;
constexpr float EPS = 1e-6f;
constexpr int O_AQ = 0, O_AK = 1024, O_AV = 2048, O_IQ = 3072, O_IK = 3584, O_IW = 3648, O_BQ = 3656, O_BF = 4680, O_BI = 5704, O_BG = 6728,
              O_CQ = 7752, O_CK = 8776, O_CV = 9800, O_CG = 11848, O_GA = 13896, O_GB = 14920, O_GC = 15944;

#define LAS __attribute__((address_space(3)))
#define GAS __attribute__((address_space(1)))
typedef unsigned short bf16_t;
typedef short bf16x8 __attribute__((ext_vector_type(8)));
typedef short s16x4 __attribute__((ext_vector_type(4)));
typedef float f32x4 __attribute__((ext_vector_type(4)));
typedef float f32x2 __attribute__((ext_vector_type(2)));
typedef unsigned u32x4 __attribute__((ext_vector_type(4)));
typedef unsigned u32x2 __attribute__((ext_vector_type(2)));
typedef unsigned long long u64;

constexpr size_t MiB = 1u << 20;
constexpr size_t WS_CTL = 0, CTL_ZERO_BYTES = 1 * MiB;
constexpr size_t WS_MOD = 1 * MiB;
constexpr size_t WS_LB = WS_MOD + 512 * 1024;
constexpr size_t WS_TB = WS_LB + 16 * 1024;
constexpr size_t WS_ROT = 2 * MiB;
constexpr size_t WS_RW = 6 * MiB;
constexpr size_t WS_X = 8 * MiB;
constexpr size_t WS_H = 72 * MiB;
constexpr size_t WS_W = 104 * MiB;
constexpr size_t W_IN = 0, W_BA = 34 * MiB, W_BB = 36 * MiB, W_BC = 38 * MiB, W_OUT = 42 * MiB, W_E1 = 44 * MiB, W_E2 = 108 * MiB;
constexpr size_t WS_P = 244 * MiB;
constexpr size_t P_QA = 0, P_KA = 32 * MiB, P_VA = 64 * MiB, P_IQ = 96 * MiB, P_IK = 112 * MiB, P_IW = 114 * MiB,
                 P_BQ = 116 * MiB, P_BG = 148 * MiB, P_BV = 180 * MiB, P_BO = 212 * MiB, P_CQ = 244 * MiB, P_CK = 276 * MiB,
                 P_CV = 308 * MiB, P_CG = 372 * MiB, P_GA = 436 * MiB, P_GB = 468 * MiB, P_GC = 500 * MiB;
constexpr size_t WS_MASK = 776 * MiB;
constexpr size_t WS_OA = 784 * MiB;
constexpr size_t WS_HA = 816 * MiB;
constexpr size_t WS_HDEC = 832 * MiB;
constexpr size_t WS_RA = 834 * MiB;
constexpr size_t WS_OB = 850 * MiB;
constexpr size_t WS_OC = 882 * MiB;
constexpr size_t WS_MG = 946 * MiB;
constexpr size_t WS_MGB = 1010 * MiB;
constexpr size_t WS_END = 1042 * MiB;
constexpr int XG_ROWS = 40960;
constexpr size_t WS_XG = WS_P, WS_ACT = WS_P + 80 * MiB, WS_YS = WS_P + 120 * MiB, WS_RINFO = WS_P + 184 * MiB, WS_TOK = WS_P + 186 * MiB, WS_T2E = WS_P + 190 * MiB;
constexpr int CW_BAR = 4096;
constexpr int CW_ECNT = 16384;

typedef __bf16 bf16x2_n __attribute__((ext_vector_type(2)));
__device__ __forceinline__ unsigned cvt_pk_bf16(float lo, float hi) { const f32x2 v = {lo, hi}; const bf16x2_n r = __builtin_convertvector(v, bf16x2_n); return __builtin_bit_cast(unsigned, r); }
__device__ __forceinline__ float bf2f(unsigned short b) { return __uint_as_float(((unsigned)b) << 16); }
__device__ __forceinline__ float bflo(unsigned w) { return __uint_as_float(w << 16); }
__device__ __forceinline__ float bfhi(unsigned w) { return __uint_as_float(w & 0xffff0000u); }
__device__ __forceinline__ float sigmoid_f(float x) { return __builtin_amdgcn_rcpf(1.f + __expf(-x)); }
__device__ __forceinline__ float silu_f(float x) { return x * sigmoid_f(x); }
__device__ __forceinline__ float wave_sum(float v) {
#pragma unroll
    for (int o = 1; o < 64; o <<= 1) v += __shfl_xor(v, o);
    return v;
}
#define LDS_WAIT() asm volatile("s_waitcnt lgkmcnt(0)" ::: "memory")
#define VM_WAIT() asm volatile("s_waitcnt vmcnt(0)" ::: "memory")
constexpr int NWAVES = 8, NTHR = 512;
constexpr int RING_BYTES = 131072;
constexpr int MISC_OFF = RING_BYTES;
constexpr int LDS_BYTES = 147456;
struct Frame {
    LAS unsigned char* lds;
    volatile LAS unsigned* MISC;
    unsigned* ctl;
    unsigned char* ws;
    int tid, lane, wave, G, bid;
    float* out;
    __device__ __forceinline__ const float* in(int i) const { const LAS unsigned* p = (const LAS unsigned*)(lds + MISC_OFF + 512) + 2 * i;
        const unsigned lo = __builtin_amdgcn_readfirstlane(p[0]), hi = __builtin_amdgcn_readfirstlane(p[1]); return (const float*)(((u64)hi << 32) | lo); }
};
struct Args { const float* in[22]; float* out; unsigned char* ws; int lay_lo, lay_hi, ph_lo, ph_hi; };

__device__ __forceinline__ int t5_bucket(int rel) {
    if (rel < 16) return rel;
    int large = 16 + (int)(logf((float)rel / 16.f) / logf(8.f) * 16.f);
    return large < 31 ? large : 31;
}
__device__ __forceinline__ void ph_prologue(Frame& F) {
    const float* c = F.in(1); const float* rel_bias = F.in(2); const float* lb_raw = F.in(3); const float* ada_w = F.in(6); const float* ada_b = F.in(7);
    const float* rg_w = F.in(14); const float* re_w = F.in(16);
    float* mod = (float*)(F.ws + WS_MOD); float* lb = (float*)(F.ws + WS_LB); float* tb = (float*)(F.ws + WS_TB); float2* rot = (float2*)(F.ws + WS_ROT); bf16_t* rw = (bf16_t*)(F.ws + WS_RW);
    LAS float* sc = (LAS float*)F.lds;
    LAS float* red = (LAS float*)(F.lds + 16384);
    for (int i = F.tid; i < BATCH * D; i += NTHR) { const float v = c[i]; sc[i] = v / (1.f + __expf(-v)); }
    __syncthreads();
    for (int it = F.bid; it < DEPTH * 48; it += F.G) {
        const int l = it / 48, j0 = (it % 48) * 128, jj = F.tid & 127, kp = F.tid >> 7;
        const float* w = ada_w + (size_t)l * D * 6 * D + j0 + jj;
        float a0 = 0.f, a1 = 0.f, a2 = 0.f, a3 = 0.f;
        for (int k = kp * 256; k < kp * 256 + 256; ++k) { const float wv = w[(size_t)k * 6 * D]; a0 += sc[k] * wv; a1 += sc[D + k] * wv; a2 += sc[2 * D + k] * wv; a3 += sc[3 * D + k] * wv; }
        red[(kp * 128 + jj) * 4 + 0] = a0; red[(kp * 128 + jj) * 4 + 1] = a1; red[(kp * 128 + jj) * 4 + 2] = a2; red[(kp * 128 + jj) * 4 + 3] = a3;
        __syncthreads();
        { const int b = F.tid >> 7;
          const float s = red[(0 * 128 + jj) * 4 + b] + red[(1 * 128 + jj) * 4 + b] + red[(2 * 128 + jj) * 4 + b] + red[(3 * 128 + jj) * 4 + b];
          mod[((size_t)l * BATCH + b) * 6 * D + j0 + jj] = s + ada_b[l * 6 * D + j0 + jj]; }
        __syncthreads();
    }
    const int gt = F.bid * NTHR + F.tid, NT = F.G * NTHR;
    for (int d = gt; d < D; d += NT) {
        float v0 = lb_raw[d], v1 = lb_raw[D + d], v2 = lb_raw[2 * D + d], v3 = lb_raw[3 * D + d];
        const float mx = fmaxf(fmaxf(v0, v1), fmaxf(v2, v3));
        v0 = expf(v0 - mx); v1 = expf(v1 - mx); v2 = expf(v2 - mx); v3 = expf(v3 - mx);
        const float s = v0 + v1 + v2 + v3;
        lb[d] = 0.f; lb[D + d] = v1 / s; lb[2 * D + d] = (v1 + v2) / s; lb[3 * D + d] = (v1 + v2 + v3) / s;
    }
    for (int idx = gt; idx < SEQ * 128; idx += NT) { const int t = idx >> 7, i = idx & 127;
        const double th = exp(-(double)i / 127.0 * 9.210340371976184), a = (double)t * th;
        rot[idx] = make_float2((float)cos(a), (float)sin(a)); }
    for (int idx = gt; idx < 8 * 128; idx += NT) { const int h = idx >> 7, rel = idx & 127;
        tb[idx] = (rel_bias[t5_bucket(rel) * A_HEADS + h] - rel_bias[31 * A_HEADS + h]) * 11.313708498984761f; }
    for (int idx = gt; idx < DEPTH * 48 * D; idx += NT) { const int l = idx / (48 * D), r = idx % (48 * D), n = r >> 10, k = r & 1023;
        float v = 0.f; if (n < 4) v = rg_w[((size_t)l * D + k) * 4 + n]; else if (n < 36) v = re_w[((size_t)l * D + k) * 32 + (n - 4)];
        rw[idx] = (bf16_t)(cvt_pk_bf16(v, 0.f) & 0xffffu); }
}

__device__ __forceinline__ void conv_tile(const float* W, int ldw, int nvalid, bf16_t* dst, int K, int k0, LAS float* scr, int lane) {
    const bool ok = (lane & 31) < nvalid;
#pragma unroll 8
    for (int i = 0; i < 32; ++i) { const int kk = 2 * i + (lane >> 5); scr[kk * 33 + (lane & 31)] = ok ? W[(size_t)(k0 + kk) * ldw + (lane & 31)] : 0.f; }
    LDS_WAIT(); asm volatile("" ::: "memory");
    const int c = lane & 7;
#pragma unroll
    for (int j = 0; j < 4; ++j) { const int n = (lane >> 3) + 8 * j; const LAS float* s = scr + (8 * c) * 33 + n;
        u32x4 o; o.x = cvt_pk_bf16(s[0 * 33], s[1 * 33]); o.y = cvt_pk_bf16(s[2 * 33], s[3 * 33]); o.z = cvt_pk_bf16(s[4 * 33], s[5 * 33]); o.w = cvt_pk_bf16(s[6 * 33], s[7 * 33]);
        *(u32x4*)(dst + (size_t)n * K + k0 + 8 * c) = o; }
    LDS_WAIT(); asm volatile("" ::: "memory");
}
__device__ __forceinline__ void ph_conv(Frame& F, int l) {
    LAS float* scr = (LAS float*)(F.lds + F.wave * 16384);
    const int gw = F.bid * NWAVES + F.wave, NGW = F.G * NWAVES;
    unsigned char* wb = F.ws + WS_W;
    constexpr int I_IN = 536 * 16, I_B = 32 * 16, I_C = 32 * 32, I_E1 = 32 * 32 * 16, I_E2 = 32 * 32 * 8;
    constexpr int NITEMS = I_IN + 3 * I_B + I_C + I_E1 + I_E2;
    for (int it = gw; it < NITEMS; it += NGW) {
        int r = it;
        if (r < I_IN) { const int nb = r >> 4, kb = r & 15, n0 = nb * 32; int c0, nv;
            if (n0 + 32 <= 3656) { c0 = n0; nv = 32; } else if (n0 < 3656) { c0 = n0; nv = 3656 - n0; } else if (n0 < 3840) { c0 = 0; nv = 0; } else { c0 = n0 - 184; nv = 32; }
            conv_tile(F.in(8) + (size_t)l * D * N_IN + c0, N_IN, nv, (bf16_t*)(wb + W_IN) + (size_t)n0 * D, D, kb * 64, scr, F.lane); continue; }
        r -= I_IN;
        if (r < I_B) { conv_tile(F.in(10) + (size_t)l * 1024 * D + (r >> 4) * 32, D, 32, (bf16_t*)(wb + W_BA) + (size_t)(r >> 4) * 32 * 1024, 1024, (r & 15) * 64, scr, F.lane); continue; }
        r -= I_B;
        if (r < I_B) { conv_tile(F.in(11) + (size_t)l * 1024 * D + (r >> 4) * 32, D, 32, (bf16_t*)(wb + W_BB) + (size_t)(r >> 4) * 32 * 1024, 1024, (r & 15) * 64, scr, F.lane); continue; }
        r -= I_B;
        if (r < I_C) { conv_tile(F.in(12) + (size_t)l * 2048 * D + (r >> 5) * 32, D, 32, (bf16_t*)(wb + W_BC) + (size_t)(r >> 5) * 32 * 2048, 2048, (r & 31) * 64, scr, F.lane); continue; }
        r -= I_C;
        if (r < I_B) { conv_tile(F.in(13) + (size_t)l * D * D + (r >> 4) * 32, D, 32, (bf16_t*)(wb + W_OUT) + (size_t)(r >> 4) * 32 * 1024, 1024, (r & 15) * 64, scr, F.lane); continue; }
        r -= I_B;
        if (r < I_E1) { const int e = r >> 9, q = r & 511, nb = q >> 4, kb = q & 15, n0 = nb * 32;
            const int pn = n0 >> 8, bj = (n0 >> 7) & 1, j0 = n0 & 127;
            const float* src = (bj ? F.in(19) : F.in(18)) + ((size_t)l * NE + e) * D * DEXP + 128 * pn + j0;
            conv_tile(src, DEXP, 32, (bf16_t*)(wb + W_E1) + ((size_t)e * 1024 + n0) * 1024, 1024, kb * 64, scr, F.lane); continue; }
        r -= I_E1;
        { const int e = r >> 8, q = r & 255, nb = q >> 3, kb = q & 7;
          conv_tile(F.in(20) + ((size_t)l * NE + e) * DEXP * D + nb * 32, D, 32, (bf16_t*)(wb + W_E2) + ((size_t)e * 1024 + nb * 32) * 512, 512, kb * 64, scr, F.lane); }
    }
}

__device__ __forceinline__ void ph_norm(Frame& F, const float* xs, const bf16_t* ys, const float* gt2, float* xd, const float* g, const float* sc, const float* sh, bf16_t* hout, float* fout) {
    const int gw = F.bid * NWAVES + F.wave, NGW = F.G * NWAVES;
    for (int row = gw; row < M; row += NGW) {
        const int b = row >> 12;
        f32x4 v[4]; float ss = 0.f;
#pragma unroll
        for (int j = 0; j < 4; ++j) { const int c = 4 * F.lane + 256 * j; v[j] = *(const f32x4*)(xs + (size_t)row * D + c);
            if (ys) { const u32x2 y0 = *(const u32x2*)(ys + ((size_t)row * 2) * D + c), y1 = *(const u32x2*)(ys + ((size_t)row * 2 + 1) * D + c); const f32x4 gg = *(const f32x4*)(gt2 + b * 6 * D + c);
                v[j][0] += gg[0] * (bflo(y0.x) + bflo(y1.x)); v[j][1] += gg[1] * (bfhi(y0.x) + bfhi(y1.x)); v[j][2] += gg[2] * (bflo(y0.y) + bflo(y1.y)); v[j][3] += gg[3] * (bfhi(y0.y) + bfhi(y1.y)); }
            ss += (v[j][0] * v[j][0] + v[j][1] * v[j][1]) + (v[j][2] * v[j][2] + v[j][3] * v[j][3]); }
        const float r = rsqrtf(wave_sum(ss) * (1.f / D) + EPS);
#pragma unroll
        for (int j = 0; j < 4; ++j) { const int c = 4 * F.lane + 256 * j;
            if (xd) *(f32x4*)(xd + (size_t)row * D + c) = v[j];
            f32x4 o = v[j] * r * *(const f32x4*)(g + c);
            if (sc) o = o * (1.f + *(const f32x4*)(sc + b * 6 * D + c)) + *(const f32x4*)(sh + b * 6 * D + c);
            if (hout) { u32x2 w; w.x = cvt_pk_bf16(o[0], o[1]); w.y = cvt_pk_bf16(o[2], o[3]); *(u32x2*)(hout + (size_t)row * D + c) = w; }
            else *(f32x4*)(fout + (size_t)row * D + c) = o; }
    }
}
namespace pg8 {
#define PG8_LAS __attribute__((address_space(3)))
typedef unsigned short bf16_t;
typedef short bf16x8 __attribute__((ext_vector_type(8)));
typedef float f32x4 __attribute__((ext_vector_type(4)));
typedef unsigned u32x4 __attribute__((ext_vector_type(4)));
constexpr int BM = 256, BK = 64, HALF = 128, HTB = HALF * BK * 2  , STAGE_BYTES = 8 * HTB, NXCD = 8, WGM = 8;

__host__ __device__ __forceinline__ int lds_byte(int r, int c) { const int st = (r >> 4) * 2 + (c >> 5), rr = r & 15, cc = c & 31, ob = rr * 64 + cc * 2; return st * 1024 + (ob ^ (((ob >> 9) & 1) << 5)); }
__host__ __device__ __forceinline__ void stage_rc(int b, int& R, int& C) { const int st = b / 1024, sb = b % 1024, swz = sb ^ (((sb >> 9) & 1) << 5); R = (st >> 1) * 16 + swz / 64; C = (st & 1) * 32 + (swz % 64) / 2; }
__host__ __device__ __forceinline__ int perm32(int rho) { const int n = rho >> 4, i = rho & 15; return 8 * (i >> 2) + 4 * n + (i & 3); }

struct Unit { int pm, pn; };
struct Gemm { const bf16_t* A; const bf16_t* Bt; int M, N, K; };

struct StaticOrder {
    int nM, nN, nwg, G, c;
    __host__ __device__ void init(int M, int N, int G_, int c_) { nM = M / BM; nN = N / BM; nwg = nM * nN; G = G_; c = c_; }
    __host__ __device__ bool next(int i, Unit& u) const {
        const long L = (long)i * G + c; if (L >= nwg) return false;
        int wgid = (int)L; { const int q = nwg / NXCD, r = nwg % NXCD, xcd = wgid % NXCD, off = wgid / NXCD; wgid = (xcd < r ? xcd * (q + 1) : r * (q + 1) + (xcd - r) * q) + off; }
        const int nig = WGM * nN, gid = wgid / nig, fm = gid * WGM, gsz = (nM - fm) < WGM ? (nM - fm) : WGM;
        u.pm = fm + ((wgid % nig) % gsz); u.pn = (wgid % nig) / gsz; return true;
    }
    __device__ __forceinline__ void a_ready(const Unit&) const {}
    __device__ __forceinline__ void done(const Unit&) const {}
};


__device__ __forceinline__ void st8(bf16_t* p, const float* x) { u32x4 w; w.x = cvt_pk_bf16(x[0], x[1]); w.y = cvt_pk_bf16(x[2], x[3]); w.z = cvt_pk_bf16(x[4], x[5]); w.w = cvt_pk_bf16(x[6], x[7]); *(u32x4*)p = w; }
enum { K_PLAIN = 0, K_LOGF = 1, K_SILU = 2, K_SIGM = 3, K_ROTQ = 4, K_ROTK = 5, K_IDX = 6 };
struct EpiProj {
    static constexpr bool PERM = true, AFTER_DRAIN = false;
    unsigned char* pb;
    const float* lb;
    const float2* rot;
    __device__ __forceinline__ void operator()(const f32x4 (&acc)[2][2][4][2], const Unit& u, int wr, int wc, int fr, int fq) const {
        const int pn = u.pn; size_t off; int ld, cb, kind, hd = 0;
        if (pn < 12) { off = P_QA + (size_t)(pn >> 2) * 32 * MiB; ld = 1024; cb = (pn & 3) * 256; kind = K_PLAIN; }
        else if (pn < 14) { off = P_IQ; ld = 512; cb = (pn - 12) * 256; kind = K_PLAIN; }
        else if (pn == 14) { off = P_IK; ld = 64; cb = 0; kind = K_IDX; }
        else if (pn < 31) { const int q = pn - 15, t = q >> 2; off = P_BQ + (size_t)t * 32 * MiB; ld = 1024; cb = (q & 3) * 256; kind = (t == 1) ? K_LOGF : (t == 3) ? K_SILU : K_PLAIN; }
        else if (pn < 39) { const int q = pn - 31, t = q >> 2; off = P_CQ + (size_t)t * 32 * MiB; ld = 1024; cb = (q & 3) * 256; kind = t ? K_ROTK : K_ROTQ; hd = q & 3; }
        else if (pn < 55) { const int q = pn - 39, t = q >> 3; off = P_CV + (size_t)t * 64 * MiB; ld = 2048; cb = (q & 7) * 256; kind = t ? K_SILU : K_PLAIN; }
        else { const int q = pn - 55, t = q >> 2; off = P_GA + (size_t)t * 32 * MiB; ld = 1024; cb = (q & 3) * 256; kind = K_SIGM; }
        bf16_t* base = (bf16_t*)(pb + off);
        const int row0 = u.pm * BM + wr * 64 + fr, cl0 = wc * 32 + 8 * fq;
        if (kind == K_IDX) {
            float* iw = (float*)(pb + P_IW);
#pragma unroll
            for (int ai = 0; ai < 2; ++ai)
#pragma unroll
                for (int m = 0; m < 4; ++m) { const int row = row0 + ai * HALF + m * 16;
                    if (cl0 < 64) { float x[8] = {acc[ai][0][m][0][0], acc[ai][0][m][0][1], acc[ai][0][m][0][2], acc[ai][0][m][0][3], acc[ai][0][m][1][0], acc[ai][0][m][1][1], acc[ai][0][m][1][2], acc[ai][0][m][1][3]};
                        st8(base + (size_t)row * 64 + cl0, x); }
                    else if (cl0 == 64) { *(f32x4*)(iw + (size_t)row * 8) = acc[ai][0][m][0]; *(f32x4*)(iw + (size_t)row * 8 + 4) = acc[ai][0][m][1]; } }
            return;
        }
        const float l2g = __log2f(1.f - exp2f(-5.f - (float)hd));
#pragma unroll
        for (int ai = 0; ai < 2; ++ai)
#pragma unroll
            for (int m = 0; m < 4; ++m) { const int row = row0 + ai * HALF + m * 16; bf16_t* rowp = base + (size_t)row * ld + cb + cl0;
#pragma unroll
                for (int bj = 0; bj < 2; ++bj) {
                    float x[8] = {acc[ai][bj][m][0][0], acc[ai][bj][m][0][1], acc[ai][bj][m][0][2], acc[ai][bj][m][0][3], acc[ai][bj][m][1][0], acc[ai][bj][m][1][1], acc[ai][bj][m][1][2], acc[ai][bj][m][1][3]};
                    if (kind == K_LOGF) {
#pragma unroll
                        for (int j = 0; j < 8; ++j) { const float lv = lb[cb + bj * HALF + cl0 + j]; x[j] = __logf(lv + (1.f - lv) * sigmoid_f(x[j])); } }
                    else if (kind == K_SILU) {
#pragma unroll
                        for (int j = 0; j < 8; ++j) x[j] = silu_f(x[j]); }
                    else if (kind == K_SIGM) {
#pragma unroll
                        for (int j = 0; j < 8; ++j) x[j] = sigmoid_f(x[j]); }
                    else if (kind == K_ROTQ || kind == K_ROTK) {
                        const int pos = row & (SEQ - 1), e = pos & 127, i0 = (bj * HALF + cl0) >> 1;
                        const f32x4 r0 = *(const f32x4*)(rot + (size_t)pos * 128 + i0), r1 = *(const f32x4*)(rot + (size_t)pos * 128 + i0 + 2);
                        const float s = (kind == K_ROTQ) ? exp2f((float)(e + 1) * l2g) : 0.0625f * exp2f((float)(127 - e) * l2g);
                        const float cs[8] = {r0[0], r0[1], r0[2], r0[3], r1[0], r1[1], r1[2], r1[3]};
#pragma unroll
                        for (int j = 0; j < 4; ++j) { const float a = x[2 * j], b = x[2 * j + 1], c = cs[2 * j], sn = cs[2 * j + 1]; x[2 * j] = (a * c - b * sn) * s; x[2 * j + 1] = (b * c + a * sn) * s; } }
                    st8(rowp + bj * HALF, x); } }
    }
};
template <int STEP> struct EpiMerge {
    static constexpr bool PERM = false, AFTER_DRAIN = false;
    const bf16_t* gate; float* mg; bf16_t* mgb;
    __device__ __forceinline__ void operator()(const f32x4 (&acc)[2][2][4][2], const Unit& u, int wr, int wc, int fr, int fq) const {
        const int row0 = u.pm * BM + wr * 64 + fr, col0 = u.pn * BM + wc * 32 + 4 * fq;
#pragma unroll
        for (int ai = 0; ai < 2; ++ai)
#pragma unroll
            for (int m = 0; m < 4; ++m) { const size_t ro = (size_t)(row0 + ai * HALF + m * 16) * 1024 + col0;
#pragma unroll
                for (int bj = 0; bj < 2; ++bj)
#pragma unroll
                    for (int n = 0; n < 2; ++n) { const size_t o = ro + bj * HALF + n * 16; const u32x2 gw = *(const u32x2*)(gate + o);
                        f32x4 v = acc[ai][bj][m][n] * (f32x4){bflo(gw.x), bfhi(gw.x), bflo(gw.y), bfhi(gw.y)};
                        if (STEP > 0) v += *(const f32x4*)(mg + o);
                        if (STEP < 2) *(f32x4*)(mg + o) = v;
                        else { u32x2 w; w.x = cvt_pk_bf16(v[0], v[1]); w.y = cvt_pk_bf16(v[2], v[3]); *(u32x2*)(mgb + o) = w; } } }
    }
};
struct EpiRes {
    static constexpr bool PERM = false, AFTER_DRAIN = false;
    const float* xs; float* xd; const float* gt;
    __device__ __forceinline__ void operator()(const f32x4 (&acc)[2][2][4][2], const Unit& u, int wr, int wc, int fr, int fq) const {
        const int row0 = u.pm * BM + wr * 64 + fr, col0 = u.pn * BM + wc * 32 + 4 * fq; const int b = (u.pm * BM) >> 12;
#pragma unroll
        for (int ai = 0; ai < 2; ++ai)
#pragma unroll
            for (int m = 0; m < 4; ++m) { const size_t ro = (size_t)(row0 + ai * HALF + m * 16) * 1024 + col0;
#pragma unroll
                for (int bj = 0; bj < 2; ++bj)
#pragma unroll
                    for (int n = 0; n < 2; ++n) { const size_t o = ro + bj * HALF + n * 16; const f32x4 g = *(const f32x4*)(gt + b * 6 * D + col0 + bj * HALF + n * 16);
                        *(f32x4*)(xd + o) = *(const f32x4*)(xs + o) + g * acc[ai][bj][m][n]; } }
    }
};
struct EpiExpUp {
    static constexpr bool PERM = true, AFTER_DRAIN = false;
    bf16_t* act;
    __device__ __forceinline__ void operator()(const f32x4 (&acc)[2][2][4][2], const Unit& u, int wr, int wc, int fr, int fq) const {
        const int row0 = u.pm * BM + wr * 64 + fr, col0 = (u.pn & 3) * 128 + wc * 32 + 8 * fq;
#pragma unroll
        for (int ai = 0; ai < 2; ++ai)
#pragma unroll
            for (int m = 0; m < 4; ++m) { float x[8];
#pragma unroll
                for (int n = 0; n < 2; ++n)
#pragma unroll
                    for (int i = 0; i < 4; ++i) x[4 * n + i] = silu_f(acc[ai][0][m][n][i]) * acc[ai][1][m][n][i];
                st8(act + (size_t)(row0 + ai * HALF + m * 16) * DEXP + col0, x); }
    }
};
struct EpiExpDown {
    static constexpr bool PERM = true, AFTER_DRAIN = false;
    const int2* rinfo; bf16_t* ys;
    __device__ __forceinline__ void operator()(const f32x4 (&acc)[2][2][4][2], const Unit& u, int wr, int wc, int fr, int fq) const {
        const int row0 = u.pm * BM + wr * 64 + fr, col0 = (u.pn & 3) * 256 + wc * 32 + 8 * fq;
#pragma unroll
        for (int ai = 0; ai < 2; ++ai)
#pragma unroll
            for (int m = 0; m < 4; ++m) { const int2 ri = rinfo[row0 + ai * HALF + m * 16];
                if (ri.x >= 0) { const float w = __int_as_float(ri.y);
#pragma unroll
                    for (int bj = 0; bj < 2; ++bj) { float x[8];
#pragma unroll
                        for (int n = 0; n < 2; ++n)
#pragma unroll
                            for (int i = 0; i < 4; ++i) x[4 * n + i] = w * acc[ai][bj][m][n][i];
                        st8(ys + (size_t)ri.x * D + col0 + bj * HALF, x); } } }
    }
};
struct ListOrder {
    const LAS int* tab; int n;
    __device__ __forceinline__ bool next(int i, Unit& u) const { if (i >= n) return false; const int v = tab[i]; u.pm = v >> 8; u.pn = v & 255; return true; }
    __device__ __forceinline__ void a_ready(const Unit&) const {}
    __device__ __forceinline__ void done(const Unit&) const {}
};

template <class Epi, class Sched, bool ALIGN_EPI = false, bool SP2 = false>
__device__ __forceinline__ void gemm_phase(PG8_LAS unsigned char* lds, const Gemm g, const Sched& S, const Epi& E) {
    int tid_ = threadIdx.x; asm volatile("" : "+v"(tid_));
    const int tid = tid_, wid = __builtin_amdgcn_readfirstlane(tid >> 6), lane = tid & 63, wr = wid >> 2, wc = wid & 3, fr = lane & 15, fq = lane >> 4;
    const int K = g.K, nt = K / BK;
    unsigned voffA[2], voffB[2];
#pragma unroll
    for (int i = 0; i < 2; ++i) { int R, C; stage_rc(tid * 16 + i * 8192, R, C); const int Rb = Epi::PERM ? ((R & ~31) + perm32(R & 31)) : R;
        voffA[i] = (unsigned)(R * K + C) * 2u; voffB[i] = (unsigned)(Rb * K + C) * 2u; }
    const size_t kstep = (size_t)(BK * 2);
    const size_t hstep = (size_t)HALF * K * 2;
    const size_t tstep = 2 * hstep;
    const unsigned ldsw = (unsigned)wid * 1024u;
    const int aoff = lds_byte(wr * 64 + fr, fq * 8), boff = lds_byte(wc * 32 + fr, fq * 8);
#define PG8_SA(b, h) (((b) * 2 + (h)) * HTB)
#define PG8_SB(b, h) ((4 + (b) * 2 + (h)) * HTB)
#define PG8_STAGE(bufoff, gbase, voff) do { _Pragma("unroll") for (int _i = 0; _i < 2; ++_i) \
        __builtin_amdgcn_global_load_lds((const unsigned*)((const char*)(gbase) + (voff)[_i]), (PG8_LAS unsigned*)(lds + (bufoff) + ldsw + _i * 8192), 16, 0, 0); } while (0)
#define PG8_LDA(dst, b, h) do { _Pragma("unroll") for (int m = 0; m < 4; ++m) _Pragma("unroll") for (int k = 0; k < 2; ++k) dst[m][k] = *(const PG8_LAS bf16x8*)(lds + PG8_SA(b, h) + aoff + m * 2048 + k * 1024); } while (0)
#define PG8_LDB(dst, b, h) do { _Pragma("unroll") for (int n = 0; n < 2; ++n) _Pragma("unroll") for (int k = 0; k < 2; ++k) dst[n][k] = *(const PG8_LAS bf16x8*)(lds + PG8_SB(b, h) + boff + n * 2048 + k * 1024); } while (0)
#define PG8_MMA(ai, bj, At, Bt) do { __builtin_amdgcn_s_setprio(1); _Pragma("unroll") for (int m = 0; m < 4; ++m) _Pragma("unroll") for (int n = 0; n < 2; ++n) _Pragma("unroll") for (int k = 0; k < 2; ++k) \
        acc[ai][bj][m][n] = __builtin_amdgcn_mfma_f32_16x16x32_bf16(Bt[n][k], At[m][k], acc[ai][bj][m][n], 0, 0, 0); __builtin_amdgcn_s_setprio(0); } while (0)
#define PG8_WAIT_V(n) asm volatile("s_waitcnt vmcnt(" #n ")" ::: "memory")
#define PG8_WAIT_L(n) asm volatile("s_waitcnt lgkmcnt(" #n ")" ::: "memory")
#define PG8_BAR __builtin_amdgcn_s_barrier()
#define PG8_SCHED __builtin_amdgcn_sched_barrier(0)
    Unit cur, nxt; int ui = 0;
    if (!S.next(0, cur)) return;
    f32x4 acc[2][2][4][2];
#pragma unroll
    for (int a = 0; a < 2; ++a)
#pragma unroll
        for (int b = 0; b < 2; ++b)
#pragma unroll
            for (int m = 0; m < 4; ++m)
#pragma unroll
                for (int n = 0; n < 2; ++n) acc[a][b][m][n] = (f32x4){0.f, 0.f, 0.f, 0.f};
    bf16x8 At[4][2], B0[2][2], B1[2][2];
    const char* cA = (const char*)g.A + (size_t)cur.pm * tstep; const char* cB = (const char*)g.Bt + (size_t)cur.pn * tstep;
    S.a_ready(cur);
    if constexpr (SP2) {
        PG8_STAGE(PG8_SB(0, 0), cB, voffB); PG8_STAGE(PG8_SB(0, 1), cB + hstep, voffB); PG8_STAGE(PG8_SA(0, 0), cA, voffA); PG8_STAGE(PG8_SA(0, 1), cA + hstep, voffA);
        if (wr == 1) PG8_BAR;
        PG8_WAIT_V(2); PG8_BAR;
        PG8_STAGE(PG8_SB(1, 0), cB + kstep, voffB); PG8_STAGE(PG8_SA(1, 0), cA + kstep, voffA); PG8_STAGE(PG8_SB(1, 1), cB + hstep + kstep, voffB);
        PG8_WAIT_V(6); PG8_BAR;
    } else {
        PG8_STAGE(PG8_SB(0, 0), cB, voffB); PG8_STAGE(PG8_SA(0, 0), cA, voffA); PG8_STAGE(PG8_SB(0, 1), cB + hstep, voffB); PG8_STAGE(PG8_SA(0, 1), cA + hstep, voffA);
        if (wr == 1) PG8_BAR;
        PG8_WAIT_V(4); PG8_BAR;
        PG8_STAGE(PG8_SB(1, 0), cB + kstep, voffB); PG8_STAGE(PG8_SA(1, 0), cA + kstep, voffA); PG8_STAGE(PG8_SB(1, 1), cB + hstep + kstep, voffB);
        PG8_WAIT_V(6); PG8_BAR;
    }
    for (;;) {
        const bool has_next = S.next(ui + 1, nxt);
        const char* nA = has_next ? (const char*)g.A + (size_t)nxt.pm * tstep : cA; const char* nB = has_next ? (const char*)g.Bt + (size_t)nxt.pn * tstep : cB;
        for (int t = 0; t < nt; t += 2) {
            const bool last = (t == nt - 2);
            const char* a1 = cA + (size_t)(t + 1) * kstep;
            const char* a2 = last ? nA : cA + (size_t)(t + 2) * kstep; const char* b2 = last ? nB : cB + (size_t)(t + 2) * kstep;
            const char* a3 = a2 + kstep; const char* b3 = b2 + kstep;
            if (last && has_next) S.a_ready(nxt);
            if constexpr (SP2) {
            PG8_LDB(B0, 0, 0); PG8_LDB(B1, 0, 1); PG8_SCHED; PG8_LDA(At, 0, 0); PG8_STAGE(PG8_SA(1, 1), a1 + hstep, voffA);
            PG8_WAIT_V(8); PG8_WAIT_L(0); PG8_BAR; PG8_MMA(0, 0, At, B0); PG8_MMA(0, 1, At, B1); PG8_BAR; PG8_SCHED;
            PG8_LDA(At, 0, 1); PG8_STAGE(PG8_SB(0, 0), b2, voffB); PG8_STAGE(PG8_SB(0, 1), b2 + hstep, voffB); PG8_STAGE(PG8_SA(0, 0), a2, voffA);
            PG8_WAIT_V(8); PG8_WAIT_L(0); PG8_BAR; PG8_MMA(1, 0, At, B0); PG8_MMA(1, 1, At, B1); PG8_BAR; PG8_SCHED;
            PG8_LDB(B0, 1, 0); PG8_LDB(B1, 1, 1); PG8_SCHED; PG8_LDA(At, 1, 0); PG8_STAGE(PG8_SA(0, 1), a2 + hstep, voffA);
            PG8_WAIT_V(8); PG8_WAIT_L(0); PG8_BAR; PG8_MMA(0, 0, At, B0); PG8_MMA(0, 1, At, B1); PG8_BAR; PG8_SCHED;
            PG8_LDA(At, 1, 1); PG8_STAGE(PG8_SB(1, 0), b3, voffB); PG8_STAGE(PG8_SB(1, 1), b3 + hstep, voffB); PG8_STAGE(PG8_SA(1, 0), a3, voffA);
            PG8_WAIT_V(8); PG8_WAIT_L(0); PG8_BAR; PG8_MMA(1, 0, At, B0); PG8_MMA(1, 1, At, B1); PG8_BAR; PG8_SCHED;
            } else {
            PG8_LDB(B0, 0, 0); PG8_SCHED; PG8_LDA(At, 0, 0); PG8_STAGE(PG8_SA(1, 1), a1 + hstep, voffA);
            PG8_WAIT_L(8); PG8_BAR; PG8_WAIT_L(0); PG8_MMA(0, 0, At, B0); PG8_BAR; PG8_SCHED;
            PG8_LDB(B1, 0, 1); PG8_STAGE(PG8_SB(0, 0), b2, voffB);
            PG8_BAR; PG8_WAIT_L(0); PG8_MMA(0, 1, At, B1); PG8_BAR;
            PG8_LDA(At, 0, 1); PG8_STAGE(PG8_SA(0, 0), a2, voffA);
            PG8_BAR; PG8_WAIT_L(0); PG8_MMA(1, 0, At, B0); PG8_BAR; PG8_SCHED;
            PG8_STAGE(PG8_SB(0, 1), b2 + hstep, voffB);
            PG8_WAIT_V(6); PG8_BAR; PG8_MMA(1, 1, At, B1); PG8_BAR;
            PG8_LDB(B0, 1, 0); PG8_SCHED; PG8_LDA(At, 1, 0); PG8_STAGE(PG8_SA(0, 1), a2 + hstep, voffA);
            PG8_WAIT_L(8); PG8_BAR; PG8_WAIT_L(0); PG8_MMA(0, 0, At, B0); PG8_BAR; PG8_SCHED;
            PG8_LDB(B1, 1, 1); PG8_STAGE(PG8_SB(1, 0), b3, voffB);
            PG8_BAR; PG8_WAIT_L(0); PG8_MMA(0, 1, At, B1); PG8_BAR;
            PG8_LDA(At, 1, 1); PG8_STAGE(PG8_SA(1, 0), a3, voffA);
            PG8_BAR; PG8_WAIT_L(0); PG8_MMA(1, 0, At, B0); PG8_BAR; PG8_SCHED;
            PG8_STAGE(PG8_SB(1, 1), b3 + hstep, voffB);
            PG8_WAIT_V(6); PG8_BAR; PG8_MMA(1, 1, At, B1); PG8_BAR;
            }
        }
        if constexpr (ALIGN_EPI) { if (wr == 0) PG8_BAR; }
        if constexpr (!Epi::AFTER_DRAIN) { E(acc, cur, wr, wc, fr, fq); S.done(cur); }
        if (!has_next) break;
#pragma unroll
        for (int a = 0; a < 2; ++a)
#pragma unroll
            for (int b = 0; b < 2; ++b)
#pragma unroll
                for (int m = 0; m < 4; ++m)
#pragma unroll
                    for (int n = 0; n < 2; ++n) acc[a][b][m][n] = (f32x4){0.f, 0.f, 0.f, 0.f};
        cur = nxt; cA = nA; cB = nB; ++ui;
        if constexpr (ALIGN_EPI) { if (wr == 1) PG8_BAR; }
    }
    PG8_WAIT_V(0);
    if constexpr (!ALIGN_EPI) { if (wr == 0) PG8_BAR; }
    PG8_BAR;
    if constexpr (Epi::AFTER_DRAIN) { E.fused(acc, cur, wr, wc, fr, fq, lds, wid, lane); S.done(cur); }
#undef PG8_SA
#undef PG8_SB
#undef PG8_STAGE
#undef PG8_LDA
#undef PG8_LDB
#undef PG8_MMA
#undef PG8_WAIT_V
#undef PG8_WAIT_L
#undef PG8_BAR
#undef PG8_SCHED
}
}

#define XB_TMO      128
#define XB_XCNT(j)  (256  + 64 * (j))
#define XB_XSUB(j)  (1280 + 64 * (j))
#define XB_XGEN(j)  (2304 + 64 * (j))
#define XB_TOP      3328
#define XB_TOPGEN   3392
#define XCD_BAR_WORDS 3456
#define XB_SPIN_CAP (1u << 18)

__device__ __forceinline__ unsigned xb_ld(unsigned* p)              { return __hip_atomic_load(p, __ATOMIC_RELAXED, __HIP_MEMORY_SCOPE_AGENT); }
__device__ __forceinline__ unsigned xb_add(unsigned* p, unsigned v) { return __hip_atomic_fetch_add(p, v, __ATOMIC_RELAXED, __HIP_MEMORY_SCOPE_AGENT); }
__device__ __forceinline__ unsigned xb_xcc_id() { return (unsigned)__builtin_amdgcn_s_getreg((3 << 11) | 20) & 0xFu; }
#define XB_SPIN(cond, bar) do { unsigned _sp = 0; while (cond) { __builtin_amdgcn_s_sleep(1); \
    if ((++_sp & 255u) == 0u) { if (xb_ld(&(bar)[XB_TMO])) break; if (_sp > XB_SPIN_CAP) { atomicAdd(&(bar)[XB_TMO], 1u); break; } } } } while (0)

struct XcdBarrier {
    unsigned* bar; unsigned x;
    volatile LAS unsigned* st;
};

__device__ __forceinline__ XcdBarrier xcd_barrier_post(unsigned* bar, volatile LAS unsigned* st) {
    XcdBarrier b; b.bar = bar; b.x = xb_xcc_id(); b.st = st;
    if (threadIdx.x == 0) (void)xb_add(&bar[XB_XCNT(b.x)], 1u);
    return b;
}
__device__ __forceinline__ void xcd_barrier_complete(unsigned* bar, unsigned x, unsigned& nloc, unsigned& nx) {
    const unsigned G = gridDim.x * gridDim.y * gridDim.z;
    unsigned sum, cnt, mine, sp = 0u;
    for (;;) {
        sum = 0u; cnt = 0u; mine = 0u;
#pragma unroll
        for (unsigned j = 0; j < 16; ++j) { const unsigned c = xb_ld(&bar[XB_XCNT(j)]); sum += c; cnt += (c > 0u) ? 1u : 0u; mine = (j == x) ? c : mine; }
        if (sum == G) break;
        __builtin_amdgcn_s_sleep(1);
        if ((++sp & 255u) == 0u) { if (xb_ld(&bar[XB_TMO])) break; if (sp > XB_SPIN_CAP) { atomicAdd(&bar[XB_TMO], 1u); break; } }
    }
    nloc = mine > 0u ? mine : 1u; nx = cnt > 0u ? cnt : 1u;
}

__device__ __forceinline__ void xcd_barrier(const XcdBarrier& b) {
    asm volatile("s_waitcnt vmcnt(0)" ::: "memory");
    __syncthreads();
    if (threadIdx.x == 0) {
        unsigned* bar = b.bar;
        __builtin_amdgcn_s_waitcnt(0);
        unsigned nloc = b.st[0], nx = b.st[1];
        if (nloc == 0u) { xcd_barrier_complete(bar, b.x, nloc, nx); b.st[0] = nloc; b.st[1] = nx; }
        const unsigned old = xb_add(&bar[XB_XSUB(b.x)], 1u);
        const unsigned gen = old / nloc;
        if (old + 1u == (gen + 1u) * nloc) {
            __builtin_amdgcn_fence(__ATOMIC_RELEASE, "agent");
            asm volatile("s_waitcnt vmcnt(0)" ::: "memory");
            const unsigned og = xb_add(&bar[XB_TOP], 1u);
            const unsigned tg = og / nx;
            if (og + 1u == (tg + 1u) * nx) xb_add(&bar[XB_TOPGEN], 1u);
            else XB_SPIN(xb_ld(&bar[XB_TOPGEN]) == tg, bar);
            __builtin_amdgcn_fence(__ATOMIC_ACQUIRE, "agent");
            xb_add(&bar[XB_XGEN(b.x)], 1u);
            asm volatile("s_waitcnt vmcnt(0)" ::: "memory");
        } else {
            XB_SPIN(xb_ld(&bar[XB_XGEN(b.x)]) == gen, bar);
            __builtin_amdgcn_fence(__ATOMIC_ACQUIRE, "agent");
            asm volatile("s_waitcnt vmcnt(0)" ::: "memory");
        }
    }
    __syncthreads();
}
__device__ __forceinline__ unsigned fkey(float f) { const unsigned u = __float_as_uint(f); return (u & 0x80000000u) ? ~u : (u | 0x80000000u); }
__device__ __forceinline__ void idx_item(Frame& F, int b, int rg) {
    const bf16_t* IQ = (const bf16_t*)(F.ws + WS_P + P_IQ); const bf16_t* IK = (const bf16_t*)(F.ws + WS_P + P_IK); const float* IW = (const float*)(F.ws + WS_P + P_IW);
    u64* maskT = (u64*)(F.ws + WS_MASK);
    LAS unsigned* cnt = (LAS unsigned*)F.lds;
    LAS unsigned* mgt = (LAS unsigned*)(F.lds + 1024);
    LAS unsigned* meq = (LAS unsigned*)(F.lds + 1024 + 8192);
    const int t0 = rg * 16, wid = F.wave, lane = F.lane, qj = lane & 15, g4 = lane >> 4;
    const int n64 = ((t0 >> 8) + 1) * 4;
    if (rg < 16) {
        for (int idx = F.tid; idx < 16 * n64; idx += NTHR) { const int row = idx & 15, j64 = idx >> 4, t = t0 + row; const int rel = t - 64 * j64;
            const u64 mk = rel >= 63 ? ~0ull : (rel < 0 ? 0ull : ((1ull << (rel + 1)) - 1ull));
            maskT[((size_t)b * 64 + j64) * SEQ + t] = mk; }
        return;
    }
    for (int i = F.tid; i < 4096; i += NTHR) mgt[i] = 0u;
    const size_t qrow = (size_t)b * SEQ + t0 + qj;
    float wq[8];
    { const f32x4 w0 = *(const f32x4*)(IW + qrow * 8), w1 = *(const f32x4*)(IW + qrow * 8 + 4); const float sc = 0.04419417382415922f;
      wq[0] = w0[0] * sc; wq[1] = w0[1] * sc; wq[2] = w0[2] * sc; wq[3] = w0[3] * sc; wq[4] = w1[0] * sc; wq[5] = w1[1] * sc; wq[6] = w1[2] * sc; wq[7] = w1[3] * sc; }
    const int ntile = rg + 1;
    const char* kbase = (const char*)IK + ((size_t)b * SEQ + wid * 16) * 128; const unsigned loff = (unsigned)(qj * 128 + g4 * 16);
    unsigned sc[32][4];
#pragma unroll
    for (int hp = 0; hp < 2; ++hp) {
        bf16x8 Bq[4][2];
#pragma unroll
        for (int h = 0; h < 4; ++h)
#pragma unroll
            for (int ks = 0; ks < 2; ++ks) Bq[h][ks] = *(const bf16x8*)(IQ + qrow * 512 + (4 * hp + h) * 64 + ks * 32 + g4 * 8);
#pragma unroll
        for (int j = 0; j < 32; ++j) {
            const int tile = wid + 8 * j;
            if (tile < ntile) {
                const char* kp = kbase + (size_t)j * 16384;
                const bf16x8 A0 = *(const bf16x8*)(kp + loff), A1 = *(const bf16x8*)(kp + loff + 64);
                f32x4 s = {0.f, 0.f, 0.f, 0.f};
                if (hp) {
#pragma unroll
                    for (int i = 0; i < 4; ++i) s[i] = __uint_as_float(sc[j][i]); }
#pragma unroll
                for (int h = 0; h < 4; ++h) { f32x4 a = __builtin_amdgcn_mfma_f32_16x16x32_bf16(A0, Bq[h][0], (f32x4){0.f, 0.f, 0.f, 0.f}, 0, 0, 0);
                    a = __builtin_amdgcn_mfma_f32_16x16x32_bf16(A1, Bq[h][1], a, 0, 0, 0);
#pragma unroll
                    for (int i = 0; i < 4; ++i) s[i] += wq[4 * hp + h] * fmaxf(a[i], 0.f); }
                if (hp == 1) {
                    if (tile == rg) {
#pragma unroll
                        for (int i = 0; i < 4; ++i) if (4 * g4 + i > qj) s[i] = -__builtin_inff(); }
#pragma unroll
                    for (int i = 0; i < 4; ++i) sc[j][i] = fkey(s[i]);
                } else {
#pragma unroll
                    for (int i = 0; i < 4; ++i) sc[j][i] = __float_as_uint(s[i]);
                }
            } else {
#pragma unroll
                for (int i = 0; i < 4; ++i) sc[j][i] = 0u;
            }
            asm volatile("" ::: "memory");
        }
    }
    unsigned prefix = 0u;
    for (int bit = 31; bit >= 0; --bit) {
        const unsigned cand = prefix | (1u << bit); unsigned c = 0u;
#pragma unroll
        for (int j = 0; j < 32; ++j)
#pragma unroll
            for (int i = 0; i < 4; ++i) c += (sc[j][i] >= cand) ? 1u : 0u;
        c += __shfl_xor(c, 16); c += __shfl_xor(c, 32);
        if (lane < 16) cnt[(bit & 1) * 128 + wid * 16 + lane] = c;
        __syncthreads();
        unsigned tot = 0u;
#pragma unroll
        for (int w = 0; w < 8; ++w) tot += cnt[(bit & 1) * 128 + w * 16 + qj];
        if (tot >= (unsigned)TOPK) prefix = cand;
    }
    const unsigned T = prefix;
    unsigned cg = 0u;
#pragma unroll
    for (int j = 0; j < 32; ++j)
#pragma unroll
        for (int i = 0; i < 4; ++i) cg += (sc[j][i] > T) ? 1u : 0u;
    cg += __shfl_xor(cg, 16); cg += __shfl_xor(cg, 32);
    __syncthreads();
    if (lane < 16) cnt[wid * 16 + lane] = cg;
    LAS unsigned* mbase = mgt + qj * 128 + (wid >> 1); const int sh0 = (wid & 1) * 16 + 4 * g4;
#pragma unroll
    for (int j = 0; j < 32; ++j) {
        const int tile = wid + 8 * j;
        if (tile < ntile) {
            unsigned g = 0u, e = 0u;
#pragma unroll
            for (int i = 0; i < 4; ++i) { g |= (sc[j][i] > T ? 1u : 0u) << i; e |= (sc[j][i] == T ? 1u : 0u) << i; }
            if (g) __hip_atomic_fetch_or(mbase + 4 * j, g << sh0, __ATOMIC_RELAXED, __HIP_MEMORY_SCOPE_WORKGROUP);
            if (e) __hip_atomic_fetch_or(mbase + 2048 + 4 * j, e << sh0, __ATOMIC_RELAXED, __HIP_MEMORY_SCOPE_WORKGROUP);
        }
    }
    __syncthreads();
    if (wid == 0 && lane < 16) {
        unsigned gt = 0u;
#pragma unroll
        for (int w = 0; w < 8; ++w) gt += cnt[w * 16 + lane];
        int need = TOPK - (int)gt, taken = 0; const int nw = (t0 + 16 + 31) >> 5;
        for (int wd = 0; wd < nw; ++wd) { unsigned e = meq[lane * 128 + wd]; if (!e) continue; int c = __popc(e);
            if (taken + c > need) { unsigned keep = 0u; int rem = need - taken; while (rem > 0) { const unsigned low = e & (0u - e); keep |= low; e ^= low; --rem; } e = keep; c = __popc(keep); }
            taken += c; mgt[lane * 128 + wd] |= e; }
    }
    __syncthreads();
    for (int idx = F.tid; idx < 16 * n64; idx += NTHR) { const int row = idx & 15, j64 = idx >> 4;
        const u64 mk = (u64)mgt[row * 128 + 2 * j64] | ((u64)mgt[row * 128 + 2 * j64 + 1] << 32);
        maskT[((size_t)b * 64 + j64) * SEQ + t0 + row] = mk; }
    __syncthreads();
}
__device__ __forceinline__ void ph_idx(Frame& F) {
    for (int c = F.bid; c < 256; c += F.G) { const int b = c & 3, base = c >> 2;
        idx_item(F, b, 255 - base); idx_item(F, b, 128 + base); idx_item(F, b, 127 - base); idx_item(F, b, base); }
}
namespace att {
constexpr int HD = 128, RS = 1024;
constexpr float SCALE = 0.08838834764831845f, THR = 8.f;
constexpr int NW = 8, QBLK = 32, KVBLK = 64, QB = NW * QBLK;
constexpr int SHM_V = KVBLK * HD * 2, SHM_K = KVBLK * HD * 2;
constexpr int LDS_ATT = 2 * SHM_V + 2 * SHM_K + NW * 64 * 4;
constexpr int LDS_TB = LDS_ATT;
typedef float f32x16 __attribute__((ext_vector_type(16)));
#define KSWZ(row, colB) ((row) * 256 + ((colB) ^ (((row) & 7) << 4)))
#define SBAR() __builtin_amdgcn_sched_barrier(0)
__device__ __forceinline__ int v_st(int k, int c) { const int kk = (k & ~0xC) | ((k & 4) << 1) | ((k & 8) >> 1); return ((kk >> 3) * 4 + (c >> 5)) * 512 + ((kk & 7) * 32 + (c & 31)) * 2; }
__device__ __forceinline__ int v_rd_base(int lane) { return ((lane & 3) << 3) | (((lane >> 2) & 3) << 6) | (((lane >> 4) & 1) << 5) | (((lane >> 5) & 1) << 8); }
constexpr int v_rd_off(int d0, int ks, int half) { return d0 * 512 + ks * 4096 + half * 2048; }
__device__ __forceinline__ int crow(int r, int hi) { return (r & 3) + 8 * (r >> 2) + 4 * hi; }
__device__ __forceinline__ bf16x8 load8(const bf16_t* p) { return *reinterpret_cast<const bf16x8*>(p); }
__device__ __forceinline__ void mask_bits(f32x16& p0, f32x16& p1, u64 mk, int hi) {
    const unsigned lo = (unsigned)mk >> (4 * hi), hh = (unsigned)(mk >> 32) >> (4 * hi);
#pragma unroll
    for (int r = 0; r < 16; ++r) { const int c = (r & 3) + 8 * (r >> 2);
        const unsigned m0 = (unsigned)((int)(lo << (31 - c)) >> 31), m1 = (unsigned)((int)(hh << (31 - c)) >> 31);
        p0[r] = __uint_as_float((__float_as_uint(p0[r]) & m0) | (0xff800000u & ~m0));
        p1[r] = __uint_as_float((__float_as_uint(p1[r]) & m1) | (0xff800000u & ~m1)); }
}
__device__ __forceinline__ void add_bias(f32x16& p0, f32x16& p1, const LAS float* tbq) {
#pragma unroll
    for (int r = 0; r < 16; ++r) { const int c = (r & 3) + 8 * (r >> 2); p0[r] += tbq[-c]; p1[r] += tbq[-c - 32]; }
}
__device__ __forceinline__ void partialSM(f32x16& p0, f32x16& p1, float& m_reg, float& mn, float& alpha) {
    float pmax = p0[0]; for (int r = 1; r < 16; ++r) pmax = fmaxf(pmax, p0[r]); for (int r = 0; r < 16; ++r) pmax = fmaxf(pmax, p1[r]);
    { auto rr = __builtin_amdgcn_permlane32_swap(__float_as_uint(pmax), __float_as_uint(pmax), false, false);
      pmax = fmaxf(__uint_as_float(rr[0]), __uint_as_float(rr[1])); }
    constexpr float C2 = 1.4426950408889634f * SCALE;
    if (__builtin_expect(__all((pmax - m_reg) * SCALE <= THR), 1)) { mn = m_reg; alpha = 1.f; }
    else { mn = fmaxf(m_reg, pmax); alpha = __builtin_amdgcn_exp2f((m_reg - mn) * C2); m_reg = mn; }
    const float mnL = -mn * C2;
    for (int r = 0; r < 16; ++r) p0[r] = fmaf(p0[r], C2, mnL); for (int r = 0; r < 16; ++r) p1[r] = fmaf(p1[r], C2, mnL);
    for (int r = 0; r < 16; ++r) p0[r] = __builtin_amdgcn_exp2f(p0[r]);
}
__device__ __forceinline__ void finishSM(f32x16& p0, f32x16& p1, float alpha, float& l_reg, bf16x8& pa0, bf16x8& pa1, bf16x8& pa2, bf16x8& pa3) {
    for (int r = 0; r < 16; ++r) p1[r] = __builtin_amdgcn_exp2f(p1[r]);
    float ps = 0; for (int r = 0; r < 16; ++r) ps += p0[r]; for (int r = 0; r < 16; ++r) ps += p1[r];
    { auto rr = __builtin_amdgcn_permlane32_swap(__float_as_uint(ps), __float_as_uint(ps), false, false);
      ps = __uint_as_float(rr[0]) + __uint_as_float(rr[1]); }
    l_reg = l_reg * alpha + ps;
#define PK4(P, B_, OUT) do { unsigned a0 = cvt_pk_bf16(P[B_+0], P[B_+1]), a1 = cvt_pk_bf16(P[B_+2], P[B_+3]);                          \
        unsigned b0 = cvt_pk_bf16(P[B_+4], P[B_+5]), b1 = cvt_pk_bf16(P[B_+6], P[B_+7]);                                             \
        auto r0 = __builtin_amdgcn_permlane32_swap(a0, b0, false, false); auto r1 = __builtin_amdgcn_permlane32_swap(a1, b1, false, false); \
        u32x4 w = {r0[0], r1[0], r0[1], r1[1]}; OUT = *reinterpret_cast<bf16x8*>(&w); } while (0)
    PK4(p0, 0, pa0); PK4(p0, 8, pa1); PK4(p1, 0, pa2); PK4(p1, 8, pa3);
#undef PK4
}
template <int KB>
__device__ __forceinline__ void qkt(f32x16& p0, f32x16& p1, const char* K_lds, int r32, int hi, const bf16x8* qr) {
    p0 = f32x16{}; p1 = f32x16{};
    const char* kb[4];
#pragma unroll
    for (int dd = 0; dd < 4; ++dd) kb[dd] = K_lds + KB * SHM_K + KSWZ(r32, (dd * 16 + hi * 8) * 2);
#pragma unroll
    for (int d0 = 0; d0 < 8; ++d0) { const char* a = kb[d0 & 3] + (d0 >> 2) * 128;
        bf16x8 b0 = *reinterpret_cast<const bf16x8*>(a);
        bf16x8 b1 = *reinterpret_cast<const bf16x8*>(a + 32 * 256);
        p0 = __builtin_amdgcn_mfma_f32_32x32x16_bf16(b0, qr[d0], p0, 0, 0, 0);
        p1 = __builtin_amdgcn_mfma_f32_32x32x16_bf16(b1, qr[d0], p1, 0, 0, 0); }
}
template <int VB>
__device__ __forceinline__ void pv_tile(f32x16* o, int vb0, bf16x8 pa0, bf16x8 pa1, bf16x8 pa2, bf16x8 pa3) {
#define TRRD(dst, off) asm volatile("ds_read_b64_tr_b16 %0, %1 offset:%2" : "=&v"(dst) : "v"(vb0), "i"(off) : "memory")
#define PV_D0(d0) do { s16x4 l0, l1, h0, h1; constexpr int b_ = VB * SHM_V + v_rd_off(d0, 0, 0); \
        TRRD(l0, b_); TRRD(h0, b_ + 2048); TRRD(l1, b_ + 4096); TRRD(h1, b_ + 6144); \
        asm volatile("s_waitcnt lgkmcnt(0)" ::: "memory"); SBAR();   \
        o[d0] = __builtin_amdgcn_mfma_f32_32x32x16_bf16(pa0, (bf16x8){l0[0], l0[1], l0[2], l0[3], h0[0], h0[1], h0[2], h0[3]}, o[d0], 0, 0, 0);   \
        o[d0] = __builtin_amdgcn_mfma_f32_32x32x16_bf16(pa1, (bf16x8){l1[0], l1[1], l1[2], l1[3], h1[0], h1[1], h1[2], h1[3]}, o[d0], 0, 0, 0);   \
        SBAR(); TRRD(l0, b_ + 8192); TRRD(h0, b_ + 10240); TRRD(l1, b_ + 12288); TRRD(h1, b_ + 14336); \
        asm volatile("s_waitcnt lgkmcnt(0)" ::: "memory"); SBAR();   \
        o[d0] = __builtin_amdgcn_mfma_f32_32x32x16_bf16(pa2, (bf16x8){l0[0], l0[1], l0[2], l0[3], h0[0], h0[1], h0[2], h0[3]}, o[d0], 0, 0, 0);   \
        o[d0] = __builtin_amdgcn_mfma_f32_32x32x16_bf16(pa3, (bf16x8){l1[0], l1[1], l1[2], l1[3], h1[0], h1[1], h1[2], h1[3]}, o[d0], 0, 0, 0); } while (0)
    PV_D0(0); PV_D0(1); PV_D0(2); PV_D0(3);
#undef PV_D0
#undef TRRD
}
struct BlockRef { const bf16_t* Q; const bf16_t* K; const bf16_t* V; bf16_t* O; const u64* MK; int P0; int h; };
struct Seam { bf16x8 qr[8]; bf16x8 st_v0, st_v1, st_k0, st_k1; };
#define LD16U(base, off) (*(const bf16x8*)((const char*)(base) + (off)))
#define VMW() asm volatile("s_waitcnt vmcnt(0)" ::: "memory")
#define TIDL() ({ int t__ = threadIdx.x; asm volatile("" : "+v"(t__)); t__; })
#define SLOAD_H(Kp, Vp, k0) do { const int t_ = TIDL(); const unsigned klo_ = (unsigned)((t_ >> 4) * RS + (t_ & 15) * 8) * 2u;   \
        const char* kb_ = (const char*)(Kp) + (size_t)(k0) * (RS * 2); const char* vb_ = (const char*)(Vp) + (size_t)(k0) * (RS * 2);   \
        S.st_v0 = LD16U(vb_, klo_); S.st_v1 = LD16U(vb_ + 32 * RS * 2, klo_); S.st_k0 = LD16U(kb_, klo_); S.st_k1 = LD16U(kb_ + 32 * RS * 2, klo_); } while (0)
#define SWRITE_HK(bf) do { const int t_ = TIDL(); const int kws_ = KSWZ(t_ >> 4, (t_ & 15) * 16); *(bf16x8*)(K_lds + (bf) * SHM_K + kws_) = S.st_k0; *(bf16x8*)(K_lds + (bf) * SHM_K + kws_ + 32 * 256) = S.st_k1; } while (0)
#define SWRITE_HV(bf) do { const int t_ = TIDL(); const int sr_ = t_ >> 4, sc_ = (t_ & 15) * 8; *(bf16x8*)(V_lds + (bf) * SHM_V + v_st(sr_, sc_)) = S.st_v0; *(bf16x8*)(V_lds + (bf) * SHM_V + v_st(32 + sr_, sc_)) = S.st_v1; } while (0)
#define SWRITE_H(bf) do { SWRITE_HV(bf); SWRITE_HK(bf); } while (0)
#define QLOAD(Qp) do { const int t_ = TIDL(); const unsigned qlo_ = (unsigned)((t_ & 31) * RS + ((t_ >> 5) & 1) * 8) * 2u; const char* qb_ = (const char*)(Qp) + (size_t)(wid * QBLK) * (RS * 2); \
        _Pragma("unroll") for (int d0 = 0; d0 < 8; ++d0) S.qr[d0] = LD16U(qb_ + d0 * 32, qlo_); } while (0)
__device__ __forceinline__ void att_prime(const BlockRef& cur, char* lds, Seam& S) {
    const int tid = threadIdx.x, wid = __builtin_amdgcn_readfirstlane(tid >> 6); char* K_lds = lds + 2 * SHM_V;
    QLOAD(cur.Q);
    SLOAD_H(cur.K, cur.V, 0); VMW(); SWRITE_HK(0);
    __syncthreads();
}
__device__ __forceinline__ void att_block(const BlockRef& cur, const BlockRef& nxt, char* lds, const LAS float* tbl, Seam& S) {
    const int tid = threadIdx.x, wid = __builtin_amdgcn_readfirstlane(tid >> 6), lane = tid & 63, r32 = lane & 31, hi = lane >> 5;
    const int NT = cur.P0 / KVBLK + 4;
    const int qlo = cur.P0 + wid * QBLK;
    char* V_lds = lds; char* K_lds = lds + 2 * SHM_V;
    float* ws = (float*)(lds + 2 * SHM_V + 2 * SHM_K) + wid * 64; float* li_l = ws, * al_l = ws + 32;
    float m_reg = -1e30f, l_reg = 0; f32x16 o[4] = {};
    const int vb0 = (int)(uintptr_t)V_lds + v_rd_base(lane);
    const bf16_t* Kh = cur.K; const bf16_t* Vh = cur.V;
    const char* mkb = (const char*)(cur.MK + qlo);
#define LDMK(j) (*(const u64*)(mkb + (size_t)(j) * (SEQ * 8) + (unsigned)(TIDL() & 31) * 8u))
#define RESC(a) do { if (__any((a) < 1.f)) { if (hi == 0) al_l[r32] = (a); asm volatile("s_waitcnt lgkmcnt(0)" ::: "memory");              \
                     for (int d_ = 0; d_ < 4; ++d_) for (int r = 0; r < 16; ++r) o[d_][r] *= al_l[crow(r, hi)]; } } while (0)
#define KBASE(t) ((t) * KVBLK)
#define MASKT(P0_, P1_, t, MK_) do { const int kb_ = KBASE(t); if (kb_ + 176 > qlo) { const int t_ = TIDL(); add_bias(P0_, P1_, tbl + cur.h * 512 + 256 + (qlo + (t_ & 31) - 4 * ((t_ >> 5) & 1) - kb_)); } mask_bits(P0_, P1_, MK_, hi); } while (0)
#define VMWN8() asm volatile("s_waitcnt vmcnt(8)" ::: "memory")
#define SEAM_K0() do { VMWN8(); SWRITE_HK(0); SBAR(); } while (0)
    f32x16 pA0, pA1, pB0, pB1; float mnA, mnB, alA, alB; bf16x8 pa0, pa1, pa2, pa3;
    u64 mk_ = LDMK(0);
    SWRITE_HV(0); SBAR();
    SLOAD_H(Kh, Vh, KBASE(1));
    SBAR(); qkt<0>(pA0, pA1, K_lds, r32, hi, S.qr);
    MASKT(pA0, pA1, 0, mk_); partialSM(pA0, pA1, m_reg, mnA, alA);
    VMW(); SWRITE_H(1);
    __syncthreads();
#define HALF_STEP(PX0, PX1, mnX, alX, PY0, PY1, alY, t, KB, VB, SB) do {                                                      \
        mk_ = LDMK(t); SBAR(); qkt<KB>(PX0, PX1, K_lds, r32, hi, S.qr);                                                                      \
        finishSM(PY0, PY1, alY, l_reg, pa0, pa1, pa2, pa3); SBAR();                                                           \
        if ((t) + 1 < NT) { SLOAD_H(Kh, Vh, KBASE((t) + 1)); SBAR(); }                                                        \
        pv_tile<VB>(o, vb0, pa0, pa1, pa2, pa3); MASKT(PX0, PX1, (t), mk_);                                                   \
        partialSM(PX0, PX1, m_reg, mnX, alX);                                                                                 \
        __syncthreads();                                                                                                      \
        if ((t) + 1 < NT) { VMW(); SWRITE_H(SB); }                                                                            \
        RESC(alX); __syncthreads(); } while (0)
    for (int t = 1; t + 1 < NT; t += 2) {
        HALF_STEP(pB0, pB1, mnB, alB, pA0, pA1, alA, t, 1, 0, 0);
        HALF_STEP(pA0, pA1, mnA, alA, pB0, pB1, alB, t + 1, 0, 1, 1);
    }
    mk_ = LDMK(NT - 1); SBAR(); qkt<1>(pB0, pB1, K_lds, r32, hi, S.qr); SBAR();
    SLOAD_H(nxt.K, nxt.V, 0); SBAR();
    QLOAD(nxt.Q);
    SBAR();
    finishSM(pA0, pA1, alA, l_reg, pa0, pa1, pa2, pa3); SBAR();
    pv_tile<0>(o, vb0, pa0, pa1, pa2, pa3);
    MASKT(pB0, pB1, NT - 1, mk_); partialSM(pB0, pB1, m_reg, mnB, alB); __syncthreads(); RESC(alB);
    finishSM(pB0, pB1, alB, l_reg, pa0, pa1, pa2, pa3); SBAR(); pv_tile<1>(o, vb0, pa0, pa1, pa2, pa3);
    SBAR(); SEAM_K0();
    if (hi == 0) li_l[r32] = l_reg; asm volatile("s_waitcnt lgkmcnt(0)" ::: "memory");
    float rli[16];
#pragma unroll
    for (int r = 0; r < 16; ++r) rli[r] = __builtin_amdgcn_rcpf(li_l[crow(r, hi)]);
    char* Ow = (char*)cur.O + (size_t)(wid * QBLK) * (RS * 2); const unsigned olo = (unsigned)(4 * ((TIDL() >> 5) & 1) * RS + (TIDL() & 31)) * 2u;
#pragma unroll
    for (int r = 0; r < 16; ++r) { const int orow0 = (r & 3) + 8 * (r >> 2);
#pragma unroll
        for (int d0 = 0; d0 < 4; ++d0) { const float v = o[d0][r] * rli[r]; const float vn = __shfl_xor(v, 1);
            if ((r32 & 1) == 0) *(unsigned*)(Ow + (size_t)orow0 * (RS * 2) + d0 * 64 + olo) = cvt_pk_bf16(v, vn); } }
    __syncthreads();
#undef LDMK
#undef RESC
#undef KBASE
#undef MASKT
#undef VMWN8
#undef SEAM_K0
#undef HALF_STEP
}
#undef LD16U
#undef VMW
#undef SLOAD_H
#undef SWRITE_HK
#undef SWRITE_HV
#undef SWRITE_H
#undef QLOAD
#undef TIDL
}
__device__ __forceinline__ void ph_att(Frame& F, char* lds) {
    const bf16_t* QA = (const bf16_t*)(F.ws + WS_P + P_QA); const bf16_t* KA = (const bf16_t*)(F.ws + WS_P + P_KA); const bf16_t* VA = (const bf16_t*)(F.ws + WS_P + P_VA);
    bf16_t* OA = (bf16_t*)(F.ws + WS_OA); const u64* maskT = (const u64*)(F.ws + WS_MASK); const float* tbg = (const float*)(F.ws + WS_TB);
    LAS float* tbl = (LAS float*)(F.lds + att::LDS_TB);
    for (int i = F.tid; i < 8 * 512; i += NTHR) { const int rel = (i & 511) - 256; tbl[i] = (rel >= 0 && rel < 128) ? tbg[(i >> 9) * 128 + rel] : 0.f; }
    __syncthreads();
    for (int c = F.bid; c < 256; c += F.G) {
        const int b = c >> 6, h = (c >> 3) & 7, x = c & 7;
        att::BlockRef r0, r1;
        { const int xb = 15 - x; const size_t ro = ((size_t)b * SEQ + 256 * xb) * 1024 + h * 128;
          r0.Q = QA + ro; r0.O = OA + ro; r0.K = KA + (size_t)b * SEQ * 1024 + h * 128; r0.V = VA + (size_t)b * SEQ * 1024 + h * 128; r0.MK = maskT + (size_t)b * 64 * SEQ; r0.P0 = 256 * xb; r0.h = h; }
        { const int xb = x; const size_t ro = ((size_t)b * SEQ + 256 * xb) * 1024 + h * 128;
          r1 = r0; r1.Q = QA + ro; r1.O = OA + ro; r1.P0 = 256 * xb; }
        att::Seam S;
        att::att_prime(r0, lds, S);
        for (int k = 0; k < 2; ++k) { att::att_block(r0, r1, lds, tbl, S); r0 = r1; }
    }
}
__device__ __forceinline__ f32x4 mfma16(bf16x8 a, bf16x8 b, f32x4 c) { return __builtin_amdgcn_mfma_f32_16x16x32_bf16(a, b, c, 0, 0, 0); }
__device__ __forceinline__ void ph_hprep(Frame& F) {
    bf16_t* BQ = (bf16_t*)(F.ws + WS_P + P_BQ); bf16_t* BG = (bf16_t*)(F.ws + WS_P + P_BG);
    bf16_t* HA = (bf16_t*)(F.ws + WS_HA); float* HDEC = (float*)(F.ws + WS_HDEC);
    LAS float* wsum = (LAS float*)F.lds;
    LAS unsigned char* qt = F.lds + 4096;
    LAS unsigned char* kt = F.lds + 4096 + 64 * 272;
    const int w = F.wave, lane = F.lane, cp = lane;
    for (int it = F.bid; it < 2048; it += F.G) {
        const int bh = it >> 6, ch = it & 63, b = bh >> 3, h = bh & 7;
        const size_t base = ((size_t)b * SEQ + ch * 64 + 8 * w) * 1024 + h * 128 + 2 * cp;
        float g0[8], g1[8], q0[8], q1[8];
#pragma unroll
        for (int r = 0; r < 8; ++r) { const unsigned gw = *(const unsigned*)(BG + base + (size_t)r * 1024), qw = *(const unsigned*)(BQ + base + (size_t)r * 1024);
            g0[r] = bflo(gw); g1[r] = bfhi(gw); q0[r] = bflo(qw); q1[r] = bfhi(qw); }
        float c0 = 0.f, c1 = 0.f, bl0[8], bl1[8];
#pragma unroll
        for (int r = 0; r < 8; ++r) { c0 += g0[r]; c1 += g1[r]; bl0[r] = c0; bl1[r] = c1; }
        wsum[w * 128 + 2 * cp] = c0; wsum[w * 128 + 2 * cp + 1] = c1;
        __syncthreads();
        float off0 = 0.f, off1 = 0.f, mid0 = 0.f, mid1 = 0.f, last0 = 0.f, last1 = 0.f;
#pragma unroll
        for (int ww = 0; ww < 8; ++ww) { const float s0 = wsum[ww * 128 + 2 * cp], s1 = wsum[ww * 128 + 2 * cp + 1];
            if (ww < w) { off0 += s0; off1 += s1; } if (ww < 4) { mid0 += s0; mid1 += s1; } last0 += s0; last1 += s1; }
#pragma unroll
        for (int r = 0; r < 8; ++r) {
            const float b0 = bl0[r] + off0, b1 = bl1[r] + off1;
            const float k0 = 1.f - __expf(g0[r]), k1 = 1.f - __expf(g1[r]);
            *(unsigned*)(BQ + base + (size_t)r * 1024) = cvt_pk_bf16(q0[r] * __expf(b0), q1[r] * __expf(b1));
            *(unsigned*)(BG + base + (size_t)r * 1024) = cvt_pk_bf16(k0 * __expf(last0 - b0), k1 * __expf(last1 - b1));
            *(LAS unsigned*)(qt + (8 * w + r) * 272 + 4 * cp) = cvt_pk_bf16(q0[r] * __expf(b0 - mid0), q1[r] * __expf(b1 - mid1));
            *(LAS unsigned*)(kt + (8 * w + r) * 272 + 4 * cp) = cvt_pk_bf16(k0 * __expf(mid0 - b0), k1 * __expf(mid1 - b1));
        }
        if (w == 0) { HDEC[(size_t)it * 128 + 2 * cp] = __expf(last0); HDEC[(size_t)it * 128 + 2 * cp + 1] = __expf(last1); }
        __syncthreads();
        { const int tt = w & 3, fr = lane & 15, g4 = lane >> 4;
          bf16x8 qf[4];
#pragma unroll
          for (int ks = 0; ks < 4; ++ks) qf[ks] = *(const LAS bf16x8*)(qt + (16 * tt + fr) * 272 + (32 * ks + 8 * g4) * 2);
#pragma unroll
          for (int si = 0; si < 2; ++si) { const int st = 2 * (w >> 2) + si; f32x4 acc = {0.f, 0.f, 0.f, 0.f};
#pragma unroll
              for (int ks = 0; ks < 4; ++ks) { const bf16x8 kf = *(const LAS bf16x8*)(kt + (16 * st + fr) * 272 + (32 * ks + 8 * g4) * 2); acc = mfma16(kf, qf[ks], acc); }
              const int t = 16 * tt + fr, s0 = 16 * st + 4 * g4;
              float x[4];
#pragma unroll
              for (int i = 0; i < 4; ++i) x[i] = (s0 + i <= t) ? acc[i] : 0.f;
              u32x2 o; o.x = cvt_pk_bf16(x[0], x[1]); o.y = cvt_pk_bf16(x[2], x[3]);
              *(u32x2*)(HA + ((size_t)it * 64 + t) * 64 + s0) = o; } }
        __syncthreads();
    }
}
__device__ __forceinline__ void ph_rprep(Frame& F) {
    const bf16_t* CQ = (const bf16_t*)(F.ws + WS_P + P_CQ); const bf16_t* CK = (const bf16_t*)(F.ws + WS_P + P_CK); bf16_t* RA = (bf16_t*)(F.ws + WS_RA);
    const int w = F.wave, lane = F.lane, fr = lane & 15, g4 = lane >> 4;
    for (int it = F.bid; it < 512; it += F.G) {
        const int bh = it >> 5, ch = it & 31, b = bh >> 2, h = bh & 3;
        const size_t base = ((size_t)b * SEQ + ch * 128) * 1024 + h * 256;
        const float gi = exp2f(-128.f * __log2f(1.f - exp2f(-5.f - (float)h)));
        bf16x8 qf[8];
#pragma unroll
        for (int ks = 0; ks < 8; ++ks) qf[ks] = *(const bf16x8*)(CQ + base + (size_t)(16 * w + fr) * 1024 + 32 * ks + 8 * g4);
        for (int st = 0; st < 8; ++st) {
            u32x2 o = {0u, 0u};
            const int t = 16 * w + fr, s0 = 16 * st + 4 * g4;
            if (st <= w) { f32x4 acc = {0.f, 0.f, 0.f, 0.f};
#pragma unroll
                for (int ks = 0; ks < 8; ++ks) { const bf16x8 kf = *(const bf16x8*)(CK + base + (size_t)(16 * st + fr) * 1024 + 32 * ks + 8 * g4); acc = mfma16(kf, qf[ks], acc); }
                float x[4];
#pragma unroll
                for (int i = 0; i < 4; ++i) x[i] = (s0 + i <= t) ? acc[i] * gi : 0.f;
                o.x = cvt_pk_bf16(x[0], x[1]); o.y = cvt_pk_bf16(x[2], x[3]); }
            *(u32x2*)(RA + ((size_t)it * 128 + t) * 128 + s0) = o;
        }
    }
}
template <int OFF> __device__ __forceinline__ s16x4 trrd(unsigned addr) { s16x4 r; asm volatile("ds_read_b64_tr_b16 %0, %1 offset:%2" : "=&v"(r) : "v"(addr), "i"(OFF) : "memory"); return r; }
__device__ __forceinline__ bf16x8 cat8(s16x4 a, s16x4 b) { return (bf16x8){a[0], a[1], a[2], a[3], b[0], b[1], b[2], b[3]}; }
template <int C, int DK, int LDQ, int LDV, bool VEC>
__device__ __forceinline__ void scan_item(LAS unsigned char* lds, int tid, int w, int lane, const bf16_t* Q, const bf16_t* Kt, const bf16_t* V, const bf16_t* A, const float* dec, float cdec, bf16_t* O, int nchunk) {
    constexpr int RSK = DK * 2 + 32, RSV = 72, RST = DK * 2 + 16;
    constexpr int KL = 0, VL = C * RSK, ST0 = VL + C * RSV, STB = 32 * RST;
    constexpr int NPK = C * DK / 8 / NTHR;
    constexpr int NKS_C = C / 32, NKS_D = DK / 32;
    constexpr int NDT = DK / 16 / 8;
    const int fr = lane & 15, g4 = lane >> 4, q4 = fr >> 2, p4 = lane & 3;
    const bool ow = w < C / 16;
    const int rt = ow ? w : 0;
    const unsigned ldsb = (unsigned)(uintptr_t)lds;
    const unsigned vtr = ldsb + VL + (8 * g4 + q4) * RSV + 8 * p4;
    const unsigned ktr = ldsb + KL + (8 * g4 + q4) * RSK + 8 * p4 + w * NDT * 32;
    f32x4 S[NDT][2];
#pragma unroll
    for (int i = 0; i < NDT; ++i) { S[i][0] = (f32x4){0.f, 0.f, 0.f, 0.f}; S[i][1] = (f32x4){0.f, 0.f, 0.f, 0.f}; }
    u32x4 kst[NPK], vst = {0u, 0u, 0u, 0u}; bf16x8 qf[NKS_D], af[NKS_C];
    const int vrow = tid >> 2, vpc = tid & 3;
    const unsigned klo = (unsigned)((tid / (DK / 8)) * LDQ + (tid % (DK / 8)) * 8) * 2u;
    const unsigned vlo = (unsigned)(vrow * LDV + vpc * 8) * 2u, qlo = (unsigned)(fr * LDQ + 8 * g4) * 2u, alo = (unsigned)(fr * C + 8 * g4) * 2u, olo = (unsigned)(fr * LDV + 4 * g4) * 2u;
    const unsigned klds = (unsigned)((tid / (DK / 8)) * RSK + (tid % (DK / 8)) * 16);
    constexpr int KROWS = NTHR / (DK / 8);
#define SC_LOADK(cc) do { const char* kb_ = (const char*)Kt + (size_t)(cc) * (C * LDQ * 2); _Pragma("unroll") for (int i = 0; i < NPK; ++i) kst[i] = *(const u32x4*)(kb_ + (size_t)i * (KROWS * LDQ * 2) + klo); \
        if (vrow < C) vst = *(const u32x4*)((const char*)V + (size_t)(cc) * (C * LDV * 2) + vlo); } while (0)
#define SC_LOADQ(cc) do { const char* qb_ = (const char*)Q + ((size_t)(cc) * C + 16 * rt) * (LDQ * 2); const char* ab_ = (const char*)A + ((size_t)(cc) * C + 16 * rt) * (C * 2); \
        _Pragma("unroll") for (int ks = 0; ks < NKS_D; ++ks) qf[ks] = *(const bf16x8*)(qb_ + ks * 64 + qlo); \
        _Pragma("unroll") for (int ks = 0; ks < NKS_C; ++ks) af[ks] = *(const bf16x8*)(ab_ + ks * 64 + alo); } while (0)
    SC_LOADK(0); SC_LOADQ(0);
    for (int c = 0; c < nchunk; ++c) {
        LAS unsigned char* stb = lds + ST0 + (c & 1) * STB;
#pragma unroll
        for (int i = 0; i < NDT; ++i)
#pragma unroll
            for (int ct = 0; ct < 2; ++ct) { u32x2 o; o.x = cvt_pk_bf16(S[i][ct][0], S[i][ct][1]); o.y = cvt_pk_bf16(S[i][ct][2], S[i][ct][3]);
                *(LAS u32x2*)(stb + (16 * ct + fr) * RST + (16 * (w * NDT + i) + 4 * g4) * 2) = o; }
#pragma unroll
        for (int i = 0; i < NPK; ++i) *(LAS u32x4*)(lds + KL + klds + i * (KROWS * RSK)) = kst[i];
        if (vrow < C) { *(LAS u32x2*)(lds + VL + vrow * RSV + vpc * 16) = (u32x2){vst.x, vst.y}; *(LAS u32x2*)(lds + VL + vrow * RSV + vpc * 16 + 8) = (u32x2){vst.z, vst.w}; }
        f32x4 dv[NDT];
#pragma unroll
        for (int i = 0; i < NDT; ++i) dv[i] = VEC ? *(const f32x4*)(dec + (size_t)c * DK + 16 * (w * NDT + i) + 4 * g4) : (f32x4){cdec, cdec, cdec, cdec};
        __syncthreads();
        if (c + 1 < nchunk) SC_LOADK(c + 1);
        bf16x8 vf0[NKS_C], vf1[NKS_C];
#pragma unroll
        for (int ks = 0; ks < NKS_C; ++ks) { s16x4 a0, a1, b0, b1;
            asm volatile("ds_read_b64_tr_b16 %0, %4 offset:%5\n\tds_read_b64_tr_b16 %1, %4 offset:%6\n\tds_read_b64_tr_b16 %2, %4 offset:%7\n\tds_read_b64_tr_b16 %3, %4 offset:%8\n\ts_waitcnt lgkmcnt(0)"
                         : "=&v"(a0), "=&v"(a1), "=&v"(b0), "=&v"(b1) : "v"(vtr + ks * 32 * RSV), "i"(0), "i"(4 * RSV), "i"(32), "i"(4 * RSV + 32) : "memory");
            vf0[ks] = cat8(a0, a1); vf1[ks] = cat8(b0, b1); }
        if (ow) {
            f32x4 acc0 = {0.f, 0.f, 0.f, 0.f}, acc1 = {0.f, 0.f, 0.f, 0.f};
#pragma unroll
            for (int ks = 0; ks < NKS_C; ++ks) { acc0 = mfma16(vf0[ks], af[ks], acc0); acc1 = mfma16(vf1[ks], af[ks], acc1); }
#pragma unroll
            for (int ks = 0; ks < NKS_D; ++ks) { const bf16x8 s0 = *(const LAS bf16x8*)(stb + fr * RST + (32 * ks + 8 * g4) * 2), s1 = *(const LAS bf16x8*)(stb + (16 + fr) * RST + (32 * ks + 8 * g4) * 2);
                acc0 = mfma16(s0, qf[ks], acc0); acc1 = mfma16(s1, qf[ks], acc1); }
            u32x2 o0, o1; o0.x = cvt_pk_bf16(acc0[0], acc0[1]); o0.y = cvt_pk_bf16(acc0[2], acc0[3]); o1.x = cvt_pk_bf16(acc1[0], acc1[1]); o1.y = cvt_pk_bf16(acc1[2], acc1[3]);
            char* op = (char*)O + ((size_t)c * C + 16 * rt) * (LDV * 2) + olo;
            *(u32x2*)op = o0; *(u32x2*)(op + 32) = o1;
            if (c + 1 < nchunk) SC_LOADQ(c + 1);
        }
#pragma unroll
        for (int i = 0; i < NDT; ++i) { S[i][0] *= dv[i]; S[i][1] *= dv[i];
#pragma unroll
            for (int ks = 0; ks < NKS_C; ++ks) { s16x4 a0, a1;
                asm volatile("ds_read_b64_tr_b16 %0, %2 offset:0\n\tds_read_b64_tr_b16 %1, %2 offset:%3\n\ts_waitcnt lgkmcnt(0)" : "=&v"(a0), "=&v"(a1) : "v"(ktr + ks * 32 * RSK + i * 32), "i"(4 * RSK) : "memory");
                const bf16x8 kf = cat8(a0, a1);
                S[i][0] = mfma16(kf, vf0[ks], S[i][0]); S[i][1] = mfma16(kf, vf1[ks], S[i][1]); } }
        __syncthreads();
    }
#undef SC_LOADK
#undef SC_LOADQ
}
__device__ __forceinline__ void ph_scan_ret(Frame& F) {
    for (int it = F.bid; it < 256; it += F.G) { const int bh = it >> 4, vs = it & 15, b = bh >> 2, h = bh & 3;
        const size_t tok = (size_t)b * SEQ;
        scan_item<128, 256, 1024, 2048, false>(F.lds, F.tid, F.wave, F.lane, (const bf16_t*)(F.ws + WS_P + P_CQ) + tok * 1024 + h * 256, (const bf16_t*)(F.ws + WS_P + P_CK) + tok * 1024 + h * 256,
            (const bf16_t*)(F.ws + WS_P + P_CV) + tok * 2048 + h * 512 + vs * 32, (const bf16_t*)(F.ws + WS_RA) + (size_t)bh * 32 * 128 * 128, nullptr, exp2f(128.f * __log2f(1.f - exp2f(-5.f - (float)h))),
            (bf16_t*)(F.ws + WS_OC) + tok * 2048 + h * 512 + vs * 32, 32); }
}
__device__ __forceinline__ void ph_scan_hgrn(Frame& F) {
    for (int it = F.bid; it < 128; it += F.G) { const int bh = it >> 2, vs = it & 3, b = bh >> 3, h = bh & 7;
        const size_t tok = (size_t)b * SEQ;
        scan_item<64, 128, 1024, 1024, true>(F.lds, F.tid, F.wave, F.lane, (const bf16_t*)(F.ws + WS_P + P_BQ) + tok * 1024 + h * 128, (const bf16_t*)(F.ws + WS_P + P_BG) + tok * 1024 + h * 128,
            (const bf16_t*)(F.ws + WS_P + P_BV) + tok * 1024 + h * 128 + vs * 32, (const bf16_t*)(F.ws + WS_HA) + (size_t)bh * 64 * 64 * 64, (const float*)(F.ws + WS_HDEC) + (size_t)bh * 64 * 128, 0.f,
            (bf16_t*)(F.ws + WS_OB) + tok * 1024 + h * 128 + vs * 32, 64); }
}
__device__ __forceinline__ void ph_post(Frame& F, const float* ng  ) {
    bf16_t* OB = (bf16_t*)(F.ws + WS_OB); bf16_t* OC = (bf16_t*)(F.ws + WS_OC); const bf16_t* BO = (const bf16_t*)(F.ws + WS_P + P_BO); const bf16_t* CG = (const bf16_t*)(F.ws + WS_P + P_CG);
    const int gw = F.bid * NWAVES + F.wave, NGW = F.G * NWAVES, lane = F.lane;
    for (int row = gw; row < M; row += NGW) {
        {
          const u32x4 a0 = *(const u32x4*)(OB + (size_t)row * 1024 + 16 * lane), a1 = *(const u32x4*)(OB + (size_t)row * 1024 + 16 * lane + 8);
          const u32x4 g0 = *(const u32x4*)(BO + (size_t)row * 1024 + 16 * lane), g1 = *(const u32x4*)(BO + (size_t)row * 1024 + 16 * lane + 8);
          float x[16] = {bflo(a0.x), bfhi(a0.x), bflo(a0.y), bfhi(a0.y), bflo(a0.z), bfhi(a0.z), bflo(a0.w), bfhi(a0.w), bflo(a1.x), bfhi(a1.x), bflo(a1.y), bfhi(a1.y), bflo(a1.z), bfhi(a1.z), bflo(a1.w), bfhi(a1.w)};
          const float gg[16] = {bflo(g0.x), bfhi(g0.x), bflo(g0.y), bfhi(g0.y), bflo(g0.z), bfhi(g0.z), bflo(g0.w), bfhi(g0.w), bflo(g1.x), bfhi(g1.x), bflo(g1.y), bfhi(g1.y), bflo(g1.z), bfhi(g1.z), bflo(g1.w), bfhi(g1.w)};
          float ss = 0.f;
#pragma unroll
          for (int j = 0; j < 16; ++j) ss += x[j] * x[j];
          ss += __shfl_xor(ss, 1); ss += __shfl_xor(ss, 2); ss += __shfl_xor(ss, 4);
          const float r = rsqrtf(ss * (1.f / 128.f) + EPS); const int d0 = (16 * lane) & 127;
#pragma unroll
          for (int j = 0; j < 16; ++j) x[j] = x[j] * r * ng[d0 + j] * gg[j];
          pg8::st8(OB + (size_t)row * 1024 + 16 * lane, x); pg8::st8(OB + (size_t)row * 1024 + 16 * lane + 8, x + 8); }
#pragma unroll
        for (int half = 0; half < 2; ++half) {
          const size_t o = (size_t)row * 2048 + 1024 * half + 16 * lane;
          const u32x4 a0 = *(const u32x4*)(OC + o), a1 = *(const u32x4*)(OC + o + 8), g0 = *(const u32x4*)(CG + o), g1 = *(const u32x4*)(CG + o + 8);
          float x[16] = {bflo(a0.x), bfhi(a0.x), bflo(a0.y), bfhi(a0.y), bflo(a0.z), bfhi(a0.z), bflo(a0.w), bfhi(a0.w), bflo(a1.x), bfhi(a1.x), bflo(a1.y), bfhi(a1.y), bflo(a1.z), bfhi(a1.z), bflo(a1.w), bfhi(a1.w)};
          const float gg[16] = {bflo(g0.x), bfhi(g0.x), bflo(g0.y), bfhi(g0.y), bflo(g0.z), bfhi(g0.z), bflo(g0.w), bfhi(g0.w), bflo(g1.x), bfhi(g1.x), bflo(g1.y), bfhi(g1.y), bflo(g1.z), bfhi(g1.z), bflo(g1.w), bfhi(g1.w)};
          float ss = 0.f;
#pragma unroll
          for (int j = 0; j < 16; ++j) ss += x[j] * x[j];
          ss += __shfl_xor(ss, 1); ss += __shfl_xor(ss, 2); ss += __shfl_xor(ss, 4); ss += __shfl_xor(ss, 8); ss += __shfl_xor(ss, 16);
          const float r = rsqrtf(ss * (1.f / 512.f) + EPS);
#pragma unroll
          for (int j = 0; j < 16; ++j) x[j] = x[j] * r * gg[j];
          pg8::st8(OC + o, x); pg8::st8(OC + o + 8, x + 8); }
    }
}
__device__ __forceinline__ void ph_norm2(Frame& F, int l, const float* g, const float* sc, const float* sh) {
    const float* X = (const float*)(F.ws + WS_X); bf16_t* H = (bf16_t*)(F.ws + WS_H); const bf16_t* RW = (const bf16_t*)(F.ws + WS_RW) + (size_t)l * 48 * 1024;
    const float* rgb = F.in(15) + l * 4; const float* reb = F.in(17) + l * 32;
    unsigned* ecnt = F.ctl + CW_ECNT + l * 64;
    int* tok_e = (int*)(F.ws + WS_TOK); int* tok_p = tok_e + 2 * M; float* tok_w = (float*)(tok_p + 2 * M);
    int2* rinfo = (int2*)(F.ws + WS_RINFO);
    LAS float* lg = (LAS float*)(F.lds + F.wave * 4096);
    const int lane = F.lane, fr = lane & 15, g4 = lane >> 4;
    const int gw = F.bid * NWAVES + F.wave, NGW = F.G * NWAVES;
    { int m1 = -1; asm volatile("" : "+v"(m1));
      for (int i = F.bid * NTHR + F.tid; i < XG_ROWS; i += F.G * NTHR) rinfo[i] = make_int2(m1, 0); }
    for (int it = gw; it < M / 16; it += NGW) {
        const int row = 16 * it + fr, b = row >> 12; const float* xr = X + (size_t)row * D;
        float ss = 0.f;
        for (int kk = 0; kk < 32; ++kk) { const f32x4 a = *(const f32x4*)(xr + 32 * kk + 8 * g4), c = *(const f32x4*)(xr + 32 * kk + 8 * g4 + 4);
            ss += (a[0] * a[0] + a[1] * a[1]) + (a[2] * a[2] + a[3] * a[3]) + (c[0] * c[0] + c[1] * c[1]) + (c[2] * c[2] + c[3] * c[3]); }
        ss += __shfl_xor(ss, 16); ss += __shfl_xor(ss, 32);
        const float r = rsqrtf(ss * (1.f / D) + EPS);
        f32x4 acc[3] = {{0.f, 0.f, 0.f, 0.f}, {0.f, 0.f, 0.f, 0.f}, {0.f, 0.f, 0.f, 0.f}};
        for (int kk = 0; kk < 32; ++kk) { const int c0 = 32 * kk + 8 * g4;
            float x[8]; { const f32x4 a = *(const f32x4*)(xr + c0), c = *(const f32x4*)(xr + c0 + 4); x[0] = a[0]; x[1] = a[1]; x[2] = a[2]; x[3] = a[3]; x[4] = c[0]; x[5] = c[1]; x[6] = c[2]; x[7] = c[3]; }
            const f32x4 ga = *(const f32x4*)(g + c0), gb = *(const f32x4*)(g + c0 + 4), sa = *(const f32x4*)(sc + b * 6 * D + c0), sb = *(const f32x4*)(sc + b * 6 * D + c0 + 4), ha = *(const f32x4*)(sh + b * 6 * D + c0), hb = *(const f32x4*)(sh + b * 6 * D + c0 + 4);
#pragma unroll
            for (int j = 0; j < 4; ++j) { x[j] = x[j] * r * ga[j] * (1.f + sa[j]) + ha[j]; x[4 + j] = x[4 + j] * r * gb[j] * (1.f + sb[j]) + hb[j]; }
            u32x4 wv; wv.x = cvt_pk_bf16(x[0], x[1]); wv.y = cvt_pk_bf16(x[2], x[3]); wv.z = cvt_pk_bf16(x[4], x[5]); wv.w = cvt_pk_bf16(x[6], x[7]);
            *(u32x4*)(H + (size_t)row * D + c0) = wv;
            const bf16x8 af = *reinterpret_cast<const bf16x8*>(&wv);
#pragma unroll
            for (int nt = 0; nt < 3; ++nt) { const bf16x8 bfm = *(const bf16x8*)(RW + (size_t)(16 * nt + fr) * 1024 + c0); acc[nt] = mfma16(af, bfm, acc[nt]); } }
#pragma unroll
        for (int nt = 0; nt < 3; ++nt)
#pragma unroll
            for (int i = 0; i < 4; ++i) lg[(4 * g4 + i) * 48 + 16 * nt + fr] = acc[nt][i];
        LDS_WAIT(); asm volatile("" ::: "memory");
        if (lane < 16) { const int tk = 16 * it + lane; const LAS float* q = lg + lane * 48;
            float mx = -1e30f; int gs = 0;
#pragma unroll
            for (int i = 0; i < 4; ++i) { const float v = q[i] + rgb[i]; if (v > mx) { mx = v; gs = i; } }
            float s = 0.f;
#pragma unroll
            for (int i = 0; i < 4; ++i) s += __expf(q[i] + rgb[i] - mx);
            const float gp = 1.f / s;
            float v0 = -1e30f, v1 = -1e30f; int i0 = 0, i1 = 0;
            for (int i = 0; i < 8; ++i) { const float e = q[4 + gs * 8 + i] + reb[gs * 8 + i];
                if (e > v0) { v1 = v0; i1 = i0; v0 = e; i0 = i; } else if (e > v1) { v1 = e; i1 = i; } }
            const float w1 = __expf(v1 - v0), den = 1.f / (1.f + w1);
            const int e0 = gs * 8 + i0, e1 = gs * 8 + i1;
            const unsigned p0 = __hip_atomic_fetch_add(ecnt + e0, 1u, __ATOMIC_RELAXED, __HIP_MEMORY_SCOPE_AGENT), p1 = __hip_atomic_fetch_add(ecnt + e1, 1u, __ATOMIC_RELAXED, __HIP_MEMORY_SCOPE_AGENT);
            tok_e[2 * tk] = e0; tok_e[2 * tk + 1] = e1; tok_p[2 * tk] = (int)p0; tok_p[2 * tk + 1] = (int)p1; tok_w[2 * tk] = gp * den; tok_w[2 * tk + 1] = gp * w1 * den; }
        LDS_WAIT(); asm volatile("" ::: "memory");
    }
}
__device__ __forceinline__ void ph_gather(Frame& F, int l) {
    const unsigned* ecnt = F.ctl + CW_ECNT + l * 64;
    const int* tok_e = (const int*)(F.ws + WS_TOK); const int* tok_p = tok_e + 2 * M; const float* tok_w = (const float*)(tok_p + 2 * M);
    int2* rinfo = (int2*)(F.ws + WS_RINFO); int* t2e = (int*)(F.ws + WS_T2E);
    const bf16_t* H = (const bf16_t*)(F.ws + WS_H); bf16_t* XG = (bf16_t*)(F.ws + WS_XG);
    LAS int* offs = (LAS int*)F.lds;
    if (F.tid == 0) { int o = 0; for (int e = 0; e < NE; ++e) { offs[e] = o; const int c = (int)__hip_atomic_load(ecnt + e, __ATOMIC_RELAXED, __HIP_MEMORY_SCOPE_AGENT); o += (c + 255) & ~255; } offs[NE] = o; }
    __syncthreads();
    if (F.bid == 0) { if (F.tid == 0) t2e[0] = offs[NE] >> 8;
        for (int e = F.tid; e < NE; e += NTHR) for (int rt = offs[e] >> 8; rt < (offs[e + 1] >> 8); ++rt) t2e[1 + rt] = e; }
    const int gw = F.bid * NWAVES + F.wave, NGW = F.G * NWAVES, lane = F.lane;
    for (int ts = gw; ts < 2 * M; ts += NGW) {
        const int e = tok_e[ts], p = tok_p[ts]; const int row = offs[e] + p; const int tk = ts >> 1;
        const u32x4 a = *(const u32x4*)(H + (size_t)tk * D + 8 * lane), c = *(const u32x4*)(H + (size_t)tk * D + 512 + 8 * lane);
        *(u32x4*)(XG + (size_t)row * D + 8 * lane) = a; *(u32x4*)(XG + (size_t)row * D + 512 + 8 * lane) = c;
        if (lane == 0) rinfo[row] = make_int2(ts, __float_as_int(tok_w[ts]));
    }
}
__device__ __forceinline__ int build_units(Frame& F, LAS int* tab) {
    const int* t2e = (const int*)(F.ws + WS_T2E); const int NT = t2e[0]; int n = 0;
    for (int i = 0; i < 8; ++i) { const int L = i * F.G + F.bid; if (L < 4 * NT) { const int rt = L >> 2; if (F.tid == 0) tab[i] = (rt << 8) | (t2e[1 + rt] * 4 + (L & 3)); n = i + 1; } }
    __syncthreads();
    return n;
}
#ifndef MK_ONE_LAUNCH
#define MK_ONE_LAUNCH 1
#endif
constexpr int NPHASE = 13;
__global__ void __launch_bounds__(NTHR, 2) mk_fwd(Args a) {
    extern __shared__ __attribute__((aligned(16))) unsigned char lds[];
    Frame F;
    F.lds = (LAS unsigned char*)lds; F.MISC = (volatile LAS unsigned*)(F.lds + MISC_OFF);
    F.tid = threadIdx.x; F.lane = F.tid & 63; F.wave = __builtin_amdgcn_readfirstlane(F.tid >> 6); F.G = gridDim.x; F.bid = blockIdx.x;
    F.ws = a.ws; F.ctl = (unsigned*)(a.ws + WS_CTL); F.out = a.out;
    for (int u = F.tid; u < 1024; u += NTHR) ((LAS unsigned*)(F.lds + MISC_OFF))[u] = 0u;
    __syncthreads();
#pragma unroll
    for (int i = 0; i < 22; ++i) if (F.tid == i) *(LAS u64*)(F.lds + MISC_OFF + 512 + 8 * i) = (u64)a.in[i];
    __syncthreads();
    XcdBarrier bar = xcd_barrier_post(F.ctl + CW_BAR, F.MISC + 8);
    const int lo = a.ph_lo, hi = a.ph_hi;
#ifndef SUB
#define SUB 7
#endif
#ifndef PHSEL
#define PHSEL 0xffff
#endif
#define IN(k) (((PHSEL >> (k)) & 1) && lo <= (k) && (k) < hi)
#define GRID_BAR() do { if (MK_ONE_LAUNCH) xcd_barrier(bar); asm volatile("" : "+v"(F.tid), "+v"(F.lane), "+s"(F.wave) :: "memory"); } while (0)
    unsigned char* ws = a.ws; unsigned char* wb = ws + WS_W; unsigned char* pb = ws + WS_P;
    float* X = (float*)(ws + WS_X); bf16_t* H = (bf16_t*)(ws + WS_H); bf16_t* YS = (bf16_t*)(ws + WS_YS);
    const float* mod = (const float*)(ws + WS_MOD);
    LAS int* utab = (LAS int*)(F.lds + MISC_OFF + 256);

    if (IN(0) && a.lay_lo == 0) { ph_prologue(F); GRID_BAR(); }

    for (int l = a.lay_lo; l < a.lay_hi; ++l) {
        const float* md = mod + (size_t)l * BATCH * 6 * D;
        if (IN(1)) {
            ph_conv(F, l);
            if (l == 0) ph_norm(F, F.in(0), nullptr, nullptr, nullptr, F.in(4) + l * D, md + 1 * D, md + 0 * D, H, nullptr);
            else ph_norm(F, X, YS, md - (size_t)BATCH * 6 * D + 5 * D, X, F.in(4) + l * D, md + 1 * D, md + 0 * D, H, nullptr);
            GRID_BAR();
        }
        if (IN(2)) {
            pg8::Gemm g{H, (const bf16_t*)(wb + W_IN), M, NP, D}; pg8::StaticOrder S; S.init(M, NP, F.G, F.bid);
            pg8::EpiProj E{pb, (const float*)(ws + WS_LB) + l * 1024, (const float2*)(ws + WS_ROT)};
            pg8::gemm_phase<pg8::EpiProj, pg8::StaticOrder, true, true>(F.lds, g, S, E);
            GRID_BAR();
        }
        if (IN(3)) { if (SUB & 1) ph_idx(F); if (SUB & 2) ph_hprep(F); if (SUB & 4) ph_rprep(F); GRID_BAR(); }
        if (IN(4)) { if (SUB & 1) ph_att(F, (char*)lds); if (SUB & 2) ph_scan_ret(F); if (SUB & 4) ph_scan_hgrn(F); GRID_BAR(); }
        if (IN(5)) { ph_post(F, F.in(9) + l * 128); GRID_BAR(); }
        if (IN(6)) {
            if (SUB & 1) { pg8::Gemm g{(const bf16_t*)(ws + WS_OA), (const bf16_t*)(wb + W_BA), M, D, 1024}; pg8::StaticOrder S; S.init(M, D, F.G, F.bid);
              pg8::EpiMerge<0> E{(const bf16_t*)(pb + P_GA), (float*)(ws + WS_MG), (bf16_t*)(ws + WS_MGB)};
              pg8::gemm_phase<pg8::EpiMerge<0>, pg8::StaticOrder, false, true>(F.lds, g, S, E); }
            if (SUB & 2) { pg8::Gemm g{(const bf16_t*)(ws + WS_OB), (const bf16_t*)(wb + W_BB), M, D, 1024}; pg8::StaticOrder S; S.init(M, D, F.G, F.bid);
              pg8::EpiMerge<1> E{(const bf16_t*)(pb + P_GB), (float*)(ws + WS_MG), (bf16_t*)(ws + WS_MGB)};
              pg8::gemm_phase<pg8::EpiMerge<1>, pg8::StaticOrder, false, true>(F.lds, g, S, E); }
            if (SUB & 4) { pg8::Gemm g{(const bf16_t*)(ws + WS_OC), (const bf16_t*)(wb + W_BC), M, D, 2048}; pg8::StaticOrder S; S.init(M, D, F.G, F.bid);
              pg8::EpiMerge<2> E{(const bf16_t*)(pb + P_GC), (float*)(ws + WS_MG), (bf16_t*)(ws + WS_MGB)};
              pg8::gemm_phase<pg8::EpiMerge<2>, pg8::StaticOrder, false, true>(F.lds, g, S, E); }
            GRID_BAR();
        }
        if (IN(7)) {
            pg8::Gemm g{(const bf16_t*)(ws + WS_MGB), (const bf16_t*)(wb + W_OUT), M, D, 1024}; pg8::StaticOrder S; S.init(M, D, F.G, F.bid);
            pg8::EpiRes E{l == 0 ? F.in(0) : (const float*)X, X, md + 2 * D};
            pg8::gemm_phase<pg8::EpiRes, pg8::StaticOrder, false, true>(F.lds, g, S, E);
            GRID_BAR();
        }
        if (IN(8)) { ph_norm2(F, l, F.in(5) + l * D, md + 4 * D, md + 3 * D); GRID_BAR(); }
        if (IN(9)) { ph_gather(F, l); GRID_BAR(); }
        if (IN(10)) {
            pg8::ListOrder S; S.tab = utab; S.n = build_units(F, utab);
            pg8::Gemm g{(const bf16_t*)(ws + WS_XG), (const bf16_t*)(wb + W_E1), XG_ROWS, NE * 1024, 1024};
            pg8::EpiExpUp E{(bf16_t*)(ws + WS_ACT)};
            pg8::gemm_phase<pg8::EpiExpUp, pg8::ListOrder, true, true>(F.lds, g, S, E);
            GRID_BAR();
        }
        if (IN(11)) {
            pg8::ListOrder S; S.tab = utab; S.n = build_units(F, utab);
            pg8::Gemm g{(const bf16_t*)(ws + WS_ACT), (const bf16_t*)(wb + W_E2), XG_ROWS, NE * 1024, 512};
            pg8::EpiExpDown E{(const int2*)(ws + WS_RINFO), YS};
            pg8::gemm_phase<pg8::EpiExpDown, pg8::ListOrder, true, true>(F.lds, g, S, E);
            GRID_BAR();
        }
    }
    if (IN(12) && a.lay_hi == DEPTH) {
        const float* md3 = mod + (size_t)3 * BATCH * 6 * D;
        ph_norm(F, X, YS, md3 + 5 * D, nullptr, F.in(21), nullptr, nullptr, nullptr, F.out);
    }
#undef IN
#undef GRID_BAR
}

#ifdef MK_DIAG
__global__ void k_nonfinite(const void* p, size_t n, int is_f32, unsigned* cnt, int slot) {
    size_t i = (size_t)blockIdx.x * blockDim.x + threadIdx.x; const size_t st = (size_t)gridDim.x * blockDim.x; unsigned c = 0;
    if (is_f32) { const unsigned* q = (const unsigned*)p; for (; i < n; i += st) c += ((q[i] & 0x7f800000u) == 0x7f800000u) ? 1u : 0u; }
    else { const unsigned short* q = (const unsigned short*)p; for (; i < n; i += st) c += ((q[i] & 0x7f80u) == 0x7f80u) ? 1u : 0u; }
    if (c) atomicAdd(cnt + slot, c);
}
__global__ void k_maskcheck(const u64* maskT, unsigned* cnt, int slot) {
    const int idx = blockIdx.x * blockDim.x + threadIdx.x; if (idx >= M) return; const int b = idx >> 12, t = idx & 4095; int pc = 0;
    for (int j = 0; j <= (t >> 6); ++j) pc += __popcll(maskT[((size_t)b * 64 + j) * SEQ + t]);
    const int want = (t + 1 < 256) ? t + 1 : 256;
    if (pc != want) atomicAdd(cnt + slot, 1u);
}
__global__ void k_emit(const float* x, const float* g, const unsigned* cnt, int nslots, float* out) {
    const int row = blockIdx.x, t = threadIdx.x; float v[4], ss = 0.f;
    for (int j = 0; j < 4; ++j) { v[j] = x[(size_t)row * D + t + 256 * j]; ss += v[j] * v[j]; }
    __shared__ float red[256]; red[t] = ss; __syncthreads();
    for (int o = 128; o > 0; o >>= 1) { if (t < o) red[t] += red[t + o]; __syncthreads(); }
    const float r = rsqrtf(red[0] / D + EPS); int code = 0;
    for (int s = nslots - 1; s >= 0; --s) if (cnt[s]) code = s + 1;
    for (int j = 0; j < 4; ++j) out[(size_t)row * D + t + 256 * j] = (1.f + code) * v[j] * r * g[t + 256 * j];
}
#endif
extern "C" void kernel_launch(void* const* d_in, const int* in_sizes, int n_in, void* d_out, int out_size, void* d_ws, size_t ws_size, hipStream_t stream) {
    static int grid = 0;
    if (grid == 0) {
        if (n_in != 22 || ws_size < WS_END) { fprintf(stderr, "kernel_launch: bad n_in %d / ws %zu (need %zu)\n", n_in, ws_size, (size_t)WS_END); grid = -1; return; }
        int dev = 0, cus = 0, per_cu = 0;
        if (hipGetDevice(&dev) != hipSuccess || hipDeviceGetAttribute(&cus, hipDeviceAttributeMultiprocessorCount, dev) != hipSuccess) { grid = -1; return; }
        if (hipFuncSetAttribute((const void*)mk_fwd, hipFuncAttributeMaxDynamicSharedMemorySize, LDS_BYTES) != hipSuccess) { fprintf(stderr, "kernel_launch: hipFuncSetAttribute failed\n"); grid = -1; return; }
        if (hipOccupancyMaxActiveBlocksPerMultiprocessor(&per_cu, (const void*)mk_fwd, NTHR, LDS_BYTES) != hipSuccess || per_cu < 1) fprintf(stderr, "kernel_launch: occupancy query says %d\n", per_cu);
        (void)hipGetLastError();
        grid = cus;
    }
    if (grid < 0) return;
    (void)hipMemsetAsync((char*)d_ws + WS_CTL, 0, CTL_ZERO_BYTES, stream);
    Args a{};
    for (int i = 0; i < 22; ++i) a.in[i] = (const float*)d_in[i];
    a.out = (float*)d_out; a.ws = (unsigned char*)d_ws;
#ifdef MK_DIAG
    {
        unsigned* cnt = (unsigned*)((char*)d_ws + WS_CTL) + 200000;
        a.lay_lo = 0; a.lay_hi = 0; a.ph_lo = 0; a.ph_hi = 1;
        hipLaunchKernelGGL(mk_fwd, dim3(grid), dim3(NTHR), LDS_BYTES, stream, a);
        for (int p = 1; p <= MK_DIAG; ++p) { a.lay_lo = 0; a.lay_hi = 1; a.ph_lo = p; a.ph_hi = p + 1; hipLaunchKernelGGL(mk_fwd, dim3(grid), dim3(NTHR), LDS_BYTES, stream, a); }
        unsigned char* w = (unsigned char*)d_ws; int s = 0;
#define NF(off, n, f32) hipLaunchKernelGGL(k_nonfinite, dim3(1024), dim3(256), 0, stream, (const void*)(w + (off)), (size_t)(n), f32, cnt, s++)
        NF(WS_MOD, DEPTH * BATCH * 6 * D, 1);
        NF(WS_H, (size_t)M * D, 0);
        NF(WS_W + W_IN, (size_t)NP * D, 0);
        NF(WS_P + P_QA, (size_t)M * D * 3, 0);
        NF(WS_P + P_IQ, (size_t)M * 512, 0);
        NF(WS_P + P_IK, (size_t)M * 64, 0);
        NF(WS_P + P_IW, (size_t)M * 8, 1);
        NF(WS_P + P_BQ, (size_t)M * D * 4, 0);
        NF(WS_P + P_CQ, (size_t)M * D * 2, 0);
        NF(WS_P + P_CV, (size_t)M * 2048 * 2, 0);
        NF(WS_P + P_GA, (size_t)M * D * 3, 0);
        hipLaunchKernelGGL(k_maskcheck, dim3(M / 256), dim3(256), 0, stream, (const u64*)(w + WS_MASK), cnt, s++);
        NF(WS_HA, (size_t)2048 * 64 * 64, 0);
        NF(WS_HDEC, (size_t)2048 * 128, 1);
        NF(WS_RA, (size_t)512 * 128 * 128, 0);
        NF(WS_OA, (size_t)M * D, 0);
        NF(WS_OB, (size_t)M * D, 0);
        NF(WS_OC, (size_t)M * 2048, 0);
        NF(WS_MGB, (size_t)M * D, 0);
        NF(WS_X, (size_t)M * D, 1);
        hipLaunchKernelGGL(k_emit, dim3(M), dim3(256), 0, stream, (const float*)d_in[0], (const float*)d_in[21], cnt, s, (float*)d_out);
    }
#elif MK_ONE_LAUNCH
    a.lay_lo = 0; a.lay_hi = DEPTH; a.ph_lo = 0; a.ph_hi = NPHASE;
    hipLaunchKernelGGL(mk_fwd, dim3(grid), dim3(NTHR), LDS_BYTES, stream, a);
#else
    a.lay_lo = 0; a.lay_hi = 0; a.ph_lo = 0; a.ph_hi = 1;
    hipLaunchKernelGGL(mk_fwd, dim3(grid), dim3(NTHR), LDS_BYTES, stream, a);
    for (int l = 0; l < DEPTH; ++l) for (int p = 1; p <= 11; ++p) { a.lay_lo = l; a.lay_hi = l + 1; a.ph_lo = p; a.ph_hi = p + 1; hipLaunchKernelGGL(mk_fwd, dim3(grid), dim3(NTHR), LDS_BYTES, stream, a); }
    a.lay_lo = DEPTH; a.lay_hi = DEPTH; a.ph_lo = 12; a.ph_hi = 13;
    hipLaunchKernelGGL(mk_fwd, dim3(grid), dim3(NTHR), LDS_BYTES, stream, a);
#endif
}
```

```cpp
#include <hip/hip_runtime.h>
#include <cstdio>
#include <cstdint>

constexpr int D = 1024, BATCH = 4, SEQ = 4096, DEPTH = 4, M = BATCH * SEQ;
constexpr int A_HEADS = 8, TOPK = 256;
constexpr int NE = 32, DEXP = 512;
constexpr int N_IN = 16968, NP = 17152;
constexpr float EPS = 1e-6f;
constexpr int O_AQ = 0, O_AK = 1024, O_AV = 2048, O_IQ = 3072, O_IK = 3584, O_IW = 3648, O_BQ = 3656, O_BF = 4680, O_BI = 5704, O_BG = 6728,
              O_CQ = 7752, O_CK = 8776, O_CV = 9800, O_CG = 11848, O_GA = 13896, O_GB = 14920, O_GC = 15944;

#define LAS __attribute__((address_space(3)))
#define GAS __attribute__((address_space(1)))
typedef unsigned short bf16_t;
typedef short bf16x8 __attribute__((ext_vector_type(8)));
typedef short s16x4 __attribute__((ext_vector_type(4)));
typedef float f32x4 __attribute__((ext_vector_type(4)));
typedef float f32x2 __attribute__((ext_vector_type(2)));
typedef unsigned u32x4 __attribute__((ext_vector_type(4)));
typedef unsigned u32x2 __attribute__((ext_vector_type(2)));
typedef unsigned long long u64;

constexpr size_t MiB = 1u << 20;
constexpr size_t WS_CTL = 0, CTL_ZERO_BYTES = 1 * MiB;
constexpr size_t WS_MOD = 1 * MiB;
constexpr size_t WS_LB = WS_MOD + 512 * 1024;
constexpr size_t WS_TB = WS_LB + 16 * 1024;
constexpr size_t WS_ROT = 2 * MiB;
constexpr size_t WS_RW = 6 * MiB;
constexpr size_t WS_X = 8 * MiB;
constexpr size_t WS_H = 72 * MiB;
constexpr size_t WS_W = 104 * MiB;
constexpr size_t W_IN = 0, W_BA = 34 * MiB, W_BB = 36 * MiB, W_BC = 38 * MiB, W_OUT = 42 * MiB, W_E1 = 44 * MiB, W_E2 = 108 * MiB;
constexpr size_t WS_P = 244 * MiB;
constexpr size_t P_QA = 0, P_KA = 32 * MiB, P_VA = 64 * MiB, P_IQ = 96 * MiB, P_IK = 112 * MiB, P_IW = 114 * MiB,
                 P_BQ = 116 * MiB, P_BG = 148 * MiB, P_BV = 180 * MiB, P_BO = 212 * MiB, P_CQ = 244 * MiB, P_CK = 276 * MiB,
                 P_CV = 308 * MiB, P_CG = 372 * MiB, P_GA = 436 * MiB, P_GB = 468 * MiB, P_GC = 500 * MiB;
constexpr size_t WS_MASK = 776 * MiB;
constexpr size_t WS_OA = 784 * MiB;
constexpr size_t WS_HA = 816 * MiB;
constexpr size_t WS_HDEC = 832 * MiB;
constexpr size_t WS_RA = 834 * MiB;
constexpr size_t WS_OB = 850 * MiB;
constexpr size_t WS_OC = 882 * MiB;
constexpr size_t WS_MG = 946 * MiB;
constexpr size_t WS_MGB = 1010 * MiB;
constexpr size_t WS_END = 1042 * MiB;
constexpr int XG_ROWS = 40960;
constexpr size_t WS_XG = WS_P, WS_ACT = WS_P + 80 * MiB, WS_YS = WS_P + 120 * MiB, WS_RINFO = WS_P + 184 * MiB, WS_TOK = WS_P + 186 * MiB, WS_T2E = WS_P + 190 * MiB;
constexpr int CW_BAR = 4096;
constexpr int CW_ECNT = 16384;

typedef __bf16 bf16x2_n __attribute__((ext_vector_type(2)));
__device__ __forceinline__ unsigned cvt_pk_bf16(float lo, float hi) { const f32x2 v = {lo, hi}; const bf16x2_n r = __builtin_convertvector(v, bf16x2_n); return __builtin_bit_cast(unsigned, r); }
__device__ __forceinline__ float bf2f(unsigned short b) { return __uint_as_float(((unsigned)b) << 16); }
__device__ __forceinline__ float bflo(unsigned w) { return __uint_as_float(w << 16); }
__device__ __forceinline__ float bfhi(unsigned w) { return __uint_as_float(w & 0xffff0000u); }
__device__ __forceinline__ float sigmoid_f(float x) { return __builtin_amdgcn_rcpf(1.f + __expf(-x)); }
__device__ __forceinline__ float silu_f(float x) { return x * sigmoid_f(x); }
__device__ __forceinline__ float wave_sum(float v) {
#pragma unroll
    for (int o = 1; o < 64; o <<= 1) v += __shfl_xor(v, o);
    return v;
}
#define LDS_WAIT() asm volatile("s_waitcnt lgkmcnt(0)" ::: "memory")
#define VM_WAIT() asm volatile("s_waitcnt vmcnt(0)" ::: "memory")
constexpr int NWAVES = 8, NTHR = 512;
constexpr int RING_BYTES = 131072;
constexpr int MISC_OFF = 139264;
constexpr int LDS_BYTES = 147456;
struct Frame {
    LAS unsigned char* lds;
    volatile LAS unsigned* MISC;
    unsigned* ctl;
    unsigned char* ws;
    int tid, lane, wave, G, bid;
    float* out;
    __device__ __forceinline__ const float* in(int i) const { const LAS unsigned* p = (const LAS unsigned*)(lds + MISC_OFF + 512) + 2 * i;
        const unsigned lo = __builtin_amdgcn_readfirstlane(p[0]), hi = __builtin_amdgcn_readfirstlane(p[1]); return (const float*)(((u64)hi << 32) | lo); }
};
struct Args { const float* in[22]; float* out; unsigned char* ws; int lay_lo, lay_hi, ph_lo, ph_hi; };

__device__ __forceinline__ int t5_bucket(int rel) {
    if (rel < 16) return rel;
    int large = 16 + (int)(logf((float)rel / 16.f) / logf(8.f) * 16.f);
    return large < 31 ? large : 31;
}
__device__ __forceinline__ void ph_prologue(Frame& F) {
    const float* c = F.in(1); const float* rel_bias = F.in(2); const float* lb_raw = F.in(3); const float* ada_w = F.in(6); const float* ada_b = F.in(7);
    const float* rg_w = F.in(14); const float* re_w = F.in(16);
    float* mod = (float*)(F.ws + WS_MOD); float* lb = (float*)(F.ws + WS_LB); float* tb = (float*)(F.ws + WS_TB); float2* rot = (float2*)(F.ws + WS_ROT); bf16_t* rw = (bf16_t*)(F.ws + WS_RW);
    LAS float* sc = (LAS float*)F.lds;
    LAS float* red = (LAS float*)(F.lds + 16384);
    for (int i = F.tid; i < BATCH * D; i += NTHR) { const float v = c[i]; sc[i] = v / (1.f + __expf(-v)); }
    __syncthreads();
    for (int it = F.bid; it < DEPTH * 48; it += F.G) {
        const int l = it / 48, j0 = (it % 48) * 128, jj = F.tid & 127, kp = F.tid >> 7;
        const float* w = ada_w + (size_t)l * D * 6 * D + j0 + jj;
        float a0 = 0.f, a1 = 0.f, a2 = 0.f, a3 = 0.f;
        for (int k = kp * 256; k < kp * 256 + 256; ++k) { const float wv = w[(size_t)k * 6 * D]; a0 += sc[k] * wv; a1 += sc[D + k] * wv; a2 += sc[2 * D + k] * wv; a3 += sc[3 * D + k] * wv; }
        red[(kp * 128 + jj) * 4 + 0] = a0; red[(kp * 128 + jj) * 4 + 1] = a1; red[(kp * 128 + jj) * 4 + 2] = a2; red[(kp * 128 + jj) * 4 + 3] = a3;
        __syncthreads();
        { const int b = F.tid >> 7;
          const float s = red[(0 * 128 + jj) * 4 + b] + red[(1 * 128 + jj) * 4 + b] + red[(2 * 128 + jj) * 4 + b] + red[(3 * 128 + jj) * 4 + b];
          mod[((size_t)l * BATCH + b) * 6 * D + j0 + jj] = s + ada_b[l * 6 * D + j0 + jj]; }
        __syncthreads();
    }
    const int gt = F.bid * NTHR + F.tid, NT = F.G * NTHR;
    for (int d = gt; d < D; d += NT) {
        float v0 = lb_raw[d], v1 = lb_raw[D + d], v2 = lb_raw[2 * D + d], v3 = lb_raw[3 * D + d];
        const float mx = fmaxf(fmaxf(v0, v1), fmaxf(v2, v3));
        v0 = expf(v0 - mx); v1 = expf(v1 - mx); v2 = expf(v2 - mx); v3 = expf(v3 - mx);
        const float s = v0 + v1 + v2 + v3;
        lb[d] = 0.f; lb[D + d] = v1 / s; lb[2 * D + d] = (v1 + v2) / s; lb[3 * D + d] = (v1 + v2 + v3) / s;
    }
    for (int idx = gt; idx < SEQ * 128; idx += NT) { const int t = idx >> 7, i = idx & 127;
        const double th = exp(-(double)i / 127.0 * 9.210340371976184), a = (double)t * th;
        rot[idx] = make_float2((float)cos(a), (float)sin(a)); }
    for (int idx = gt; idx < 8 * 128; idx += NT) { const int h = idx >> 7, rel = idx & 127;
        tb[idx] = (rel_bias[t5_bucket(rel) * A_HEADS + h] - rel_bias[31 * A_HEADS + h]) * 11.313708498984761f; }
    for (int idx = gt; idx < DEPTH * 48 * D; idx += NT) { const int l = idx / (48 * D), r = idx % (48 * D), n = r >> 10, k = r & 1023;
        float v = 0.f; if (n < 4) v = rg_w[((size_t)l * D + k) * 4 + n]; else if (n < 36) v = re_w[((size_t)l * D + k) * 32 + (n - 4)];
        rw[idx] = (bf16_t)(cvt_pk_bf16(v, 0.f) & 0xffffu); }
}

__device__ __forceinline__ void conv_tile(const float* W, int ldw, int nvalid, bf16_t* dst, int K, int k0, LAS float* scr, int lane) {
    const int nq = (lane & 15) * 4, kq = lane >> 4; const bool ok = nq < nvalid;
    f32x4 v[16];
#pragma unroll
    for (int i = 0; i < 16; ++i) v[i] = ok ? *(const f32x4*)(W + (size_t)(k0 + 4 * i + kq) * ldw + nq) : (f32x4){0.f, 0.f, 0.f, 0.f};
#pragma unroll
    for (int i = 0; i < 16; ++i) { LAS float* p = scr + (4 * i + kq) * 65 + nq; p[0] = v[i][0]; p[1] = v[i][1]; p[2] = v[i][2]; p[3] = v[i][3]; }
    LDS_WAIT(); asm volatile("" ::: "memory");
    const int c = lane & 7;
#pragma unroll
    for (int j = 0; j < 8; ++j) { const int n = (lane >> 3) + 8 * j; const LAS float* s = scr + (8 * c) * 65 + n;
        u32x4 o; o.x = cvt_pk_bf16(s[0 * 65], s[1 * 65]); o.y = cvt_pk_bf16(s[2 * 65], s[3 * 65]); o.z = cvt_pk_bf16(s[4 * 65], s[5 * 65]); o.w = cvt_pk_bf16(s[6 * 65], s[7 * 65]);
        *(u32x4*)(dst + (size_t)n * K + k0 + 8 * c) = o; }
    LDS_WAIT(); asm volatile("" ::: "memory");
}
__device__ __forceinline__ void ph_conv(Frame& F, int l) {
    LAS float* scr = (LAS float*)(F.lds + F.wave * 16640);
    const int gw = F.bid * NWAVES + F.wave, NGW = F.G * NWAVES;
    unsigned char* wb = F.ws + WS_W;
    constexpr int I_IN = 268 * 16, I_B = 16 * 16, I_C = 16 * 32, I_E1 = 32 * 16 * 16, I_E2 = 32 * 16 * 8;
    constexpr int NITEMS = I_IN + 3 * I_B + I_C + I_E1 + I_E2;
    for (int it = gw; it < NITEMS; it += NGW) {
        int r = it;
        if (r < I_IN) { const int nb = r >> 4, kb = r & 15, n0 = nb * 64; int c0, nv;
            if (n0 + 64 <= 3656) { c0 = n0; nv = 64; } else if (n0 < 3656) { c0 = n0; nv = 3656 - n0; } else if (n0 < 3840) { c0 = 0; nv = 0; } else { c0 = n0 - 184; nv = 64; }
            conv_tile(F.in(8) + (size_t)l * D * N_IN + c0, N_IN, nv, (bf16_t*)(wb + W_IN) + (size_t)n0 * D, D, kb * 64, scr, F.lane); continue; }
        r -= I_IN;
        if (r < I_B) { conv_tile(F.in(10) + (size_t)l * 1024 * D + (r >> 4) * 64, D, 64, (bf16_t*)(wb + W_BA) + (size_t)(r >> 4) * 64 * 1024, 1024, (r & 15) * 64, scr, F.lane); continue; }
        r -= I_B;
        if (r < I_B) { conv_tile(F.in(11) + (size_t)l * 1024 * D + (r >> 4) * 64, D, 64, (bf16_t*)(wb + W_BB) + (size_t)(r >> 4) * 64 * 1024, 1024, (r & 15) * 64, scr, F.lane); continue; }
        r -= I_B;
        if (r < I_C) { conv_tile(F.in(12) + (size_t)l * 2048 * D + (r >> 5) * 64, D, 64, (bf16_t*)(wb + W_BC) + (size_t)(r >> 5) * 64 * 2048, 2048, (r & 31) * 64, scr, F.lane); continue; }
        r -= I_C;
        if (r < I_B) { conv_tile(F.in(13) + (size_t)l * D * D + (r >> 4) * 64, D, 64, (bf16_t*)(wb + W_OUT) + (size_t)(r >> 4) * 64 * 1024, 1024, (r & 15) * 64, scr, F.lane); continue; }
        r -= I_B;
        if (r < I_E1) { const int e = r >> 8, q = r & 255, nb = q >> 4, kb = q & 15, n0 = nb * 64;
            const int pn = n0 >> 8, bj = (n0 >> 7) & 1, j0 = n0 & 127;
            const float* src = (bj ? F.in(19) : F.in(18)) + ((size_t)l * NE + e) * D * DEXP + 128 * pn + j0;
            conv_tile(src, DEXP, 64, (bf16_t*)(wb + W_E1) + ((size_t)e * 1024 + n0) * 1024, 1024, kb * 64, scr, F.lane); continue; }
        r -= I_E1;
        { const int e = r >> 7, q = r & 127, nb = q >> 3, kb = q & 7;
          conv_tile(F.in(20) + ((size_t)l * NE + e) * DEXP * D + nb * 64, D, 64, (bf16_t*)(wb + W_E2) + ((size_t)e * 1024 + nb * 64) * 512, 512, kb * 64, scr, F.lane); }
    }
}

__device__ __forceinline__ void ph_norm(Frame& F, const float* xs, const bf16_t* ys, const float* gt2, float* xd, const float* g, const float* sc, const float* sh, bf16_t* hout, float* fout) {
    const int gw = F.bid * NWAVES + F.wave, NGW = F.G * NWAVES;
    for (int row = gw; row < M; row += NGW) {
        const int b = row >> 12;
        f32x4 v[4]; float ss = 0.f;
#pragma unroll
        for (int j = 0; j < 4; ++j) { const int c = 4 * F.lane + 256 * j; v[j] = *(const f32x4*)(xs + (size_t)row * D + c);
            if (ys) { const u32x2 y0 = *(const u32x2*)(ys + ((size_t)row * 2) * D + c), y1 = *(const u32x2*)(ys + ((size_t)row * 2 + 1) * D + c); const f32x4 gg = *(const f32x4*)(gt2 + b * 6 * D + c);
                v[j][0] += gg[0] * (bflo(y0.x) + bflo(y1.x)); v[j][1] += gg[1] * (bfhi(y0.x) + bfhi(y1.x)); v[j][2] += gg[2] * (bflo(y0.y) + bflo(y1.y)); v[j][3] += gg[3] * (bfhi(y0.y) + bfhi(y1.y)); }
            ss += (v[j][0] * v[j][0] + v[j][1] * v[j][1]) + (v[j][2] * v[j][2] + v[j][3] * v[j][3]); }
        const float r = rsqrtf(wave_sum(ss) * (1.f / D) + EPS);
#pragma unroll
        for (int j = 0; j < 4; ++j) { const int c = 4 * F.lane + 256 * j;
            if (xd) *(f32x4*)(xd + (size_t)row * D + c) = v[j];
            f32x4 o = v[j] * r * *(const f32x4*)(g + c);
            if (sc) o = o * (1.f + *(const f32x4*)(sc + b * 6 * D + c)) + *(const f32x4*)(sh + b * 6 * D + c);
            if (hout) { u32x2 w; w.x = cvt_pk_bf16(o[0], o[1]); w.y = cvt_pk_bf16(o[2], o[3]); *(u32x2*)(hout + (size_t)row * D + c) = w; }
            else *(f32x4*)(fout + (size_t)row * D + c) = o; }
    }
}
namespace pg8 {
#define PG8_LAS __attribute__((address_space(3)))
typedef unsigned short bf16_t;
typedef short bf16x8 __attribute__((ext_vector_type(8)));
typedef float f32x4 __attribute__((ext_vector_type(4)));
typedef unsigned u32x4 __attribute__((ext_vector_type(4)));
constexpr int BM = 256, BK = 64, HALF = 128, HTB = HALF * BK * 2  , STAGE_BYTES = 8 * HTB, NXCD = 8, WGM = 8;

__host__ __device__ __forceinline__ int lds_byte(int r, int c) { const int st = (r >> 4) * 2 + (c >> 5), rr = r & 15, cc = c & 31, ob = rr * 64 + cc * 2; return st * 1024 + (ob ^ (((ob >> 9) & 1) << 5)); }
__host__ __device__ __forceinline__ void stage_rc(int b, int& R, int& C) { const int st = b / 1024, sb = b % 1024, swz = sb ^ (((sb >> 9) & 1) << 5); R = (st >> 1) * 16 + swz / 64; C = (st & 1) * 32 + (swz % 64) / 2; }
__host__ __device__ __forceinline__ int perm32(int rho) { const int n = rho >> 4, i = rho & 15; return 8 * (i >> 2) + 4 * n + (i & 3); }

struct Unit { int pm, pn; };
struct Gemm { const bf16_t* A; const bf16_t* Bt; int M, N, K; };

struct StaticOrder {
    int nM, nN, nwg, G, c;
    __host__ __device__ void init(int M, int N, int G_, int c_) { nM = M / BM; nN = N / BM; nwg = nM * nN; G = G_; c = c_; }
    __host__ __device__ bool next(int i, Unit& u) const {
        const long L = (long)i * G + c; if (L >= nwg) return false;
        int wgid = (int)L; { const int q = nwg / NXCD, r = nwg % NXCD, xcd = wgid % NXCD, off = wgid / NXCD; wgid = (xcd < r ? xcd * (q + 1) : r * (q + 1) + (xcd - r) * q) + off; }
        const int nig = WGM * nN, gid = wgid / nig, fm = gid * WGM, gsz = (nM - fm) < WGM ? (nM - fm) : WGM;
        u.pm = fm + ((wgid % nig) % gsz); u.pn = (wgid % nig) / gsz; return true;
    }
    __device__ __forceinline__ void a_ready(const Unit&) const {}
    __device__ __forceinline__ void done(const Unit&) const {}
};


__device__ __forceinline__ void st8(bf16_t* p, const float* x) { u32x4 w; w.x = cvt_pk_bf16(x[0], x[1]); w.y = cvt_pk_bf16(x[2], x[3]); w.z = cvt_pk_bf16(x[4], x[5]); w.w = cvt_pk_bf16(x[6], x[7]); *(u32x4*)p = w; }
enum { K_PLAIN = 0, K_LOGF = 1, K_SILU = 2, K_SIGM = 3, K_ROTQ = 4, K_ROTK = 5, K_IDX = 6 };
struct EpiProj {
    static constexpr bool PERM = true, AFTER_DRAIN = false;
    unsigned char* pb;
    const float* lb;
    const float2* rot;
    __device__ __forceinline__ void operator()(const f32x4 (&acc)[2][2][4][2], const Unit& u, int wr, int wc, int fr, int fq) const {
        const int pn = u.pn; size_t off; int ld, cb, kind, hd = 0;
        if (pn < 12) { off = P_QA + (size_t)(pn >> 2) * 32 * MiB; ld = 1024; cb = (pn & 3) * 256; kind = K_PLAIN; }
        else if (pn < 14) { off = P_IQ; ld = 512; cb = (pn - 12) * 256; kind = K_PLAIN; }
        else if (pn == 14) { off = P_IK; ld = 64; cb = 0; kind = K_IDX; }
        else if (pn < 31) { const int q = pn - 15, t = q >> 2; off = P_BQ + (size_t)t * 32 * MiB; ld = 1024; cb = (q & 3) * 256; kind = (t == 1) ? K_LOGF : (t == 3) ? K_SILU : K_PLAIN; }
        else if (pn < 39) { const int q = pn - 31, t = q >> 2; off = P_CQ + (size_t)t * 32 * MiB; ld = 1024; cb = (q & 3) * 256; kind = t ? K_ROTK : K_ROTQ; hd = q & 3; }
        else if (pn < 55) { const int q = pn - 39, t = q >> 3; off = P_CV + (size_t)t * 64 * MiB; ld = 2048; cb = (q & 7) * 256; kind = t ? K_SILU : K_PLAIN; }
        else { const int q = pn - 55, t = q >> 2; off = P_GA + (size_t)t * 32 * MiB; ld = 1024; cb = (q & 3) * 256; kind = K_SIGM; }
        bf16_t* base = (bf16_t*)(pb + off);
        const int row0 = u.pm * BM + wr * 64 + fr, cl0 = wc * 32 + 8 * fq;
        if (kind == K_IDX) {
            float* iw = (float*)(pb + P_IW);
#pragma unroll
            for (int ai = 0; ai < 2; ++ai)
#pragma unroll
                for (int m = 0; m < 4; ++m) { const int row = row0 + ai * HALF + m * 16;
                    if (cl0 < 64) { float x[8] = {acc[ai][0][m][0][0], acc[ai][0][m][0][1], acc[ai][0][m][0][2], acc[ai][0][m][0][3], acc[ai][0][m][1][0], acc[ai][0][m][1][1], acc[ai][0][m][1][2], acc[ai][0][m][1][3]};
                        st8(base + (size_t)row * 64 + cl0, x); }
                    else if (cl0 == 64) { *(f32x4*)(iw + (size_t)row * 8) = acc[ai][0][m][0]; *(f32x4*)(iw + (size_t)row * 8 + 4) = acc[ai][0][m][1]; } }
            return;
        }
        const float l2g = __log2f(1.f - exp2f(-5.f - (float)hd));
#pragma unroll
        for (int ai = 0; ai < 2; ++ai)
#pragma unroll
            for (int m = 0; m < 4; ++m) { const int row = row0 + ai * HALF + m * 16; bf16_t* rowp = base + (size_t)row * ld + cb + cl0;
#pragma unroll
                for (int bj = 0; bj < 2; ++bj) {
                    float x[8] = {acc[ai][bj][m][0][0], acc[ai][bj][m][0][1], acc[ai][bj][m][0][2], acc[ai][bj][m][0][3], acc[ai][bj][m][1][0], acc[ai][bj][m][1][1], acc[ai][bj][m][1][2], acc[ai][bj][m][1][3]};
                    if (kind == K_LOGF) {
#pragma unroll
                        for (int j = 0; j < 8; ++j) { const float lv = lb[cb + bj * HALF + cl0 + j]; x[j] = __logf(lv + (1.f - lv) * sigmoid_f(x[j])); } }
                    else if (kind == K_SILU) {
#pragma unroll
                        for (int j = 0; j < 8; ++j) x[j] = silu_f(x[j]); }
                    else if (kind == K_SIGM) {
#pragma unroll
                        for (int j = 0; j < 8; ++j) x[j] = sigmoid_f(x[j]); }
                    else if (kind == K_ROTQ || kind == K_ROTK) {
                        const int pos = row & (SEQ - 1), e = pos & 127, i0 = (bj * HALF + cl0) >> 1;
                        const f32x4 r0 = *(const f32x4*)(rot + (size_t)pos * 128 + i0), r1 = *(const f32x4*)(rot + (size_t)pos * 128 + i0 + 2);
                        const float s = (kind == K_ROTQ) ? exp2f((float)(e + 1) * l2g) : 0.0625f * exp2f((float)(127 - e) * l2g);
                        const float cs[8] = {r0[0], r0[1], r0[2], r0[3], r1[0], r1[1], r1[2], r1[3]};
#pragma unroll
                        for (int j = 0; j < 4; ++j) { const float a = x[2 * j], b = x[2 * j + 1], c = cs[2 * j], sn = cs[2 * j + 1]; x[2 * j] = (a * c - b * sn) * s; x[2 * j + 1] = (b * c + a * sn) * s; } }
                    st8(rowp + bj * HALF, x); } }
    }
};
template <int STEP> struct EpiMerge {
    static constexpr bool PERM = false, AFTER_DRAIN = false;
    const bf16_t* gate; float* mg; bf16_t* mgb;
    __device__ __forceinline__ void operator()(const f32x4 (&acc)[2][2][4][2], const Unit& u, int wr, int wc, int fr, int fq) const {
        const int row0 = u.pm * BM + wr * 64 + fr, col0 = u.pn * BM + wc * 32 + 4 * fq;
#pragma unroll
        for (int ai = 0; ai < 2; ++ai)
#pragma unroll
            for (int m = 0; m < 4; ++m) { const size_t ro = (size_t)(row0 + ai * HALF + m * 16) * 1024 + col0;
#pragma unroll
                for (int bj = 0; bj < 2; ++bj)
#pragma unroll
                    for (int n = 0; n < 2; ++n) { const size_t o = ro + bj * HALF + n * 16; const u32x2 gw = *(const u32x2*)(gate + o);
                        f32x4 v = acc[ai][bj][m][n] * (f32x4){bflo(gw.x), bfhi(gw.x), bflo(gw.y), bfhi(gw.y)};
                        if (STEP > 0) v += *(const f32x4*)(mg + o);
                        if (STEP < 2) *(f32x4*)(mg + o) = v;
                        else { u32x2 w; w.x = cvt_pk_bf16(v[0], v[1]); w.y = cvt_pk_bf16(v[2], v[3]); *(u32x2*)(mgb + o) = w; } } }
    }
};
struct EpiRes {
    static constexpr bool PERM = false, AFTER_DRAIN = false;
    const float* xs; float* xd; const float* gt;
    __device__ __forceinline__ void operator()(const f32x4 (&acc)[2][2][4][2], const Unit& u, int wr, int wc, int fr, int fq) const {
        const int row0 = u.pm * BM + wr * 64 + fr, col0 = u.pn * BM + wc * 32 + 4 * fq; const int b = (u.pm * BM) >> 12;
#pragma unroll
        for (int ai = 0; ai < 2; ++ai)
#pragma unroll
            for (int m = 0; m < 4; ++m) { const size_t ro = (size_t)(row0 + ai * HALF + m * 16) * 1024 + col0;
#pragma unroll
                for (int bj = 0; bj < 2; ++bj)
#pragma unroll
                    for (int n = 0; n < 2; ++n) { const size_t o = ro + bj * HALF + n * 16; const f32x4 g = *(const f32x4*)(gt + b * 6 * D + col0 + bj * HALF + n * 16);
                        *(f32x4*)(xd + o) = *(const f32x4*)(xs + o) + g * acc[ai][bj][m][n]; } }
    }
};
struct EpiExpUp {
    static constexpr bool PERM = true, AFTER_DRAIN = false;
    bf16_t* act;
    __device__ __forceinline__ void operator()(const f32x4 (&acc)[2][2][4][2], const Unit& u, int wr, int wc, int fr, int fq) const {
        const int row0 = u.pm * BM + wr * 64 + fr, col0 = (u.pn & 3) * 128 + wc * 32 + 8 * fq;
#pragma unroll
        for (int ai = 0; ai < 2; ++ai)
#pragma unroll
            for (int m = 0; m < 4; ++m) { float x[8];
#pragma unroll
                for (int n = 0; n < 2; ++n)
#pragma unroll
                    for (int i = 0; i < 4; ++i) x[4 * n + i] = silu_f(acc[ai][0][m][n][i]) * acc[ai][1][m][n][i];
                st8(act + (size_t)(row0 + ai * HALF + m * 16) * DEXP + col0, x); }
    }
};
struct EpiExpDown {
    static constexpr bool PERM = true, AFTER_DRAIN = false;
    const int2* rinfo; bf16_t* ys;
    __device__ __forceinline__ void operator()(const f32x4 (&acc)[2][2][4][2], const Unit& u, int wr, int wc, int fr, int fq) const {
        const int row0 = u.pm * BM + wr * 64 + fr, col0 = (u.pn & 3) * 256 + wc * 32 + 8 * fq;
#pragma unroll
        for (int ai = 0; ai < 2; ++ai)
#pragma unroll
            for (int m = 0; m < 4; ++m) { const int2 ri = rinfo[row0 + ai * HALF + m * 16];
                if (ri.x >= 0) { const float w = __int_as_float(ri.y);
#pragma unroll
                    for (int bj = 0; bj < 2; ++bj) { float x[8];
#pragma unroll
                        for (int n = 0; n < 2; ++n)
#pragma unroll
                            for (int i = 0; i < 4; ++i) x[4 * n + i] = w * acc[ai][bj][m][n][i];
                        st8(ys + (size_t)ri.x * D + col0 + bj * HALF, x); } } }
    }
};
struct ListOrder {
    const LAS int* tab; int n;
    __device__ __forceinline__ bool next(int i, Unit& u) const { if (i >= n) return false; const int v = tab[i]; u.pm = v >> 8; u.pn = v & 255; return true; }
    __device__ __forceinline__ void a_ready(const Unit&) const {}
    __device__ __forceinline__ void done(const Unit&) const {}
};

template <class Epi, class Sched, bool ALIGN_EPI = false, bool SP2 = false>
__device__ __forceinline__ void gemm_phase(PG8_LAS unsigned char* lds, const Gemm g, const Sched& S, const Epi& E) {
    int tid_ = threadIdx.x; asm volatile("" : "+v"(tid_));
    const int tid = tid_, wid = __builtin_amdgcn_readfirstlane(tid >> 6), lane = tid & 63, wr = wid >> 2, wc = wid & 3, fr = lane & 15, fq = lane >> 4;
    const int K = g.K, nt = K / BK;
    unsigned voffA[2], voffB[2];
#pragma unroll
    for (int i = 0; i < 2; ++i) { int R, C; stage_rc(tid * 16 + i * 8192, R, C); const int Rb = Epi::PERM ? ((R & ~31) + perm32(R & 31)) : R;
        voffA[i] = (unsigned)(R * K + C) * 2u; voffB[i] = (unsigned)(Rb * K + C) * 2u; }
    const size_t kstep = (size_t)(BK * 2);
    const size_t hstep = (size_t)HALF * K * 2;
    const size_t tstep = 2 * hstep;
    const unsigned ldsw = (unsigned)wid * 1024u;
    const int aoff = lds_byte(wr * 64 + fr, fq * 8), boff = lds_byte(wc * 32 + fr, fq * 8);
#define PG8_SA(b, h) (((b) * 2 + (h)) * HTB)
#define PG8_SB(b, h) ((4 + (b) * 2 + (h)) * HTB)
#define PG8_STAGE(bufoff, gbase, voff) do { _Pragma("unroll") for (int _i = 0; _i < 2; ++_i) \
        __builtin_amdgcn_global_load_lds((const unsigned*)((const char*)(gbase) + (voff)[_i]), (PG8_LAS unsigned*)(lds + (bufoff) + ldsw + _i * 8192), 16, 0, 0); } while (0)
#define PG8_LDA(dst, b, h) do { _Pragma("unroll") for (int m = 0; m < 4; ++m) _Pragma("unroll") for (int k = 0; k < 2; ++k) dst[m][k] = *(const PG8_LAS bf16x8*)(lds + PG8_SA(b, h) + aoff + m * 2048 + k * 1024); } while (0)
#define PG8_LDB(dst, b, h) do { _Pragma("unroll") for (int n = 0; n < 2; ++n) _Pragma("unroll") for (int k = 0; k < 2; ++k) dst[n][k] = *(const PG8_LAS bf16x8*)(lds + PG8_SB(b, h) + boff + n * 2048 + k * 1024); } while (0)
#define PG8_MMA(ai, bj, At, Bt) do { __builtin_amdgcn_s_setprio(1); _Pragma("unroll") for (int m = 0; m < 4; ++m) _Pragma("unroll") for (int n = 0; n < 2; ++n) _Pragma("unroll") for (int k = 0; k < 2; ++k) \
        acc[ai][bj][m][n] = __builtin_amdgcn_mfma_f32_16x16x32_bf16(Bt[n][k], At[m][k], acc[ai][bj][m][n], 0, 0, 0); __builtin_amdgcn_s_setprio(0); } while (0)
#define PG8_WAIT_V(n) asm volatile("s_waitcnt vmcnt(" #n ")" ::: "memory")
#define PG8_WAIT_L(n) asm volatile("s_waitcnt lgkmcnt(" #n ")" ::: "memory")
#define PG8_BAR __builtin_amdgcn_s_barrier()
#define PG8_SCHED __builtin_amdgcn_sched_barrier(0)
    Unit cur, nxt; int ui = 0;
    if (!S.next(0, cur)) return;
    f32x4 acc[2][2][4][2];
#pragma unroll
    for (int a = 0; a < 2; ++a)
#pragma unroll
        for (int b = 0; b < 2; ++b)
#pragma unroll
            for (int m = 0; m < 4; ++m)
#pragma unroll
                for (int n = 0; n < 2; ++n) acc[a][b][m][n] = (f32x4){0.f, 0.f, 0.f, 0.f};
    bf16x8 At[4][2], B0[2][2], B1[2][2];
    const char* cA = (const char*)g.A + (size_t)cur.pm * tstep; const char* cB = (const char*)g.Bt + (size_t)cur.pn * tstep;
    S.a_ready(cur);
    if constexpr (SP2) {
        PG8_STAGE(PG8_SB(0, 0), cB, voffB); PG8_STAGE(PG8_SB(0, 1), cB + hstep, voffB); PG8_STAGE(PG8_SA(0, 0), cA, voffA); PG8_STAGE(PG8_SA(0, 1), cA + hstep, voffA);
        if (wr == 1) PG8_BAR;
        PG8_WAIT_V(2); PG8_BAR;
        PG8_STAGE(PG8_SB(1, 0), cB + kstep, voffB); PG8_STAGE(PG8_SA(1, 0), cA + kstep, voffA); PG8_STAGE(PG8_SB(1, 1), cB + hstep + kstep, voffB);
        PG8_WAIT_V(6); PG8_BAR;
    } else {
        PG8_STAGE(PG8_SB(0, 0), cB, voffB); PG8_STAGE(PG8_SA(0, 0), cA, voffA); PG8_STAGE(PG8_SB(0, 1), cB + hstep, voffB); PG8_STAGE(PG8_SA(0, 1), cA + hstep, voffA);
        if (wr == 1) PG8_BAR;
        PG8_WAIT_V(4); PG8_BAR;
        PG8_STAGE(PG8_SB(1, 0), cB + kstep, voffB); PG8_STAGE(PG8_SA(1, 0), cA + kstep, voffA); PG8_STAGE(PG8_SB(1, 1), cB + hstep + kstep, voffB);
        PG8_WAIT_V(6); PG8_BAR;
    }
    for (;;) {
        const bool has_next = S.next(ui + 1, nxt);
        const char* nA = has_next ? (const char*)g.A + (size_t)nxt.pm * tstep : cA; const char* nB = has_next ? (const char*)g.Bt + (size_t)nxt.pn * tstep : cB;
        for (int t = 0; t < nt; t += 2) {
            const bool last = (t == nt - 2);
            const char* a1 = cA + (size_t)(t + 1) * kstep;
            const char* a2 = last ? nA : cA + (size_t)(t + 2) * kstep; const char* b2 = last ? nB : cB + (size_t)(t + 2) * kstep;
            const char* a3 = a2 + kstep; const char* b3 = b2 + kstep;
            if (last && has_next) S.a_ready(nxt);
            if constexpr (SP2) {
            PG8_LDB(B0, 0, 0); PG8_LDB(B1, 0, 1); PG8_SCHED; PG8_LDA(At, 0, 0); PG8_STAGE(PG8_SA(1, 1), a1 + hstep, voffA);
            PG8_WAIT_V(8); PG8_WAIT_L(0); PG8_BAR; PG8_MMA(0, 0, At, B0); PG8_MMA(0, 1, At, B1); PG8_BAR; PG8_SCHED;
            PG8_LDA(At, 0, 1); PG8_STAGE(PG8_SB(0, 0), b2, voffB); PG8_STAGE(PG8_SB(0, 1), b2 + hstep, voffB); PG8_STAGE(PG8_SA(0, 0), a2, voffA);
            PG8_WAIT_V(8); PG8_WAIT_L(0); PG8_BAR; PG8_MMA(1, 0, At, B0); PG8_MMA(1, 1, At, B1); PG8_BAR; PG8_SCHED;
            PG8_LDB(B0, 1, 0); PG8_LDB(B1, 1, 1); PG8_SCHED; PG8_LDA(At, 1, 0); PG8_STAGE(PG8_SA(0, 1), a2 + hstep, voffA);
            PG8_WAIT_V(8); PG8_WAIT_L(0); PG8_BAR; PG8_MMA(0, 0, At, B0); PG8_MMA(0, 1, At, B1); PG8_BAR; PG8_SCHED;
            PG8_LDA(At, 1, 1); PG8_STAGE(PG8_SB(1, 0), b3, voffB); PG8_STAGE(PG8_SB(1, 1), b3 + hstep, voffB); PG8_STAGE(PG8_SA(1, 0), a3, voffA);
            PG8_WAIT_V(8); PG8_WAIT_L(0); PG8_BAR; PG8_MMA(1, 0, At, B0); PG8_MMA(1, 1, At, B1); PG8_BAR; PG8_SCHED;
            } else {
            PG8_LDB(B0, 0, 0); PG8_SCHED; PG8_LDA(At, 0, 0); PG8_STAGE(PG8_SA(1, 1), a1 + hstep, voffA);
            PG8_WAIT_L(8); PG8_BAR; PG8_WAIT_L(0); PG8_MMA(0, 0, At, B0); PG8_BAR; PG8_SCHED;
            PG8_LDB(B1, 0, 1); PG8_STAGE(PG8_SB(0, 0), b2, voffB);
            PG8_BAR; PG8_WAIT_L(0); PG8_MMA(0, 1, At, B1); PG8_BAR;
            PG8_LDA(At, 0, 1); PG8_STAGE(PG8_SA(0, 0), a2, voffA);
            PG8_BAR; PG8_WAIT_L(0); PG8_MMA(1, 0, At, B0); PG8_BAR; PG8_SCHED;
            PG8_STAGE(PG8_SB(0, 1), b2 + hstep, voffB);
            PG8_WAIT_V(6); PG8_BAR; PG8_MMA(1, 1, At, B1); PG8_BAR;
            PG8_LDB(B0, 1, 0); PG8_SCHED; PG8_LDA(At, 1, 0); PG8_STAGE(PG8_SA(0, 1), a2 + hstep, voffA);
            PG8_WAIT_L(8); PG8_BAR; PG8_WAIT_L(0); PG8_MMA(0, 0, At, B0); PG8_BAR; PG8_SCHED;
            PG8_LDB(B1, 1, 1); PG8_STAGE(PG8_SB(1, 0), b3, voffB);
            PG8_BAR; PG8_WAIT_L(0); PG8_MMA(0, 1, At, B1); PG8_BAR;
            PG8_LDA(At, 1, 1); PG8_STAGE(PG8_SA(1, 0), a3, voffA);
            PG8_BAR; PG8_WAIT_L(0); PG8_MMA(1, 0, At, B0); PG8_BAR; PG8_SCHED;
            PG8_STAGE(PG8_SB(1, 1), b3 + hstep, voffB);
            PG8_WAIT_V(6); PG8_BAR; PG8_MMA(1, 1, At, B1); PG8_BAR;
            }
        }
        if constexpr (ALIGN_EPI) { if (wr == 0) PG8_BAR; }
        if constexpr (!Epi::AFTER_DRAIN) { E(acc, cur, wr, wc, fr, fq); S.done(cur); }
        if (!has_next) break;
#pragma unroll
        for (int a = 0; a < 2; ++a)
#pragma unroll
            for (int b = 0; b < 2; ++b)
#pragma unroll
                for (int m = 0; m < 4; ++m)
#pragma unroll
                    for (int n = 0; n < 2; ++n) acc[a][b][m][n] = (f32x4){0.f, 0.f, 0.f, 0.f};
        cur = nxt; cA = nA; cB = nB; ++ui;
        if constexpr (ALIGN_EPI) { if (wr == 1) PG8_BAR; }
    }
    PG8_WAIT_V(0);
    if constexpr (!ALIGN_EPI) { if (wr == 0) PG8_BAR; }
    PG8_BAR;
    if constexpr (Epi::AFTER_DRAIN) { E.fused(acc, cur, wr, wc, fr, fq, lds, wid, lane); S.done(cur); }
#undef PG8_SA
#undef PG8_SB
#undef PG8_STAGE
#undef PG8_LDA
#undef PG8_LDB
#undef PG8_MMA
#undef PG8_WAIT_V
#undef PG8_WAIT_L
#undef PG8_BAR
#undef PG8_SCHED
}
}

#define XB_TMO      128
#define XB_XCNT(j)  (256  + 64 * (j))
#define XB_XSUB(j)  (1280 + 64 * (j))
#define XB_XGEN(j)  (2304 + 64 * (j))
#define XB_TOP      3328
#define XB_TOPGEN   3392
#define XCD_BAR_WORDS 3456
#define XB_SPIN_CAP (1u << 18)

__device__ __forceinline__ unsigned xb_ld(unsigned* p)              { return __hip_atomic_load(p, __ATOMIC_RELAXED, __HIP_MEMORY_SCOPE_AGENT); }
__device__ __forceinline__ unsigned xb_add(unsigned* p, unsigned v) { return __hip_atomic_fetch_add(p, v, __ATOMIC_RELAXED, __HIP_MEMORY_SCOPE_AGENT); }
__device__ __forceinline__ unsigned xb_xcc_id() { return (unsigned)__builtin_amdgcn_s_getreg((3 << 11) | 20) & 0xFu; }
#define XB_SPIN(cond, bar) do { unsigned _sp = 0; while (cond) { __builtin_amdgcn_s_sleep(1); \
    if ((++_sp & 255u) == 0u) { if (xb_ld(&(bar)[XB_TMO])) break; if (_sp > XB_SPIN_CAP) { atomicAdd(&(bar)[XB_TMO], 1u); break; } } } } while (0)

struct XcdBarrier {
    unsigned* bar; unsigned x;
    volatile LAS unsigned* st;
};

__device__ __forceinline__ XcdBarrier xcd_barrier_post(unsigned* bar, volatile LAS unsigned* st) {
    XcdBarrier b; b.bar = bar; b.x = xb_xcc_id(); b.st = st;
    if (threadIdx.x == 0) (void)xb_add(&bar[XB_XCNT(b.x)], 1u);
    return b;
}
__device__ __forceinline__ void xcd_barrier_complete(unsigned* bar, unsigned x, unsigned& nloc, unsigned& nx) {
    const unsigned G = gridDim.x * gridDim.y * gridDim.z;
    unsigned sum, cnt, mine, sp = 0u;
    for (;;) {
        sum = 0u; cnt = 0u; mine = 0u;
#pragma unroll
        for (unsigned j = 0; j < 16; ++j) { const unsigned c = xb_ld(&bar[XB_XCNT(j)]); sum += c; cnt += (c > 0u) ? 1u : 0u; mine = (j == x) ? c : mine; }
        if (sum == G) break;
        __builtin_amdgcn_s_sleep(1);
        if ((++sp & 255u) == 0u) { if (xb_ld(&bar[XB_TMO])) break; if (sp > XB_SPIN_CAP) { atomicAdd(&bar[XB_TMO], 1u); break; } }
    }
    nloc = mine > 0u ? mine : 1u; nx = cnt > 0u ? cnt : 1u;
}

__device__ __forceinline__ void xcd_barrier(const XcdBarrier& b) {
    asm volatile("s_waitcnt vmcnt(0)" ::: "memory");
    __syncthreads();
    if (threadIdx.x == 0) {
        unsigned* bar = b.bar;
        __builtin_amdgcn_s_waitcnt(0);
        unsigned nloc = b.st[0], nx = b.st[1];
        if (nloc == 0u) { xcd_barrier_complete(bar, b.x, nloc, nx); b.st[0] = nloc; b.st[1] = nx; }
        const unsigned old = xb_add(&bar[XB_XSUB(b.x)], 1u);
        const unsigned gen = old / nloc;
        if (old + 1u == (gen + 1u) * nloc) {
            __builtin_amdgcn_fence(__ATOMIC_RELEASE, "agent");
            asm volatile("s_waitcnt vmcnt(0)" ::: "memory");
            const unsigned og = xb_add(&bar[XB_TOP], 1u);
            const unsigned tg = og / nx;
            if (og + 1u == (tg + 1u) * nx) xb_add(&bar[XB_TOPGEN], 1u);
            else XB_SPIN(xb_ld(&bar[XB_TOPGEN]) == tg, bar);
            __builtin_amdgcn_fence(__ATOMIC_ACQUIRE, "agent");
            xb_add(&bar[XB_XGEN(b.x)], 1u);
            asm volatile("s_waitcnt vmcnt(0)" ::: "memory");
        } else {
            XB_SPIN(xb_ld(&bar[XB_XGEN(b.x)]) == gen, bar);
            __builtin_amdgcn_fence(__ATOMIC_ACQUIRE, "agent");
            asm volatile("s_waitcnt vmcnt(0)" ::: "memory");
        }
    }
    __syncthreads();
}
__device__ __forceinline__ unsigned fkey(float f) { const unsigned u = __float_as_uint(f); return (u & 0x80000000u) ? ~u : (u | 0x80000000u); }
__device__ __forceinline__ void idx_item(Frame& F, int b, int rg) {
    const bf16_t* IQ = (const bf16_t*)(F.ws + WS_P + P_IQ); const bf16_t* IK = (const bf16_t*)(F.ws + WS_P + P_IK); const float* IW = (const float*)(F.ws + WS_P + P_IW);
    u64* maskT = (u64*)(F.ws + WS_MASK);
    LAS unsigned* cnt = (LAS unsigned*)F.lds;
    LAS unsigned* mgt = (LAS unsigned*)(F.lds + 1024);
    LAS unsigned* meq = (LAS unsigned*)(F.lds + 1024 + 8192);
    const int t0 = rg * 16, wid = F.wave, lane = F.lane, qj = lane & 15, g4 = lane >> 4;
    const int n64 = ((t0 >> 8) + 1) * 4;
    if (rg < 16) {
        for (int idx = F.tid; idx < 16 * n64; idx += NTHR) { const int row = idx & 15, j64 = idx >> 4, t = t0 + row; const int rel = t - 64 * j64;
            const u64 mk = rel >= 63 ? ~0ull : (rel < 0 ? 0ull : ((1ull << (rel + 1)) - 1ull));
            maskT[((size_t)b * 64 + j64) * SEQ + t] = mk; }
        return;
    }
    for (int i = F.tid; i < 4096; i += NTHR) mgt[i] = 0u;
    const size_t qrow = (size_t)b * SEQ + t0 + qj;
    float wq[8];
    { const f32x4 w0 = *(const f32x4*)(IW + qrow * 8), w1 = *(const f32x4*)(IW + qrow * 8 + 4); const float sc = 0.04419417382415922f;
      wq[0] = w0[0] * sc; wq[1] = w0[1] * sc; wq[2] = w0[2] * sc; wq[3] = w0[3] * sc; wq[4] = w1[0] * sc; wq[5] = w1[1] * sc; wq[6] = w1[2] * sc; wq[7] = w1[3] * sc; }
    const int ntile = rg + 1;
    const char* kbase = (const char*)IK + ((size_t)b * SEQ + wid * 16) * 128; const unsigned loff = (unsigned)(qj * 128 + g4 * 16);
    unsigned sc[32][4];
#pragma unroll
    for (int hp = 0; hp < 2; ++hp) {
        bf16x8 Bq[4][2];
#pragma unroll
        for (int h = 0; h < 4; ++h)
#pragma unroll
            for (int ks = 0; ks < 2; ++ks) Bq[h][ks] = *(const bf16x8*)(IQ + qrow * 512 + (4 * hp + h) * 64 + ks * 32 + g4 * 8);
#pragma unroll
        for (int j = 0; j < 32; ++j) {
            const int tile = wid + 8 * j;
            if (tile < ntile) {
                const char* kp = kbase + (size_t)j * 16384;
                const bf16x8 A0 = *(const bf16x8*)(kp + loff), A1 = *(const bf16x8*)(kp + loff + 64);
                f32x4 s = {0.f, 0.f, 0.f, 0.f};
                if (hp) {
#pragma unroll
                    for (int i = 0; i < 4; ++i) s[i] = __uint_as_float(sc[j][i]); }
#pragma unroll
                for (int h = 0; h < 4; ++h) { f32x4 a = __builtin_amdgcn_mfma_f32_16x16x32_bf16(A0, Bq[h][0], (f32x4){0.f, 0.f, 0.f, 0.f}, 0, 0, 0);
                    a = __builtin_amdgcn_mfma_f32_16x16x32_bf16(A1, Bq[h][1], a, 0, 0, 0);
#pragma unroll
                    for (int i = 0; i < 4; ++i) s[i] += wq[4 * hp + h] * fmaxf(a[i], 0.f); }
                if (hp == 1) {
                    if (tile == rg) {
#pragma unroll
                        for (int i = 0; i < 4; ++i) if (4 * g4 + i > qj) s[i] = -__builtin_inff(); }
#pragma unroll
                    for (int i = 0; i < 4; ++i) sc[j][i] = fkey(s[i]);
                } else {
#pragma unroll
                    for (int i = 0; i < 4; ++i) sc[j][i] = __float_as_uint(s[i]);
                }
            } else {
#pragma unroll
                for (int i = 0; i < 4; ++i) sc[j][i] = 0u;
            }
            asm volatile("" ::: "memory");
        }
    }
    unsigned prefix = 0u;
    for (int bit = 31; bit >= 0; --bit) {
        const unsigned cand = prefix | (1u << bit); unsigned c = 0u;
#pragma unroll
        for (int j = 0; j < 32; ++j)
#pragma unroll
            for (int i = 0; i < 4; ++i) c += (sc[j][i] >= cand) ? 1u : 0u;
        c += __shfl_xor(c, 16); c += __shfl_xor(c, 32);
        if (lane < 16) cnt[(bit & 1) * 128 + wid * 16 + lane] = c;
        __syncthreads();
        unsigned tot = 0u;
#pragma unroll
        for (int w = 0; w < 8; ++w) tot += cnt[(bit & 1) * 128 + w * 16 + qj];
        if (tot >= (unsigned)TOPK) prefix = cand;
    }
    const unsigned T = prefix;
    unsigned cg = 0u;
#pragma unroll
    for (int j = 0; j < 32; ++j)
#pragma unroll
        for (int i = 0; i < 4; ++i) cg += (sc[j][i] > T) ? 1u : 0u;
    cg += __shfl_xor(cg, 16); cg += __shfl_xor(cg, 32);
    __syncthreads();
    if (lane < 16) cnt[wid * 16 + lane] = cg;
    LAS unsigned* mbase = mgt + qj * 128 + (wid >> 1); const int sh0 = (wid & 1) * 16 + 4 * g4;
#pragma unroll
    for (int j = 0; j < 32; ++j) {
        const int tile = wid + 8 * j;
        if (tile < ntile) {
            unsigned g = 0u, e = 0u;
#pragma unroll
            for (int i = 0; i < 4; ++i) { g |= (sc[j][i] > T ? 1u : 0u) << i; e |= (sc[j][i] == T ? 1u : 0u) << i; }
            if (g) __hip_atomic_fetch_or(mbase + 4 * j, g << sh0, __ATOMIC_RELAXED, __HIP_MEMORY_SCOPE_WORKGROUP);
            if (e) __hip_atomic_fetch_or(mbase + 2048 + 4 * j, e << sh0, __ATOMIC_RELAXED, __HIP_MEMORY_SCOPE_WORKGROUP);
        }
    }
    __syncthreads();
    if (wid == 0 && lane < 16) {
        unsigned gt = 0u;
#pragma unroll
        for (int w = 0; w < 8; ++w) gt += cnt[w * 16 + lane];
        int need = TOPK - (int)gt, taken = 0; const int nw = (t0 + 16 + 31) >> 5;
        for (int wd = 0; wd < nw; ++wd) { unsigned e = meq[lane * 128 + wd]; if (!e) continue; int c = __popc(e);
            if (taken + c > need) { unsigned keep = 0u; int rem = need - taken; while (rem > 0) { const unsigned low = e & (0u - e); keep |= low; e ^= low; --rem; } e = keep; c = __popc(keep); }
            taken += c; mgt[lane * 128 + wd] |= e; }
    }
    __syncthreads();
    for (int idx = F.tid; idx < 16 * n64; idx += NTHR) { const int row = idx & 15, j64 = idx >> 4;
        const u64 mk = (u64)mgt[row * 128 + 2 * j64] | ((u64)mgt[row * 128 + 2 * j64 + 1] << 32);
        maskT[((size_t)b * 64 + j64) * SEQ + t0 + row] = mk; }
    __syncthreads();
}
__device__ __forceinline__ void ph_idx(Frame& F) {
    for (int c = F.bid; c < 256; c += F.G) { const int b = c & 3, base = c >> 2;
        idx_item(F, b, 255 - base); idx_item(F, b, 128 + base); idx_item(F, b, 127 - base); idx_item(F, b, base); }
}
namespace att {
constexpr int HD = 128, RS = 1024;
constexpr float SCALE = 0.08838834764831845f, THR = 8.f;
constexpr int NW = 8, QBLK = 32, KVBLK = 64, QB = NW * QBLK;
constexpr int SHM_V = KVBLK * HD * 2, SHM_K = KVBLK * HD * 2;
constexpr int LDS_ATT = 2 * SHM_V + 2 * SHM_K + NW * 64 * 4;
constexpr int LDS_TB = LDS_ATT;
typedef float f32x16 __attribute__((ext_vector_type(16)));
#define KSWZ(row, colB) ((row) * 256 + ((colB) ^ (((row) & 7) << 4)))
#define SBAR() __builtin_amdgcn_sched_barrier(0)
__device__ __forceinline__ int v_st(int k, int c) { const int kk = (k & ~0xC) | ((k & 4) << 1) | ((k & 8) >> 1); return ((kk >> 3) * 4 + (c >> 5)) * 512 + ((kk & 7) * 32 + (c & 31)) * 2; }
__device__ __forceinline__ int v_rd_base(int lane) { return ((lane & 3) << 3) | (((lane >> 2) & 3) << 6) | (((lane >> 4) & 1) << 5) | (((lane >> 5) & 1) << 8); }
constexpr int v_rd_off(int d0, int ks, int half) { return d0 * 512 + ks * 4096 + half * 2048; }
__device__ __forceinline__ int crow(int r, int hi) { return (r & 3) + 8 * (r >> 2) + 4 * hi; }
__device__ __forceinline__ bf16x8 load8(const bf16_t* p) { return *reinterpret_cast<const bf16x8*>(p); }
__device__ __forceinline__ void mask_bits(f32x16& p0, f32x16& p1, u64 mk, int hi) {
    const unsigned lo = (unsigned)mk >> (4 * hi), hh = (unsigned)(mk >> 32) >> (4 * hi);
#pragma unroll
    for (int r = 0; r < 16; ++r) { const int c = (r & 3) + 8 * (r >> 2);
        const unsigned m0 = (unsigned)((int)(lo << (31 - c)) >> 31), m1 = (unsigned)((int)(hh << (31 - c)) >> 31);
        p0[r] = __uint_as_float((__float_as_uint(p0[r]) & m0) | (0xff800000u & ~m0));
        p1[r] = __uint_as_float((__float_as_uint(p1[r]) & m1) | (0xff800000u & ~m1)); }
}
__device__ __forceinline__ void add_bias(f32x16& p0, f32x16& p1, const LAS float* tbq) {
#pragma unroll
    for (int r = 0; r < 16; ++r) { const int c = (r & 3) + 8 * (r >> 2); p0[r] += tbq[-c]; p1[r] += tbq[-c - 32]; }
}
__device__ __forceinline__ void partialSM(f32x16& p0, f32x16& p1, float& m_reg, float& mn, float& alpha) {
    float pmax = p0[0]; for (int r = 1; r < 16; ++r) pmax = fmaxf(pmax, p0[r]); for (int r = 0; r < 16; ++r) pmax = fmaxf(pmax, p1[r]);
    { auto rr = __builtin_amdgcn_permlane32_swap(__float_as_uint(pmax), __float_as_uint(pmax), false, false);
      pmax = fmaxf(__uint_as_float(rr[0]), __uint_as_float(rr[1])); }
    constexpr float C2 = 1.4426950408889634f * SCALE;
    if (__builtin_expect(__all((pmax - m_reg) * SCALE <= THR), 1)) { mn = m_reg; alpha = 1.f; }
    else { mn = fmaxf(m_reg, pmax); alpha = __builtin_amdgcn_exp2f((m_reg - mn) * C2); m_reg = mn; }
    const float mnL = -mn * C2;
    for (int r = 0; r < 16; ++r) p0[r] = fmaf(p0[r], C2, mnL); for (int r = 0; r < 16; ++r) p1[r] = fmaf(p1[r], C2, mnL);
    for (int r = 0; r < 16; ++r) p0[r] = __builtin_amdgcn_exp2f(p0[r]);
}
__device__ __forceinline__ void finishSM(f32x16& p0, f32x16& p1, float alpha, float& l_reg, bf16x8& pa0, bf16x8& pa1, bf16x8& pa2, bf16x8& pa3) {
    for (int r = 0; r < 16; ++r) p1[r] = __builtin_amdgcn_exp2f(p1[r]);
    float ps = 0; for (int r = 0; r < 16; ++r) ps += p0[r]; for (int r = 0; r < 16; ++r) ps += p1[r];
    { auto rr = __builtin_amdgcn_permlane32_swap(__float_as_uint(ps), __float_as_uint(ps), false, false);
      ps = __uint_as_float(rr[0]) + __uint_as_float(rr[1]); }
    l_reg = l_reg * alpha + ps;
#define PK4(P, B_, OUT) do { unsigned a0 = cvt_pk_bf16(P[B_+0], P[B_+1]), a1 = cvt_pk_bf16(P[B_+2], P[B_+3]);                          \
        unsigned b0 = cvt_pk_bf16(P[B_+4], P[B_+5]), b1 = cvt_pk_bf16(P[B_+6], P[B_+7]);                                             \
        auto r0 = __builtin_amdgcn_permlane32_swap(a0, b0, false, false); auto r1 = __builtin_amdgcn_permlane32_swap(a1, b1, false, false); \
        u32x4 w = {r0[0], r1[0], r0[1], r1[1]}; OUT = *reinterpret_cast<bf16x8*>(&w); } while (0)
    PK4(p0, 0, pa0); PK4(p0, 8, pa1); PK4(p1, 0, pa2); PK4(p1, 8, pa3);
#undef PK4
}
template <int KB>
__device__ __forceinline__ void qkt(f32x16& p0, f32x16& p1, const char* K_lds, int r32, int hi, const bf16x8* qr) {
    p0 = f32x16{}; p1 = f32x16{};
    const char* kb[4];
#pragma unroll
    for (int dd = 0; dd < 4; ++dd) kb[dd] = K_lds + KB * SHM_K + KSWZ(r32, (dd * 16 + hi * 8) * 2);
#pragma unroll
    for (int d0 = 0; d0 < 8; ++d0) { const char* a = kb[d0 & 3] + (d0 >> 2) * 128;
        bf16x8 b0 = *reinterpret_cast<const bf16x8*>(a);
        bf16x8 b1 = *reinterpret_cast<const bf16x8*>(a + 32 * 256);
        p0 = __builtin_amdgcn_mfma_f32_32x32x16_bf16(b0, qr[d0], p0, 0, 0, 0);
        p1 = __builtin_amdgcn_mfma_f32_32x32x16_bf16(b1, qr[d0], p1, 0, 0, 0); }
}
template <int VB>
__device__ __forceinline__ void pv_tile(f32x16* o, int vb0, bf16x8 pa0, bf16x8 pa1, bf16x8 pa2, bf16x8 pa3) {
#define TRRD(dst, off) asm volatile("ds_read_b64_tr_b16 %0, %1 offset:%2" : "=&v"(dst) : "v"(vb0), "i"(off) : "memory")
#define PV_D0(d0) do { s16x4 l0, l1, h0, h1; constexpr int b_ = VB * SHM_V + v_rd_off(d0, 0, 0); \
        TRRD(l0, b_); TRRD(h0, b_ + 2048); TRRD(l1, b_ + 4096); TRRD(h1, b_ + 6144); \
        asm volatile("s_waitcnt lgkmcnt(0)" ::: "memory"); SBAR();   \
        o[d0] = __builtin_amdgcn_mfma_f32_32x32x16_bf16(pa0, (bf16x8){l0[0], l0[1], l0[2], l0[3], h0[0], h0[1], h0[2], h0[3]}, o[d0], 0, 0, 0);   \
        o[d0] = __builtin_amdgcn_mfma_f32_32x32x16_bf16(pa1, (bf16x8){l1[0], l1[1], l1[2], l1[3], h1[0], h1[1], h1[2], h1[3]}, o[d0], 0, 0, 0);   \
        SBAR(); TRRD(l0, b_ + 8192); TRRD(h0, b_ + 10240); TRRD(l1, b_ + 12288); TRRD(h1, b_ + 14336); \
        asm volatile("s_waitcnt lgkmcnt(0)" ::: "memory"); SBAR();   \
        o[d0] = __builtin_amdgcn_mfma_f32_32x32x16_bf16(pa2, (bf16x8){l0[0], l0[1], l0[2], l0[3], h0[0], h0[1], h0[2], h0[3]}, o[d0], 0, 0, 0);   \
        o[d0] = __builtin_amdgcn_mfma_f32_32x32x16_bf16(pa3, (bf16x8){l1[0], l1[1], l1[2], l1[3], h1[0], h1[1], h1[2], h1[3]}, o[d0], 0, 0, 0); } while (0)
    PV_D0(0); PV_D0(1); PV_D0(2); PV_D0(3);
#undef PV_D0
#undef TRRD
}
struct BlockRef { const bf16_t* Q; const bf16_t* K; const bf16_t* V; bf16_t* O; const u64* MK; int P0; int h; };
struct Seam { bf16x8 qr[8]; bf16x8 st_v0, st_v1, st_k0, st_k1; };
#define LD16U(base, off) (*(const bf16x8*)((const char*)(base) + (off)))
#define VMW() asm volatile("s_waitcnt vmcnt(0)" ::: "memory")
#define TIDL() ({ int t__ = threadIdx.x; asm volatile("" : "+v"(t__)); t__; })
#define SLOAD_H(Kp, Vp, k0) do { const int t_ = TIDL(); const unsigned klo_ = (unsigned)((t_ >> 4) * RS + (t_ & 15) * 8) * 2u;   \
        const char* kb_ = (const char*)(Kp) + (size_t)(k0) * (RS * 2); const char* vb_ = (const char*)(Vp) + (size_t)(k0) * (RS * 2);   \
        S.st_v0 = LD16U(vb_, klo_); S.st_v1 = LD16U(vb_ + 32 * RS * 2, klo_); S.st_k0 = LD16U(kb_, klo_); S.st_k1 = LD16U(kb_ + 32 * RS * 2, klo_); } while (0)
#define SWRITE_HK(bf) do { const int t_ = TIDL(); const int kws_ = KSWZ(t_ >> 4, (t_ & 15) * 16); *(bf16x8*)(K_lds + (bf) * SHM_K + kws_) = S.st_k0; *(bf16x8*)(K_lds + (bf) * SHM_K + kws_ + 32 * 256) = S.st_k1; } while (0)
#define SWRITE_HV(bf) do { const int t_ = TIDL(); const int sr_ = t_ >> 4, sc_ = (t_ & 15) * 8; *(bf16x8*)(V_lds + (bf) * SHM_V + v_st(sr_, sc_)) = S.st_v0; *(bf16x8*)(V_lds + (bf) * SHM_V + v_st(32 + sr_, sc_)) = S.st_v1; } while (0)
#define SWRITE_H(bf) do { SWRITE_HV(bf); SWRITE_HK(bf); } while (0)
#define QLOAD(Qp) do { const int t_ = TIDL(); const unsigned qlo_ = (unsigned)((t_ & 31) * RS + ((t_ >> 5) & 1) * 8) * 2u; const char* qb_ = (const char*)(Qp) + (size_t)(wid * QBLK) * (RS * 2); \
        _Pragma("unroll") for (int d0 = 0; d0 < 8; ++d0) S.qr[d0] = LD16U(qb_ + d0 * 32, qlo_); } while (0)
__device__ __forceinline__ void att_prime(const BlockRef& cur, char* lds, Seam& S) {
    const int tid = threadIdx.x, wid = __builtin_amdgcn_readfirstlane(tid >> 6); char* K_lds = lds + 2 * SHM_V;
    QLOAD(cur.Q);
    SLOAD_H(cur.K, cur.V, 0); VMW(); SWRITE_HK(0);
    __syncthreads();
}
__device__ __forceinline__ void att_block(const BlockRef& cur, const BlockRef& nxt, char* lds, const LAS float* tbl, Seam& S) {
    const int tid = threadIdx.x, wid = __builtin_amdgcn_readfirstlane(tid >> 6), lane = tid & 63, r32 = lane & 31, hi = lane >> 5;
    const int NT = cur.P0 / KVBLK + 4;
    const int qlo = cur.P0 + wid * QBLK;
    char* V_lds = lds; char* K_lds = lds + 2 * SHM_V;
    float* ws = (float*)(lds + 2 * SHM_V + 2 * SHM_K) + wid * 64; float* li_l = ws, * al_l = ws + 32;
    float m_reg = -1e30f, l_reg = 0; f32x16 o[4] = {};
    const int vb0 = (int)(uintptr_t)V_lds + v_rd_base(lane);
    const bf16_t* Kh = cur.K; const bf16_t* Vh = cur.V;
    const char* mkb = (const char*)(cur.MK + qlo);
#define LDMK(j) (*(const u64*)(mkb + (size_t)(j) * (SEQ * 8) + (unsigned)(TIDL() & 31) * 8u))
#define RESC(a) do { if (__any((a) < 1.f)) { if (hi == 0) al_l[r32] = (a); asm volatile("s_waitcnt lgkmcnt(0)" ::: "memory");              \
                     for (int d_ = 0; d_ < 4; ++d_) for (int r = 0; r < 16; ++r) o[d_][r] *= al_l[crow(r, hi)]; } } while (0)
#define KBASE(t) ((t) * KVBLK)
#define MASKT(P0_, P1_, t, MK_) do { const int kb_ = KBASE(t); if (kb_ + 176 > qlo) { const int t_ = TIDL(); add_bias(P0_, P1_, tbl + cur.h * 512 + 256 + (qlo + (t_ & 31) - 4 * ((t_ >> 5) & 1) - kb_)); } mask_bits(P0_, P1_, MK_, hi); } while (0)
#define VMWN8() asm volatile("s_waitcnt vmcnt(8)" ::: "memory")
#define SEAM_K0() do { VMWN8(); SWRITE_HK(0); SBAR(); } while (0)
    f32x16 pA0, pA1, pB0, pB1; float mnA, mnB, alA, alB; bf16x8 pa0, pa1, pa2, pa3;
    u64 mk_ = LDMK(0);
    SWRITE_HV(0); SBAR();
    SLOAD_H(Kh, Vh, KBASE(1));
    SBAR(); qkt<0>(pA0, pA1, K_lds, r32, hi, S.qr);
    MASKT(pA0, pA1, 0, mk_); partialSM(pA0, pA1, m_reg, mnA, alA);
    VMW(); SWRITE_H(1);
    __syncthreads();
#define HALF_STEP(PX0, PX1, mnX, alX, PY0, PY1, alY, t, KB, VB, SB) do {                                                      \
        mk_ = LDMK(t); SBAR(); qkt<KB>(PX0, PX1, K_lds, r32, hi, S.qr);                                                                      \
        finishSM(PY0, PY1, alY, l_reg, pa0, pa1, pa2, pa3); SBAR();                                                           \
        if ((t) + 1 < NT) { SLOAD_H(Kh, Vh, KBASE((t) + 1)); SBAR(); }                                                        \
        pv_tile<VB>(o, vb0, pa0, pa1, pa2, pa3); MASKT(PX0, PX1, (t), mk_);                                                   \
        partialSM(PX0, PX1, m_reg, mnX, alX);                                                                                 \
        __syncthreads();                                                                                                      \
        if ((t) + 1 < NT) { VMW(); SWRITE_H(SB); }                                                                            \
        RESC(alX); __syncthreads(); } while (0)
    for (int t = 1; t + 1 < NT; t += 2) {
        HALF_STEP(pB0, pB1, mnB, alB, pA0, pA1, alA, t, 1, 0, 0);
        HALF_STEP(pA0, pA1, mnA, alA, pB0, pB1, alB, t + 1, 0, 1, 1);
    }
    mk_ = LDMK(NT - 1); SBAR(); qkt<1>(pB0, pB1, K_lds, r32, hi, S.qr); SBAR();
    SLOAD_H(nxt.K, nxt.V, 0); SBAR();
    QLOAD(nxt.Q);
    SBAR();
    finishSM(pA0, pA1, alA, l_reg, pa0, pa1, pa2, pa3); SBAR();
    pv_tile<0>(o, vb0, pa0, pa1, pa2, pa3);
    MASKT(pB0, pB1, NT - 1, mk_); partialSM(pB0, pB1, m_reg, mnB, alB); __syncthreads(); RESC(alB);
    finishSM(pB0, pB1, alB, l_reg, pa0, pa1, pa2, pa3); SBAR(); pv_tile<1>(o, vb0, pa0, pa1, pa2, pa3);
    SBAR(); SEAM_K0();
    if (hi == 0) li_l[r32] = l_reg; asm volatile("s_waitcnt lgkmcnt(0)" ::: "memory");
    float rli[16];
#pragma unroll
    for (int r = 0; r < 16; ++r) rli[r] = __builtin_amdgcn_rcpf(li_l[crow(r, hi)]);
    char* Ow = (char*)cur.O + (size_t)(wid * QBLK) * (RS * 2); const unsigned olo = (unsigned)(4 * ((TIDL() >> 5) & 1) * RS + (TIDL() & 31)) * 2u;
#pragma unroll
    for (int r = 0; r < 16; ++r) { const int orow0 = (r & 3) + 8 * (r >> 2);
#pragma unroll
        for (int d0 = 0; d0 < 4; ++d0) { const float v = o[d0][r] * rli[r]; const float vn = __shfl_xor(v, 1);
            if ((r32 & 1) == 0) *(unsigned*)(Ow + (size_t)orow0 * (RS * 2) + d0 * 64 + olo) = cvt_pk_bf16(v, vn); } }
    __syncthreads();
#undef LDMK
#undef RESC
#undef KBASE
#undef MASKT
#undef VMWN8
#undef SEAM_K0
#undef HALF_STEP
}
#undef LD16U
#undef VMW
#undef SLOAD_H
#undef SWRITE_HK
#undef SWRITE_HV
#undef SWRITE_H
#undef QLOAD
#undef TIDL
}
__device__ __forceinline__ void ph_att(Frame& F, char* lds) {
    const bf16_t* QA = (const bf16_t*)(F.ws + WS_P + P_QA); const bf16_t* KA = (const bf16_t*)(F.ws + WS_P + P_KA); const bf16_t* VA = (const bf16_t*)(F.ws + WS_P + P_VA);
    bf16_t* OA = (bf16_t*)(F.ws + WS_OA); const u64* maskT = (const u64*)(F.ws + WS_MASK); const float* tbg = (const float*)(F.ws + WS_TB);
    LAS float* tbl = (LAS float*)(F.lds + att::LDS_TB);
    for (int i = F.tid; i < 8 * 512; i += NTHR) { const int rel = (i & 511) - 256; tbl[i] = (rel >= 0 && rel < 128) ? tbg[(i >> 9) * 128 + rel] : 0.f; }
    __syncthreads();
    for (int c = F.bid; c < 256; c += F.G) {
        const int b = c >> 6, h = (c >> 3) & 7, x = c & 7;
        att::BlockRef r0, r1;
        { const int xb = 15 - x; const size_t ro = ((size_t)b * SEQ + 256 * xb) * 1024 + h * 128;
          r0.Q = QA + ro; r0.O = OA + ro; r0.K = KA + (size_t)b * SEQ * 1024 + h * 128; r0.V = VA + (size_t)b * SEQ * 1024 + h * 128; r0.MK = maskT + (size_t)b * 64 * SEQ; r0.P0 = 256 * xb; r0.h = h; }
        { const int xb = x; const size_t ro = ((size_t)b * SEQ + 256 * xb) * 1024 + h * 128;
          r1 = r0; r1.Q = QA + ro; r1.O = OA + ro; r1.P0 = 256 * xb; }
        att::Seam S;
        att::att_prime(r0, lds, S);
        for (int k = 0; k < 2; ++k) { att::att_block(r0, r1, lds, tbl, S); r0 = r1; }
    }
}
__device__ __forceinline__ f32x4 mfma16(bf16x8 a, bf16x8 b, f32x4 c) { return __builtin_amdgcn_mfma_f32_16x16x32_bf16(a, b, c, 0, 0, 0); }
__device__ __forceinline__ void ph_hprep(Frame& F) {
    bf16_t* BQ = (bf16_t*)(F.ws + WS_P + P_BQ); bf16_t* BG = (bf16_t*)(F.ws + WS_P + P_BG);
    bf16_t* HA = (bf16_t*)(F.ws + WS_HA); float* HDEC = (float*)(F.ws + WS_HDEC);
    LAS float* wsum = (LAS float*)F.lds;
    LAS unsigned char* qt = F.lds + 4096;
    LAS unsigned char* kt = F.lds + 4096 + 64 * 272;
    const int w = F.wave, lane = F.lane, cp = lane;
    for (int it = F.bid; it < 2048; it += F.G) {
        const int bh = it >> 6, ch = it & 63, b = bh >> 3, h = bh & 7;
        const size_t base = ((size_t)b * SEQ + ch * 64 + 8 * w) * 1024 + h * 128 + 2 * cp;
        float g0[8], g1[8], q0[8], q1[8];
#pragma unroll
        for (int r = 0; r < 8; ++r) { const unsigned gw = *(const unsigned*)(BG + base + (size_t)r * 1024), qw = *(const unsigned*)(BQ + base + (size_t)r * 1024);
            g0[r] = bflo(gw); g1[r] = bfhi(gw); q0[r] = bflo(qw); q1[r] = bfhi(qw); }
        float c0 = 0.f, c1 = 0.f, bl0[8], bl1[8];
#pragma unroll
        for (int r = 0; r < 8; ++r) { c0 += g0[r]; c1 += g1[r]; bl0[r] = c0; bl1[r] = c1; }
        wsum[w * 128 + 2 * cp] = c0; wsum[w * 128 + 2 * cp + 1] = c1;
        __syncthreads();
        float off0 = 0.f, off1 = 0.f, mid0 = 0.f, mid1 = 0.f, last0 = 0.f, last1 = 0.f;
#pragma unroll
        for (int ww = 0; ww < 8; ++ww) { const float s0 = wsum[ww * 128 + 2 * cp], s1 = wsum[ww * 128 + 2 * cp + 1];
            if (ww < w) { off0 += s0; off1 += s1; } if (ww < 4) { mid0 += s0; mid1 += s1; } last0 += s0; last1 += s1; }
#pragma unroll
        for (int r = 0; r < 8; ++r) {
            const float b0 = bl0[r] + off0, b1 = bl1[r] + off1;
            const float k0 = 1.f - __expf(g0[r]), k1 = 1.f - __expf(g1[r]);
            *(unsigned*)(BQ + base + (size_t)r * 1024) = cvt_pk_bf16(q0[r] * __expf(b0), q1[r] * __expf(b1));
            *(unsigned*)(BG + base + (size_t)r * 1024) = cvt_pk_bf16(k0 * __expf(last0 - b0), k1 * __expf(last1 - b1));
            *(LAS unsigned*)(qt + (8 * w + r) * 272 + 4 * cp) = cvt_pk_bf16(q0[r] * __expf(b0 - mid0), q1[r] * __expf(b1 - mid1));
            *(LAS unsigned*)(kt + (8 * w + r) * 272 + 4 * cp) = cvt_pk_bf16(k0 * __expf(mid0 - b0), k1 * __expf(mid1 - b1));
        }
        if (w == 0) { HDEC[(size_t)it * 128 + 2 * cp] = __expf(last0); HDEC[(size_t)it * 128 + 2 * cp + 1] = __expf(last1); }
        __syncthreads();
        { const int tt = w & 3, fr = lane & 15, g4 = lane >> 4;
          bf16x8 qf[4];
#pragma unroll
          for (int ks = 0; ks < 4; ++ks) qf[ks] = *(const LAS bf16x8*)(qt + (16 * tt + fr) * 272 + (32 * ks + 8 * g4) * 2);
#pragma unroll
          for (int si = 0; si < 2; ++si) { const int st = 2 * (w >> 2) + si; f32x4 acc = {0.f, 0.f, 0.f, 0.f};
#pragma unroll
              for (int ks = 0; ks < 4; ++ks) { const bf16x8 kf = *(const LAS bf16x8*)(kt + (16 * st + fr) * 272 + (32 * ks + 8 * g4) * 2); acc = mfma16(kf, qf[ks], acc); }
              const int t = 16 * tt + fr, s0 = 16 * st + 4 * g4;
              float x[4];
#pragma unroll
              for (int i = 0; i < 4; ++i) x[i] = (s0 + i <= t) ? acc[i] : 0.f;
              u32x2 o; o.x = cvt_pk_bf16(x[0], x[1]); o.y = cvt_pk_bf16(x[2], x[3]);
              *(u32x2*)(HA + ((size_t)it * 64 + t) * 64 + s0) = o; } }
        __syncthreads();
    }
}
__device__ __forceinline__ void ph_rprep(Frame& F) {
    const bf16_t* CQ = (const bf16_t*)(F.ws + WS_P + P_CQ); const bf16_t* CK = (const bf16_t*)(F.ws + WS_P + P_CK); bf16_t* RA = (bf16_t*)(F.ws + WS_RA);
    const int w = F.wave, lane = F.lane, fr = lane & 15, g4 = lane >> 4;
    for (int it = F.bid; it < 512; it += F.G) {
        const int bh = it >> 5, ch = it & 31, b = bh >> 2, h = bh & 3;
        const size_t base = ((size_t)b * SEQ + ch * 128) * 1024 + h * 256;
        const float gi = exp2f(-128.f * __log2f(1.f - exp2f(-5.f - (float)h)));
        bf16x8 qf[8];
#pragma unroll
        for (int ks = 0; ks < 8; ++ks) qf[ks] = *(const bf16x8*)(CQ + base + (size_t)(16 * w + fr) * 1024 + 32 * ks + 8 * g4);
        for (int st = 0; st < 8; ++st) {
            u32x2 o = {0u, 0u};
            const int t = 16 * w + fr, s0 = 16 * st + 4 * g4;
            if (st <= w) { f32x4 acc = {0.f, 0.f, 0.f, 0.f};
#pragma unroll
                for (int ks = 0; ks < 8; ++ks) { const bf16x8 kf = *(const bf16x8*)(CK + base + (size_t)(16 * st + fr) * 1024 + 32 * ks + 8 * g4); acc = mfma16(kf, qf[ks], acc); }
                float x[4];
#pragma unroll
                for (int i = 0; i < 4; ++i) x[i] = (s0 + i <= t) ? acc[i] * gi : 0.f;
                o.x = cvt_pk_bf16(x[0], x[1]); o.y = cvt_pk_bf16(x[2], x[3]); }
            *(u32x2*)(RA + ((size_t)it * 128 + t) * 128 + s0) = o;
        }
    }
}
template <int OFF> __device__ __forceinline__ s16x4 trrd(unsigned addr) { s16x4 r; asm volatile("ds_read_b64_tr_b16 %0, %1 offset:%2" : "=&v"(r) : "v"(addr), "i"(OFF) : "memory"); return r; }
__device__ __forceinline__ bf16x8 cat8(s16x4 a, s16x4 b) { return (bf16x8){a[0], a[1], a[2], a[3], b[0], b[1], b[2], b[3]}; }
template <int C, int DK, int LDQ, int LDV, bool VEC>
__device__ __forceinline__ void scan_item(LAS unsigned char* lds, int tid, int w, int lane, const bf16_t* Q, const bf16_t* Kt, const bf16_t* V, const bf16_t* A, const float* dec, float cdec, bf16_t* O, int nchunk) {
    constexpr int RSK = DK * 2 + 32, RSV = 72, RST = DK * 2 + 16;
    constexpr int KL = 0, VL = C * RSK, ST0 = VL + C * RSV, STB = 32 * RST;
    constexpr int NPK = C * DK / 8 / NTHR;
    constexpr int NKS_C = C / 32, NKS_D = DK / 32;
    constexpr int NDT = DK / 16 / 8;
    const int fr = lane & 15, g4 = lane >> 4, q4 = fr >> 2, p4 = lane & 3;
    const bool ow = w < C / 16;
    const int rt = ow ? w : 0;
    const unsigned ldsb = (unsigned)(uintptr_t)lds;
    const unsigned vtr = ldsb + VL + (8 * g4 + q4) * RSV + 8 * p4;
    const unsigned ktr = ldsb + KL + (8 * g4 + q4) * RSK + 8 * p4 + w * NDT * 32;
    f32x4 S[NDT][2];
#pragma unroll
    for (int i = 0; i < NDT; ++i) { S[i][0] = (f32x4){0.f, 0.f, 0.f, 0.f}; S[i][1] = (f32x4){0.f, 0.f, 0.f, 0.f}; }
    u32x4 kst[NPK], vst = {0u, 0u, 0u, 0u}; bf16x8 qf[NKS_D], af[NKS_C];
    const int vrow = tid >> 2, vpc = tid & 3;
    const unsigned klo = (unsigned)((tid / (DK / 8)) * LDQ + (tid % (DK / 8)) * 8) * 2u;
    const unsigned vlo = (unsigned)(vrow * LDV + vpc * 8) * 2u, qlo = (unsigned)(fr * LDQ + 8 * g4) * 2u, alo = (unsigned)(fr * C + 8 * g4) * 2u, olo = (unsigned)(fr * LDV + 4 * g4) * 2u;
    const unsigned klds = (unsigned)((tid / (DK / 8)) * RSK + (tid % (DK / 8)) * 16);
    constexpr int KROWS = NTHR / (DK / 8);
#define SC_LOADK(cc) do { const char* kb_ = (const char*)Kt + (size_t)(cc) * (C * LDQ * 2); _Pragma("unroll") for (int i = 0; i < NPK; ++i) kst[i] = *(const u32x4*)(kb_ + (size_t)i * (KROWS * LDQ * 2) + klo); \
        if (vrow < C) vst = *(const u32x4*)((const char*)V + (size_t)(cc) * (C * LDV * 2) + vlo); } while (0)
#define SC_LOADQ(cc) do { const char* qb_ = (const char*)Q + ((size_t)(cc) * C + 16 * rt) * (LDQ * 2); const char* ab_ = (const char*)A + ((size_t)(cc) * C + 16 * rt) * (C * 2); \
        _Pragma("unroll") for (int ks = 0; ks < NKS_D; ++ks) qf[ks] = *(const bf16x8*)(qb_ + ks * 64 + qlo); \
        _Pragma("unroll") for (int ks = 0; ks < NKS_C; ++ks) af[ks] = *(const bf16x8*)(ab_ + ks * 64 + alo); } while (0)
    SC_LOADK(0); SC_LOADQ(0);
    for (int c = 0; c < nchunk; ++c) {
        LAS unsigned char* stb = lds + ST0 + (c & 1) * STB;
#pragma unroll
        for (int i = 0; i < NDT; ++i)
#pragma unroll
            for (int ct = 0; ct < 2; ++ct) { u32x2 o; o.x = cvt_pk_bf16(S[i][ct][0], S[i][ct][1]); o.y = cvt_pk_bf16(S[i][ct][2], S[i][ct][3]);
                *(LAS u32x2*)(stb + (16 * ct + fr) * RST + (16 * (w * NDT + i) + 4 * g4) * 2) = o; }
#pragma unroll
        for (int i = 0; i < NPK; ++i) *(LAS u32x4*)(lds + KL + klds + i * (KROWS * RSK)) = kst[i];
        if (vrow < C) { *(LAS u32x2*)(lds + VL + vrow * RSV + vpc * 16) = (u32x2){vst.x, vst.y}; *(LAS u32x2*)(lds + VL + vrow * RSV + vpc * 16 + 8) = (u32x2){vst.z, vst.w}; }
        f32x4 dv[NDT];
#pragma unroll
        for (int i = 0; i < NDT; ++i) dv[i] = VEC ? *(const f32x4*)(dec + (size_t)c * DK + 16 * (w * NDT + i) + 4 * g4) : (f32x4){cdec, cdec, cdec, cdec};
        __syncthreads();
        if (c + 1 < nchunk) SC_LOADK(c + 1);
        bf16x8 vf0[NKS_C], vf1[NKS_C];
#pragma unroll
        for (int ks = 0; ks < NKS_C; ++ks) { s16x4 a0, a1, b0, b1;
            asm volatile("ds_read_b64_tr_b16 %0, %4 offset:%5\n\tds_read_b64_tr_b16 %1, %4 offset:%6\n\tds_read_b64_tr_b16 %2, %4 offset:%7\n\tds_read_b64_tr_b16 %3, %4 offset:%8\n\ts_waitcnt lgkmcnt(0)"
                         : "=&v"(a0), "=&v"(a1), "=&v"(b0), "=&v"(b1) : "v"(vtr + ks * 32 * RSV), "i"(0), "i"(4 * RSV), "i"(32), "i"(4 * RSV + 32) : "memory");
            vf0[ks] = cat8(a0, a1); vf1[ks] = cat8(b0, b1); }
        if (ow) {
            f32x4 acc0 = {0.f, 0.f, 0.f, 0.f}, acc1 = {0.f, 0.f, 0.f, 0.f};
#pragma unroll
            for (int ks = 0; ks < NKS_C; ++ks) { acc0 = mfma16(vf0[ks], af[ks], acc0); acc1 = mfma16(vf1[ks], af[ks], acc1); }
#pragma unroll
            for (int ks = 0; ks < NKS_D; ++ks) { const bf16x8 s0 = *(const LAS bf16x8*)(stb + fr * RST + (32 * ks + 8 * g4) * 2), s1 = *(const LAS bf16x8*)(stb + (16 + fr) * RST + (32 * ks + 8 * g4) * 2);
                acc0 = mfma16(s0, qf[ks], acc0); acc1 = mfma16(s1, qf[ks], acc1); }
            u32x2 o0, o1; o0.x = cvt_pk_bf16(acc0[0], acc0[1]); o0.y = cvt_pk_bf16(acc0[2], acc0[3]); o1.x = cvt_pk_bf16(acc1[0], acc1[1]); o1.y = cvt_pk_bf16(acc1[2], acc1[3]);
            char* op = (char*)O + ((size_t)c * C + 16 * rt) * (LDV * 2) + olo;
            *(u32x2*)op = o0; *(u32x2*)(op + 32) = o1;
            if (c + 1 < nchunk) SC_LOADQ(c + 1);
        }
#pragma unroll
        for (int i = 0; i < NDT; ++i) { S[i][0] *= dv[i]; S[i][1] *= dv[i];
#pragma unroll
            for (int ks = 0; ks < NKS_C; ++ks) { s16x4 a0, a1;
                asm volatile("ds_read_b64_tr_b16 %0, %2 offset:0\n\tds_read_b64_tr_b16 %1, %2 offset:%3\n\ts_waitcnt lgkmcnt(0)" : "=&v"(a0), "=&v"(a1) : "v"(ktr + ks * 32 * RSK + i * 32), "i"(4 * RSK) : "memory");
                const bf16x8 kf = cat8(a0, a1);
                S[i][0] = mfma16(kf, vf0[ks], S[i][0]); S[i][1] = mfma16(kf, vf1[ks], S[i][1]); } }
        __syncthreads();
    }
#undef SC_LOADK
#undef SC_LOADQ
}
__device__ __forceinline__ void ph_scan_ret(Frame& F) {
    for (int it = F.bid; it < 256; it += F.G) { const int bh = it >> 4, vs = it & 15, b = bh >> 2, h = bh & 3;
        const size_t tok = (size_t)b * SEQ;
        scan_item<128, 256, 1024, 2048, false>(F.lds, F.tid, F.wave, F.lane, (const bf16_t*)(F.ws + WS_P + P_CQ) + tok * 1024 + h * 256, (const bf16_t*)(F.ws + WS_P + P_CK) + tok * 1024 + h * 256,
            (const bf16_t*)(F.ws + WS_P + P_CV) + tok * 2048 + h * 512 + vs * 32, (const bf16_t*)(F.ws + WS_RA) + (size_t)bh * 32 * 128 * 128, nullptr, exp2f(128.f * __log2f(1.f - exp2f(-5.f - (float)h))),
            (bf16_t*)(F.ws + WS_OC) + tok * 2048 + h * 512 + vs * 32, 32); }
}
__device__ __forceinline__ void ph_scan_hgrn(Frame& F) {
    for (int it = F.bid; it < 128; it += F.G) { const int bh = it >> 2, vs = it & 3, b = bh >> 3, h = bh & 7;
        const size_t tok = (size_t)b * SEQ;
        scan_item<64, 128, 1024, 1024, true>(F.lds, F.tid, F.wave, F.lane, (const bf16_t*)(F.ws + WS_P + P_BQ) + tok * 1024 + h * 128, (const bf16_t*)(F.ws + WS_P + P_BG) + tok * 1024 + h * 128,
            (const bf16_t*)(F.ws + WS_P + P_BV) + tok * 1024 + h * 128 + vs * 32, (const bf16_t*)(F.ws + WS_HA) + (size_t)bh * 64 * 64 * 64, (const float*)(F.ws + WS_HDEC) + (size_t)bh * 64 * 128, 0.f,
            (bf16_t*)(F.ws + WS_OB) + tok * 1024 + h * 128 + vs * 32, 64); }
}
__device__ __forceinline__ void ph_post(Frame& F, const float* ng  ) {
    bf16_t* OB = (bf16_t*)(F.ws + WS_OB); bf16_t* OC = (bf16_t*)(F.ws + WS_OC); const bf16_t* BO = (const bf16_t*)(F.ws + WS_P + P_BO); const bf16_t* CG = (const bf16_t*)(F.ws + WS_P + P_CG);
    const int gw = F.bid * NWAVES + F.wave, NGW = F.G * NWAVES, lane = F.lane;
    for (int row = gw; row < M; row += NGW) {
        {
          const u32x4 a0 = *(const u32x4*)(OB + (size_t)row * 1024 + 16 * lane), a1 = *(const u32x4*)(OB + (size_t)row * 1024 + 16 * lane + 8);
          const u32x4 g0 = *(const u32x4*)(BO + (size_t)row * 1024 + 16 * lane), g1 = *(const u32x4*)(BO + (size_t)row * 1024 + 16 * lane + 8);
          float x[16] = {bflo(a0.x), bfhi(a0.x), bflo(a0.y), bfhi(a0.y), bflo(a0.z), bfhi(a0.z), bflo(a0.w), bfhi(a0.w), bflo(a1.x), bfhi(a1.x), bflo(a1.y), bfhi(a1.y), bflo(a1.z), bfhi(a1.z), bflo(a1.w), bfhi(a1.w)};
          const float gg[16] = {bflo(g0.x), bfhi(g0.x), bflo(g0.y), bfhi(g0.y), bflo(g0.z), bfhi(g0.z), bflo(g0.w), bfhi(g0.w), bflo(g1.x), bfhi(g1.x), bflo(g1.y), bfhi(g1.y), bflo(g1.z), bfhi(g1.z), bflo(g1.w), bfhi(g1.w)};
          float ss = 0.f;
#pragma unroll
          for (int j = 0; j < 16; ++j) ss += x[j] * x[j];
          ss += __shfl_xor(ss, 1); ss += __shfl_xor(ss, 2); ss += __shfl_xor(ss, 4);
          const float r = rsqrtf(ss * (1.f / 128.f) + EPS); const int d0 = (16 * lane) & 127;
#pragma unroll
          for (int j = 0; j < 16; ++j) x[j] = x[j] * r * ng[d0 + j] * gg[j];
          pg8::st8(OB + (size_t)row * 1024 + 16 * lane, x); pg8::st8(OB + (size_t)row * 1024 + 16 * lane + 8, x + 8); }
#pragma unroll
        for (int half = 0; half < 2; ++half) {
          const size_t o = (size_t)row * 2048 + 1024 * half + 16 * lane;
          const u32x4 a0 = *(const u32x4*)(OC + o), a1 = *(const u32x4*)(OC + o + 8), g0 = *(const u32x4*)(CG + o), g1 = *(const u32x4*)(CG + o + 8);
          float x[16] = {bflo(a0.x), bfhi(a0.x), bflo(a0.y), bfhi(a0.y), bflo(a0.z), bfhi(a0.z), bflo(a0.w), bfhi(a0.w), bflo(a1.x), bfhi(a1.x), bflo(a1.y), bfhi(a1.y), bflo(a1.z), bfhi(a1.z), bflo(a1.w), bfhi(a1.w)};
          const float gg[16] = {bflo(g0.x), bfhi(g0.x), bflo(g0.y), bfhi(g0.y), bflo(g0.z), bfhi(g0.z), bflo(g0.w), bfhi(g0.w), bflo(g1.x), bfhi(g1.x), bflo(g1.y), bfhi(g1.y), bflo(g1.z), bfhi(g1.z), bflo(g1.w), bfhi(g1.w)};
          float ss = 0.f;
#pragma unroll
          for (int j = 0; j < 16; ++j) ss += x[j] * x[j];
          ss += __shfl_xor(ss, 1); ss += __shfl_xor(ss, 2); ss += __shfl_xor(ss, 4); ss += __shfl_xor(ss, 8); ss += __shfl_xor(ss, 16);
          const float r = rsqrtf(ss * (1.f / 512.f) + EPS);
#pragma unroll
          for (int j = 0; j < 16; ++j) x[j] = x[j] * r * gg[j];
          pg8::st8(OC + o, x); pg8::st8(OC + o + 8, x + 8); }
    }
}
__device__ __forceinline__ void ph_norm2(Frame& F, int l, const float* g, const float* sc, const float* sh) {
    const float* X = (const float*)(F.ws + WS_X); bf16_t* H = (bf16_t*)(F.ws + WS_H); const bf16_t* RW = (const bf16_t*)(F.ws + WS_RW) + (size_t)l * 48 * 1024;
    const float* rgb = F.in(15) + l * 4; const float* reb = F.in(17) + l * 32;
    unsigned* ecnt = F.ctl + CW_ECNT + l * 64;
    int* tok_e = (int*)(F.ws + WS_TOK); int* tok_p = tok_e + 2 * M; float* tok_w = (float*)(tok_p + 2 * M);
    int2* rinfo = (int2*)(F.ws + WS_RINFO);
    LAS float* lg = (LAS float*)(F.lds + F.wave * 4096);
    const int lane = F.lane, fr = lane & 15, g4 = lane >> 4;
    const int gw = F.bid * NWAVES + F.wave, NGW = F.G * NWAVES;
    { int m1 = -1; asm volatile("" : "+v"(m1));
      for (int i = F.bid * NTHR + F.tid; i < XG_ROWS; i += F.G * NTHR) rinfo[i] = make_int2(m1, 0); }
    for (int it = gw; it < M / 16; it += NGW) {
        const int row = 16 * it + fr, b = row >> 12; const float* xr = X + (size_t)row * D;
        float ss = 0.f;
        for (int kk = 0; kk < 32; ++kk) { const f32x4 a = *(const f32x4*)(xr + 32 * kk + 8 * g4), c = *(const f32x4*)(xr + 32 * kk + 8 * g4 + 4);
            ss += (a[0] * a[0] + a[1] * a[1]) + (a[2] * a[2] + a[3] * a[3]) + (c[0] * c[0] + c[1] * c[1]) + (c[2] * c[2] + c[3] * c[3]); }
        ss += __shfl_xor(ss, 16); ss += __shfl_xor(ss, 32);
        const float r = rsqrtf(ss * (1.f / D) + EPS);
        f32x4 acc[3] = {{0.f, 0.f, 0.f, 0.f}, {0.f, 0.f, 0.f, 0.f}, {0.f, 0.f, 0.f, 0.f}};
        for (int kk = 0; kk < 32; ++kk) { const int c0 = 32 * kk + 8 * g4;
            float x[8]; { const f32x4 a = *(const f32x4*)(xr + c0), c = *(const f32x4*)(xr + c0 + 4); x[0] = a[0]; x[1] = a[1]; x[2] = a[2]; x[3] = a[3]; x[4] = c[0]; x[5] = c[1]; x[6] = c[2]; x[7] = c[3]; }
            const f32x4 ga = *(const f32x4*)(g + c0), gb = *(const f32x4*)(g + c0 + 4), sa = *(const f32x4*)(sc + b * 6 * D + c0), sb = *(const f32x4*)(sc + b * 6 * D + c0 + 4), ha = *(const f32x4*)(sh + b * 6 * D + c0), hb = *(const f32x4*)(sh + b * 6 * D + c0 + 4);
#pragma unroll
            for (int j = 0; j < 4; ++j) { x[j] = x[j] * r * ga[j] * (1.f + sa[j]) + ha[j]; x[4 + j] = x[4 + j] * r * gb[j] * (1.f + sb[j]) + hb[j]; }
            u32x4 wv; wv.x = cvt_pk_bf16(x[0], x[1]); wv.y = cvt_pk_bf16(x[2], x[3]); wv.z = cvt_pk_bf16(x[4], x[5]); wv.w = cvt_pk_bf16(x[6], x[7]);
            *(u32x4*)(H + (size_t)row * D + c0) = wv;
            const bf16x8 af = *reinterpret_cast<const bf16x8*>(&wv);
#pragma unroll
            for (int nt = 0; nt < 3; ++nt) { const bf16x8 bfm = *(const bf16x8*)(RW + (size_t)(16 * nt + fr) * 1024 + c0); acc[nt] = mfma16(af, bfm, acc[nt]); } }
#pragma unroll
        for (int nt = 0; nt < 3; ++nt)
#pragma unroll
            for (int i = 0; i < 4; ++i) lg[(4 * g4 + i) * 48 + 16 * nt + fr] = acc[nt][i];
        LDS_WAIT(); asm volatile("" ::: "memory");
        if (lane < 16) { const int tk = 16 * it + lane; const LAS float* q = lg + lane * 48;
            float mx = -1e30f; int gs = 0;
#pragma unroll
            for (int i = 0; i < 4; ++i) { const float v = q[i] + rgb[i]; if (v > mx) { mx = v; gs = i; } }
            float s = 0.f;
#pragma unroll
            for (int i = 0; i < 4; ++i) s += __expf(q[i] + rgb[i] - mx);
            const float gp = 1.f / s;
            float v0 = -1e30f, v1 = -1e30f; int i0 = 0, i1 = 0;
            for (int i = 0; i < 8; ++i) { const float e = q[4 + gs * 8 + i] + reb[gs * 8 + i];
                if (e > v0) { v1 = v0; i1 = i0; v0 = e; i0 = i; } else if (e > v1) { v1 = e; i1 = i; } }
            const float w1 = __expf(v1 - v0), den = 1.f / (1.f + w1);
            const int e0 = gs * 8 + i0, e1 = gs * 8 + i1;
            const unsigned p0 = __hip_atomic_fetch_add(ecnt + e0, 1u, __ATOMIC_RELAXED, __HIP_MEMORY_SCOPE_AGENT), p1 = __hip_atomic_fetch_add(ecnt + e1, 1u, __ATOMIC_RELAXED, __HIP_MEMORY_SCOPE_AGENT);
            tok_e[2 * tk] = e0; tok_e[2 * tk + 1] = e1; tok_p[2 * tk] = (int)p0; tok_p[2 * tk + 1] = (int)p1; tok_w[2 * tk] = gp * den; tok_w[2 * tk + 1] = gp * w1 * den; }
        LDS_WAIT(); asm volatile("" ::: "memory");
    }
}
__device__ __forceinline__ void ph_gather(Frame& F, int l) {
    const unsigned* ecnt = F.ctl + CW_ECNT + l * 64;
    const int* tok_e = (const int*)(F.ws + WS_TOK); const int* tok_p = tok_e + 2 * M; const float* tok_w = (const float*)(tok_p + 2 * M);
    int2* rinfo = (int2*)(F.ws + WS_RINFO); int* t2e = (int*)(F.ws + WS_T2E);
    const bf16_t* H = (const bf16_t*)(F.ws + WS_H); bf16_t* XG = (bf16_t*)(F.ws + WS_XG);
    LAS int* offs = (LAS int*)F.lds;
    if (F.tid == 0) { int o = 0; for (int e = 0; e < NE; ++e) { offs[e] = o; const int c = (int)__hip_atomic_load(ecnt + e, __ATOMIC_RELAXED, __HIP_MEMORY_SCOPE_AGENT); o += (c + 255) & ~255; } offs[NE] = o; }
    __syncthreads();
    if (F.bid == 0) { if (F.tid == 0) t2e[0] = offs[NE] >> 8;
        for (int e = F.tid; e < NE; e += NTHR) for (int rt = offs[e] >> 8; rt < (offs[e + 1] >> 8); ++rt) t2e[1 + rt] = e; }
    const int gw = F.bid * NWAVES + F.wave, NGW = F.G * NWAVES, lane = F.lane;
    for (int ts = gw; ts < 2 * M; ts += NGW) {
        const int e = tok_e[ts], p = tok_p[ts]; const int row = offs[e] + p; const int tk = ts >> 1;
        const u32x4 a = *(const u32x4*)(H + (size_t)tk * D + 8 * lane), c = *(const u32x4*)(H + (size_t)tk * D + 512 + 8 * lane);
        *(u32x4*)(XG + (size_t)row * D + 8 * lane) = a; *(u32x4*)(XG + (size_t)row * D + 512 + 8 * lane) = c;
        if (lane == 0) rinfo[row] = make_int2(ts, __float_as_int(tok_w[ts]));
    }
}
__device__ __forceinline__ int build_units(Frame& F, LAS int* tab) {
    const int* t2e = (const int*)(F.ws + WS_T2E); const int NT = t2e[0]; int n = 0;
    for (int i = 0; i < 8; ++i) { const int L = i * F.G + F.bid; if (L < 4 * NT) { const int rt = L >> 2; if (F.tid == 0) tab[i] = (rt << 8) | (t2e[1 + rt] * 4 + (L & 3)); n = i + 1; } }
    __syncthreads();
    return n;
}
#ifndef MK_ONE_LAUNCH
#define MK_ONE_LAUNCH 1
#endif
constexpr int NPHASE = 13;
__global__ void __launch_bounds__(NTHR, 2) mk_fwd(Args a) {
    extern __shared__ __attribute__((aligned(16))) unsigned char lds[];
    Frame F;
    F.lds = (LAS unsigned char*)lds; F.MISC = (volatile LAS unsigned*)(F.lds + MISC_OFF);
    F.tid = threadIdx.x; F.lane = F.tid & 63; F.wave = __builtin_amdgcn_readfirstlane(F.tid >> 6); F.G = gridDim.x; F.bid = blockIdx.x;
    F.ws = a.ws; F.ctl = (unsigned*)(a.ws + WS_CTL); F.out = a.out;
    for (int u = F.tid; u < 1024; u += NTHR) ((LAS unsigned*)(F.lds + MISC_OFF))[u] = 0u;
    __syncthreads();
#pragma unroll
    for (int i = 0; i < 22; ++i) if (F.tid == i) *(LAS u64*)(F.lds + MISC_OFF + 512 + 8 * i) = (u64)a.in[i];
    __syncthreads();
    XcdBarrier bar = xcd_barrier_post(F.ctl + CW_BAR, F.MISC + 8);
    const int lo = a.ph_lo, hi = a.ph_hi;
#ifndef SUB
#define SUB 7
#endif
#ifndef DBL
#define DBL 0
#endif
#define REP(k) _Pragma("nounroll") for (int rep_ = 0; rep_ < ((DBL == (k)) ? 2 : 1); ++rep_)
#ifndef PHSEL
#define PHSEL 0xffff
#endif
#define IN(k) (((PHSEL >> (k)) & 1) && lo <= (k) && (k) < hi)
#define GRID_BAR() do { if (MK_ONE_LAUNCH) xcd_barrier(bar); asm volatile("" : "+v"(F.tid), "+v"(F.lane), "+s"(F.wave) :: "memory"); } while (0)
    unsigned char* ws = a.ws; unsigned char* wb = ws + WS_W; unsigned char* pb = ws + WS_P;
    float* X = (float*)(ws + WS_X); bf16_t* H = (bf16_t*)(ws + WS_H); bf16_t* YS = (bf16_t*)(ws + WS_YS);
    const float* mod = (const float*)(ws + WS_MOD);
    LAS int* utab = (LAS int*)(F.lds + MISC_OFF + 256);

    if (IN(0) && a.lay_lo == 0) { ph_prologue(F); GRID_BAR(); }

    for (int l = a.lay_lo; l < a.lay_hi; ++l) {
        const float* md = mod + (size_t)l * BATCH * 6 * D;
        if (IN(1)) {
            REP(1) ph_conv(F, l);
            if (l == 0) ph_norm(F, F.in(0), nullptr, nullptr, nullptr, F.in(4) + l * D, md + 1 * D, md + 0 * D, H, nullptr);
            else ph_norm(F, X, YS, md - (size_t)BATCH * 6 * D + 5 * D, X, F.in(4) + l * D, md + 1 * D, md + 0 * D, H, nullptr);
            GRID_BAR();
        }
        if (IN(2)) REP(2) {
            pg8::Gemm g{H, (const bf16_t*)(wb + W_IN), M, NP, D}; pg8::StaticOrder S; S.init(M, NP, F.G, F.bid);
            pg8::EpiProj E{pb, (const float*)(ws + WS_LB) + l * 1024, (const float2*)(ws + WS_ROT)};
            pg8::gemm_phase<pg8::EpiProj, pg8::StaticOrder, true, true>(F.lds, g, S, E);
            if (rep_ == ((DBL == 2) ? 1 : 0)) GRID_BAR();
        }
        if (IN(3)) { if (SUB & 1) REP(3) ph_idx(F); if (SUB & 2) ph_hprep(F); if (SUB & 4) REP(4) ph_rprep(F); GRID_BAR(); }
        if (IN(4)) { if (SUB & 1) REP(5) ph_att(F, (char*)lds); if (SUB & 2) REP(6) ph_scan_ret(F); if (SUB & 4) REP(7) ph_scan_hgrn(F); GRID_BAR(); }
        if (IN(5)) { ph_post(F, F.in(9) + l * 128); GRID_BAR(); }
        if (IN(6)) { REP(8) {
            if (SUB & 1) { pg8::Gemm g{(const bf16_t*)(ws + WS_OA), (const bf16_t*)(wb + W_BA), M, D, 1024}; pg8::StaticOrder S; S.init(M, D, F.G, F.bid);
              pg8::EpiMerge<0> E{(const bf16_t*)(pb + P_GA), (float*)(ws + WS_MG), (bf16_t*)(ws + WS_MGB)};
              pg8::gemm_phase<pg8::EpiMerge<0>, pg8::StaticOrder, false, true>(F.lds, g, S, E); }
            if (SUB & 2) { pg8::Gemm g{(const bf16_t*)(ws + WS_OB), (const bf16_t*)(wb + W_BB), M, D, 1024}; pg8::StaticOrder S; S.init(M, D, F.G, F.bid);
              pg8::EpiMerge<1> E{(const bf16_t*)(pb + P_GB), (float*)(ws + WS_MG), (bf16_t*)(ws + WS_MGB)};
              pg8::gemm_phase<pg8::EpiMerge<1>, pg8::StaticOrder, false, true>(F.lds, g, S, E); }
            if (SUB & 4) { pg8::Gemm g{(const bf16_t*)(ws + WS_OC), (const bf16_t*)(wb + W_BC), M, D, 2048}; pg8::StaticOrder S; S.init(M, D, F.G, F.bid);
              pg8::EpiMerge<2> E{(const bf16_t*)(pb + P_GC), (float*)(ws + WS_MG), (bf16_t*)(ws + WS_MGB)};
              pg8::gemm_phase<pg8::EpiMerge<2>, pg8::StaticOrder, false, true>(F.lds, g, S, E); } }
            GRID_BAR();
        }
        if (IN(7)) {
            pg8::Gemm g{(const bf16_t*)(ws + WS_MGB), (const bf16_t*)(wb + W_OUT), M, D, 1024}; pg8::StaticOrder S; S.init(M, D, F.G, F.bid);
            pg8::EpiRes E{l == 0 ? F.in(0) : (const float*)X, X, md + 2 * D};
            pg8::gemm_phase<pg8::EpiRes, pg8::StaticOrder, false, true>(F.lds, g, S, E);
            GRID_BAR();
        }
        if (IN(8)) { ph_norm2(F, l, F.in(5) + l * D, md + 4 * D, md + 3 * D); GRID_BAR(); }
        if (IN(9)) { ph_gather(F, l); GRID_BAR(); }
        if (IN(10)) REP(9) {
            pg8::ListOrder S; S.tab = utab; S.n = build_units(F, utab);
            pg8::Gemm g{(const bf16_t*)(ws + WS_XG), (const bf16_t*)(wb + W_E1), XG_ROWS, NE * 1024, 1024};
            pg8::EpiExpUp E{(bf16_t*)(ws + WS_ACT)};
            pg8::gemm_phase<pg8::EpiExpUp, pg8::ListOrder, true, true>(F.lds, g, S, E);
            if (rep_ == ((DBL == 9) ? 1 : 0)) GRID_BAR();
        }
        if (IN(11)) REP(10) {
            pg8::ListOrder S; S.tab = utab; S.n = build_units(F, utab);
            pg8::Gemm g{(const bf16_t*)(ws + WS_ACT), (const bf16_t*)(wb + W_E2), XG_ROWS, NE * 1024, 512};
            pg8::EpiExpDown E{(const int2*)(ws + WS_RINFO), YS};
            pg8::gemm_phase<pg8::EpiExpDown, pg8::ListOrder, true, true>(F.lds, g, S, E);
            if (rep_ == ((DBL == 10) ? 1 : 0)) GRID_BAR();
        }
    }
    if (IN(12) && a.lay_hi == DEPTH) {
        const float* md3 = mod + (size_t)3 * BATCH * 6 * D;
        ph_norm(F, X, YS, md3 + 5 * D, nullptr, F.in(21), nullptr, nullptr, nullptr, F.out);
    }
#undef IN
#undef GRID_BAR
}

#ifdef MK_DIAG
__global__ void k_nonfinite(const void* p, size_t n, int is_f32, unsigned* cnt, int slot) {
    size_t i = (size_t)blockIdx.x * blockDim.x + threadIdx.x; const size_t st = (size_t)gridDim.x * blockDim.x; unsigned c = 0;
    if (is_f32) { const unsigned* q = (const unsigned*)p; for (; i < n; i += st) c += ((q[i] & 0x7f800000u) == 0x7f800000u) ? 1u : 0u; }
    else { const unsigned short* q = (const unsigned short*)p; for (; i < n; i += st) c += ((q[i] & 0x7f80u) == 0x7f80u) ? 1u : 0u; }
    if (c) atomicAdd(cnt + slot, c);
}
__global__ void k_maskcheck(const u64* maskT, unsigned* cnt, int slot) {
    const int idx = blockIdx.x * blockDim.x + threadIdx.x; if (idx >= M) return; const int b = idx >> 12, t = idx & 4095; int pc = 0;
    for (int j = 0; j <= (t >> 6); ++j) pc += __popcll(maskT[((size_t)b * 64 + j) * SEQ + t]);
    const int want = (t + 1 < 256) ? t + 1 : 256;
    if (pc != want) atomicAdd(cnt + slot, 1u);
}
__global__ void k_emit(const float* x, const float* g, const unsigned* cnt, int nslots, float* out) {
    const int row = blockIdx.x, t = threadIdx.x; float v[4], ss = 0.f;
    for (int j = 0; j < 4; ++j) { v[j] = x[(size_t)row * D + t + 256 * j]; ss += v[j] * v[j]; }
    __shared__ float red[256]; red[t] = ss; __syncthreads();
    for (int o = 128; o > 0; o >>= 1) { if (t < o) red[t] += red[t + o]; __syncthreads(); }
    const float r = rsqrtf(red[0] / D + EPS); int code = 0;
    for (int s = nslots - 1; s >= 0; --s) if (cnt[s]) code = s + 1;
    for (int j = 0; j < 4; ++j) out[(size_t)row * D + t + 256 * j] = (1.f + code) * v[j] * r * g[t + 256 * j];
}
#endif
extern "C" void kernel_launch(void* const* d_in, const int* in_sizes, int n_in, void* d_out, int out_size, void* d_ws, size_t ws_size, hipStream_t stream) {
    static int grid = 0;
    if (grid == 0) {
        if (n_in != 22 || ws_size < WS_END) { fprintf(stderr, "kernel_launch: bad n_in %d / ws %zu (need %zu)\n", n_in, ws_size, (size_t)WS_END); grid = -1; return; }
        int dev = 0, cus = 0, per_cu = 0;
        if (hipGetDevice(&dev) != hipSuccess || hipDeviceGetAttribute(&cus, hipDeviceAttributeMultiprocessorCount, dev) != hipSuccess) { grid = -1; return; }
        if (hipFuncSetAttribute((const void*)mk_fwd, hipFuncAttributeMaxDynamicSharedMemorySize, LDS_BYTES) != hipSuccess) { fprintf(stderr, "kernel_launch: hipFuncSetAttribute failed\n"); grid = -1; return; }
        if (hipOccupancyMaxActiveBlocksPerMultiprocessor(&per_cu, (const void*)mk_fwd, NTHR, LDS_BYTES) != hipSuccess || per_cu < 1) fprintf(stderr, "kernel_launch: occupancy query says %d\n", per_cu);
        (void)hipGetLastError();
        grid = cus;
    }
    if (grid < 0) return;
    (void)hipMemsetAsync((char*)d_ws + WS_CTL, 0, CTL_ZERO_BYTES, stream);
    Args a{};
    for (int i = 0; i < 22; ++i) a.in[i] = (const float*)d_in[i];
    a.out = (float*)d_out; a.ws = (unsigned char*)d_ws;
#ifdef MK_DIAG
    {
        unsigned* cnt = (unsigned*)((char*)d_ws + WS_CTL) + 200000;
        a.lay_lo = 0; a.lay_hi = 0; a.ph_lo = 0; a.ph_hi = 1;
        hipLaunchKernelGGL(mk_fwd, dim3(grid), dim3(NTHR), LDS_BYTES, stream, a);
        for (int p = 1; p <= MK_DIAG; ++p) { a.lay_lo = 0; a.lay_hi = 1; a.ph_lo = p; a.ph_hi = p + 1; hipLaunchKernelGGL(mk_fwd, dim3(grid), dim3(NTHR), LDS_BYTES, stream, a); }
        unsigned char* w = (unsigned char*)d_ws; int s = 0;
#define NF(off, n, f32) hipLaunchKernelGGL(k_nonfinite, dim3(1024), dim3(256), 0, stream, (const void*)(w + (off)), (size_t)(n), f32, cnt, s++)
        NF(WS_MOD, DEPTH * BATCH * 6 * D, 1);
        NF(WS_H, (size_t)M * D, 0);
        NF(WS_W + W_IN, (size_t)NP * D, 0);
        NF(WS_P + P_QA, (size_t)M * D * 3, 0);
        NF(WS_P + P_IQ, (size_t)M * 512, 0);
        NF(WS_P + P_IK, (size_t)M * 64, 0);
        NF(WS_P + P_IW, (size_t)M * 8, 1);
        NF(WS_P + P_BQ, (size_t)M * D * 4, 0);
        NF(WS_P + P_CQ, (size_t)M * D * 2, 0);
        NF(WS_P + P_CV, (size_t)M * 2048 * 2, 0);
        NF(WS_P + P_GA, (size_t)M * D * 3, 0);
        hipLaunchKernelGGL(k_maskcheck, dim3(M / 256), dim3(256), 0, stream, (const u64*)(w + WS_MASK), cnt, s++);
        NF(WS_HA, (size_t)2048 * 64 * 64, 0);
        NF(WS_HDEC, (size_t)2048 * 128, 1);
        NF(WS_RA, (size_t)512 * 128 * 128, 0);
        NF(WS_OA, (size_t)M * D, 0);
        NF(WS_OB, (size_t)M * D, 0);
        NF(WS_OC, (size_t)M * 2048, 0);
        NF(WS_MGB, (size_t)M * D, 0);
        NF(WS_X, (size_t)M * D, 1);
        hipLaunchKernelGGL(k_emit, dim3(M), dim3(256), 0, stream, (const float*)d_in[0], (const float*)d_in[21], cnt, s, (float*)d_out);
    }
#elif MK_ONE_LAUNCH
    a.lay_lo = 0; a.lay_hi = DEPTH; a.ph_lo = 0; a.ph_hi = NPHASE;
    hipLaunchKernelGGL(mk_fwd, dim3(grid), dim3(NTHR), LDS_BYTES, stream, a);
#else
    a.lay_lo = 0; a.lay_hi = 0; a.ph_lo = 0; a.ph_hi = 1;
    hipLaunchKernelGGL(mk_fwd, dim3(grid), dim3(NTHR), LDS_BYTES, stream, a);
#ifndef DBLH
#define DBLH 0
#endif
    for (int l = 0; l < DEPTH; ++l) for (int p = 1; p <= 11; ++p) { a.lay_lo = l; a.lay_hi = l + 1; a.ph_lo = p; a.ph_hi = p + 1; for (int r = 0; r < (p == DBLH ? 2 : 1); ++r) hipLaunchKernelGGL(mk_fwd, dim3(grid), dim3(NTHR), LDS_BYTES, stream, a); }
    a.lay_lo = DEPTH; a.lay_hi = DEPTH; a.ph_lo = 12; a.ph_hi = 13;
    hipLaunchKernelGGL(mk_fwd, dim3(grid), dim3(NTHR), LDS_BYTES, stream, a);
#endif
}
```

```cpp
#include <hip/hip_runtime.h>
#include <cstdio>
#include <cstdint>

constexpr int D = 1024, BATCH = 4, SEQ = 4096, DEPTH = 4, M = BATCH * SEQ;
constexpr int A_HEADS = 8, TOPK = 256;
constexpr int NE = 32, DEXP = 512;
constexpr int N_IN = 16968, NP = 17152;
constexpr float EPS = 1e-6f;
constexpr int O_AQ = 0, O_AK = 1024, O_AV = 2048, O_IQ = 3072, O_IK = 3584, O_IW = 3648, O_BQ = 3656, O_BF = 4680, O_BI = 5704, O_BG = 6728,
              O_CQ = 7752, O_CK = 8776, O_CV = 9800, O_CG = 11848, O_GA = 13896, O_GB = 14920, O_GC = 15944;

#define LAS __attribute__((address_space(3)))
#define GAS __attribute__((address_space(1)))
typedef unsigned short bf16_t;
typedef short bf16x8 __attribute__((ext_vector_type(8)));
typedef short s16x4 __attribute__((ext_vector_type(4)));
typedef float f32x4 __attribute__((ext_vector_type(4)));
typedef float f32x2 __attribute__((ext_vector_type(2)));
typedef unsigned u32x4 __attribute__((ext_vector_type(4)));
typedef unsigned u32x2 __attribute__((ext_vector_type(2)));
typedef unsigned long long u64;

constexpr size_t MiB = 1u << 20;
constexpr size_t WS_CTL = 0, CTL_ZERO_BYTES = 1 * MiB;
constexpr size_t WS_MOD = 1 * MiB;
constexpr size_t WS_LB = WS_MOD + 512 * 1024;
constexpr size_t WS_TB = WS_LB + 16 * 1024;
constexpr size_t WS_ROT = 2 * MiB;
constexpr size_t WS_RW = 6 * MiB;
constexpr size_t WS_X = 8 * MiB;
constexpr size_t WS_H = 72 * MiB;
constexpr size_t WS_W = 104 * MiB;
constexpr size_t W_IN = 0, W_BA = 34 * MiB, W_BB = 36 * MiB, W_BC = 38 * MiB, W_OUT = 42 * MiB, W_E1 = 44 * MiB, W_E2 = 108 * MiB;
constexpr size_t WS_P = 244 * MiB;
constexpr size_t P_QA = 0, P_KA = 32 * MiB, P_VA = 64 * MiB, P_IQ = 96 * MiB, P_IK = 112 * MiB, P_IW = 114 * MiB,
                 P_BQ = 116 * MiB, P_BG = 148 * MiB, P_BV = 180 * MiB, P_BO = 212 * MiB, P_CQ = 244 * MiB, P_CK = 276 * MiB,
                 P_CV = 308 * MiB, P_CG = 372 * MiB, P_GA = 436 * MiB, P_GB = 468 * MiB, P_GC = 500 * MiB;
constexpr size_t WS_MASK = 776 * MiB;
constexpr size_t WS_HA = 784 * MiB;
constexpr size_t WS_HDEC = 800 * MiB;
constexpr size_t WS_RA = 802 * MiB;
constexpr size_t WS_OA = 818 * MiB;
constexpr size_t WS_OB = 850 * MiB;
constexpr size_t WS_OC = 882 * MiB;
constexpr size_t WS_MG = 946 * MiB;
constexpr size_t WS_MGB = 1010 * MiB;
constexpr size_t WS_END = 1042 * MiB;
constexpr int XG_ROWS = 40960;
constexpr size_t WS_XG = WS_P, WS_ACT = WS_P + 80 * MiB, WS_YS = WS_P + 120 * MiB, WS_RINFO = WS_P + 184 * MiB, WS_TOK = WS_P + 186 * MiB, WS_T2E = WS_P + 190 * MiB;
constexpr int CW_BAR = 4096;
constexpr int CW_ECNT = 16384;
constexpr int CW_HIST = 32768;

typedef __bf16 bf16x2_n __attribute__((ext_vector_type(2)));
__device__ __forceinline__ unsigned cvt_pk_bf16(float lo, float hi) { const f32x2 v = {lo, hi}; const bf16x2_n r = __builtin_convertvector(v, bf16x2_n); return __builtin_bit_cast(unsigned, r); }
__device__ __forceinline__ float bf2f(unsigned short b) { return __uint_as_float(((unsigned)b) << 16); }
__device__ __forceinline__ float bflo(unsigned w) { return __uint_as_float(w << 16); }
__device__ __forceinline__ float bfhi(unsigned w) { return __uint_as_float(w & 0xffff0000u); }
__device__ __forceinline__ float sigmoid_f(float x) { return __builtin_amdgcn_rcpf(1.f + __expf(-x)); }
__device__ __forceinline__ float silu_f(float x) { return x * sigmoid_f(x); }
#define DPPF(v, ctrl) __int_as_float(__builtin_amdgcn_update_dpp(0, __float_as_int(v), (ctrl), 0xF, 0xF, true))
__device__ __forceinline__ float sum8(float v) { v += DPPF(v, 0xB1); v += DPPF(v, 0x4E); v += DPPF(v, 0x141); return v; }
__device__ __forceinline__ float sum16(float v) { v = sum8(v); v += DPPF(v, 0x140); return v; }
__device__ __forceinline__ float xadd16(float v) { auto r = __builtin_amdgcn_permlane16_swap(__float_as_uint(v), __float_as_uint(v), false, false); return __uint_as_float(r[0]) + __uint_as_float(r[1]); }
__device__ __forceinline__ float xadd32(float v) { auto r = __builtin_amdgcn_permlane32_swap(__float_as_uint(v), __float_as_uint(v), false, false); return __uint_as_float(r[0]) + __uint_as_float(r[1]); }
__device__ __forceinline__ float wave_sum(float v) { return xadd32(xadd16(sum16(v))); }
#define LDS_WAIT() asm volatile("s_waitcnt lgkmcnt(0)" ::: "memory")
#define VM_WAIT() asm volatile("s_waitcnt vmcnt(0)" ::: "memory")
constexpr int NWAVES = 8, NTHR = 512;
constexpr int RING_BYTES = 131072;
constexpr int MISC_OFF = 139264;
constexpr int LDS_BYTES = 147456;
struct Frame {
    LAS unsigned char* lds;
    volatile LAS unsigned* MISC;
    unsigned* ctl;
    unsigned char* ws;
    int tid, lane, wave, G, bid;
    float* out;
    __device__ __forceinline__ const float* in(int i) const { const LAS unsigned* p = (const LAS unsigned*)(lds + MISC_OFF + 512) + 2 * i;
        const unsigned lo = __builtin_amdgcn_readfirstlane(p[0]), hi = __builtin_amdgcn_readfirstlane(p[1]); return (const float*)(((u64)hi << 32) | lo); }
};
struct Args { const float* in[22]; float* out; unsigned char* ws; int lay_lo, lay_hi, ph_lo, ph_hi, dry, pad; };

__device__ __forceinline__ int t5_bucket(int rel) {
    if (rel < 16) return rel;
    int large = 16 + (int)(logf((float)rel / 16.f) / logf(8.f) * 16.f);
    return large < 31 ? large : 31;
}
__device__ __forceinline__ void ph_prologue(Frame& F) {
    const float* c = F.in(1); const float* rel_bias = F.in(2); const float* lb_raw = F.in(3); const float* ada_w = F.in(6); const float* ada_b = F.in(7);
    const float* rg_w = F.in(14); const float* re_w = F.in(16);
    float* mod = (float*)(F.ws + WS_MOD); float* lb = (float*)(F.ws + WS_LB); float* tb = (float*)(F.ws + WS_TB); float2* rot = (float2*)(F.ws + WS_ROT); bf16_t* rw = (bf16_t*)(F.ws + WS_RW);
    LAS float* sc = (LAS float*)F.lds;
    LAS float* red = (LAS float*)(F.lds + 16384);
    for (int i = F.tid; i < BATCH * D; i += NTHR) { const float v = c[i]; sc[i] = v / (1.f + __expf(-v)); }
    __syncthreads();
    for (int it = F.bid; it < DEPTH * 48; it += F.G) {
        const int l = it / 48, j0 = (it % 48) * 128, j4 = (F.tid & 31) * 4, kp = F.tid >> 5;
        const float* w = ada_w + (size_t)l * D * 6 * D + j0 + j4;
        f32x4 a0 = {0.f, 0.f, 0.f, 0.f}, a1 = a0, a2 = a0, a3 = a0;
#pragma unroll 16
        for (int k = kp * 64; k < kp * 64 + 64; ++k) { const f32x4 wv = *(const f32x4*)(w + (size_t)k * 6 * D); a0 += sc[k] * wv; a1 += sc[D + k] * wv; a2 += sc[2 * D + k] * wv; a3 += sc[3 * D + k] * wv; }
#pragma unroll
        for (int q = 0; q < 4; ++q) { LAS float* r = red + ((kp * 128 + j4 + q) * 4); r[0] = a0[q]; r[1] = a1[q]; r[2] = a2[q]; r[3] = a3[q]; }
        __syncthreads();
        { const int b = F.tid >> 7, jj = F.tid & 127;
          float s = 0.f;
#pragma unroll
          for (int p = 0; p < 16; ++p) s += red[(p * 128 + jj) * 4 + b];
          mod[((size_t)l * BATCH + b) * 6 * D + j0 + jj] = s + ada_b[l * 6 * D + j0 + jj]; }
        __syncthreads();
    }
    const int gt = F.bid * NTHR + F.tid, NT = F.G * NTHR;
    for (int d = gt; d < D; d += NT) {
        float v0 = lb_raw[d], v1 = lb_raw[D + d], v2 = lb_raw[2 * D + d], v3 = lb_raw[3 * D + d];
        const float mx = fmaxf(fmaxf(v0, v1), fmaxf(v2, v3));
        v0 = expf(v0 - mx); v1 = expf(v1 - mx); v2 = expf(v2 - mx); v3 = expf(v3 - mx);
        const float s = v0 + v1 + v2 + v3;
        lb[d] = 0.f; lb[D + d] = v1 / s; lb[2 * D + d] = (v1 + v2) / s; lb[3 * D + d] = (v1 + v2 + v3) / s;
    }
    { const double th = exp(-(double)(gt & 127) / 127.0 * 9.210340371976184);
      for (int idx = gt; idx < SEQ * 128; idx += NT) { const int t = idx >> 7;
          const double a = (double)t * th, k = rint(a * 0.15915494309189535), r = fma(-k, 6.283185307179586, a);
          const float rf = (float)r;
          rot[idx] = make_float2(cosf(rf), sinf(rf)); } }
    for (int idx = gt; idx < 8 * 128; idx += NT) { const int h = idx >> 7, rel = idx & 127;
        tb[idx] = (rel_bias[t5_bucket(rel) * A_HEADS + h] - rel_bias[31 * A_HEADS + h]) * 11.313708498984761f; }
    for (int idx = gt; idx < DEPTH * 48 * D; idx += NT) { const int l = idx / (48 * D), r = idx % (48 * D), n = r >> 10, k = r & 1023;
        float v = 0.f; if (n < 4) v = rg_w[((size_t)l * D + k) * 4 + n]; else if (n < 36) v = re_w[((size_t)l * D + k) * 32 + (n - 4)];
        rw[idx] = (bf16_t)(cvt_pk_bf16(v, 0.f) & 0xffffu); }
}

__device__ __forceinline__ void conv_load(const float* W, int ldw, int nvalid, int k0, int lane, f32x4 (&v)[16]) {
    const int nq = (lane & 15) * 4, kq = lane >> 4; const bool ok = nq < nvalid;
#pragma unroll
    for (int i = 0; i < 16; ++i) v[i] = ok ? __builtin_nontemporal_load((const __attribute__((address_space(1))) f32x4*)(W + (size_t)(k0 + 4 * i + kq) * ldw + nq)) : (f32x4){0.f, 0.f, 0.f, 0.f};
}
__device__ __forceinline__ void conv_store(const f32x4 (&v)[16], bf16_t* dst, int K, int k0, LAS float* scr, int lane) {
    const int nq = (lane & 15) * 4, kq = lane >> 4;
#pragma unroll
    for (int i = 0; i < 16; ++i) { LAS float* p = scr + (4 * i + kq) * 65 + nq; p[0] = v[i][0]; p[1] = v[i][1]; p[2] = v[i][2]; p[3] = v[i][3]; }
    LDS_WAIT(); asm volatile("" ::: "memory");
    const int c = lane & 7;
#pragma unroll
    for (int j = 0; j < 8; ++j) { const int n = (lane >> 3) + 8 * j; const LAS float* s = scr + (8 * c) * 65 + n;
        u32x4 o; o.x = cvt_pk_bf16(s[0 * 65], s[1 * 65]); o.y = cvt_pk_bf16(s[2 * 65], s[3 * 65]); o.z = cvt_pk_bf16(s[4 * 65], s[5 * 65]); o.w = cvt_pk_bf16(s[6 * 65], s[7 * 65]);
        *(u32x4*)(dst + (size_t)n * K + k0 + 8 * c) = o; }
    LDS_WAIT(); asm volatile("" ::: "memory");
}
__device__ __forceinline__ void conv_decode(Frame& F, int l, int it, const float*& W, int& ldw, int& nv, bf16_t*& dst, int& K, int& k0) {
    unsigned char* wb = F.ws + WS_W;
    constexpr int I_IN = 268 * 16, I_B = 16 * 16, I_C = 16 * 32, I_E1 = 32 * 16 * 16;
    int r = it; nv = 64; ldw = D; K = 1024;
    if (r < I_IN) { const int nb = r >> 4, kb = r & 15, n0 = nb * 64; int c0;
        if (n0 + 64 <= 3656) { c0 = n0; nv = 64; } else if (n0 < 3656) { c0 = n0; nv = 3656 - n0; } else if (n0 < 3840) { c0 = 0; nv = 0; } else { c0 = n0 - 184; nv = 64; }
        W = F.in(8) + (size_t)l * D * N_IN + c0; ldw = N_IN; dst = (bf16_t*)(wb + W_IN) + (size_t)n0 * D; K = D; k0 = kb * 64; return; }
    r -= I_IN;
    if (r < I_B) { W = F.in(10) + (size_t)l * 1024 * D + (r >> 4) * 64; dst = (bf16_t*)(wb + W_BA) + (size_t)(r >> 4) * 64 * 1024; k0 = (r & 15) * 64; return; }
    r -= I_B;
    if (r < I_B) { W = F.in(11) + (size_t)l * 1024 * D + (r >> 4) * 64; dst = (bf16_t*)(wb + W_BB) + (size_t)(r >> 4) * 64 * 1024; k0 = (r & 15) * 64; return; }
    r -= I_B;
    if (r < I_C) { const int nb = r >> 5, kb = r & 31;
        W = F.in(12) + ((size_t)l * 2048 + (kb >> 4) * 1024) * D + nb * 64; dst = (bf16_t*)(wb + W_BC + (size_t)(kb >> 4) * 2 * MiB) + (size_t)nb * 64 * 1024; k0 = (kb & 15) * 64; return; }
    r -= I_C;
    if (r < I_B) { W = F.in(13) + (size_t)l * D * D + (r >> 4) * 64; dst = (bf16_t*)(wb + W_OUT) + (size_t)(r >> 4) * 64 * 1024; k0 = (r & 15) * 64; return; }
    r -= I_B;
    if (r < I_E1) { const int e = r >> 8, q = r & 255, nb = q >> 4, kb = q & 15, n0 = nb * 64;
        const int pn = n0 >> 8, bj = (n0 >> 7) & 1, j0 = n0 & 127;
        W = (bj ? F.in(19) : F.in(18)) + ((size_t)l * NE + e) * D * DEXP + 128 * pn + j0; ldw = DEXP; dst = (bf16_t*)(wb + W_E1) + ((size_t)e * 1024 + n0) * 1024; k0 = kb * 64; return; }
    r -= I_E1;
    { const int e = r >> 7, q = r & 127, nb = q >> 3, kb = q & 7;
      W = F.in(20) + ((size_t)l * NE + e) * DEXP * D + nb * 64; dst = (bf16_t*)(wb + W_E2) + ((size_t)e * 1024 + nb * 64) * 512; K = 512; k0 = kb * 64; }
}
__device__ __forceinline__ void ph_conv(Frame& F, int l) {
    LAS float* scr = (LAS float*)(F.lds + F.wave * 16640);
    const int gw = F.bid * NWAVES + F.wave, NGW = F.G * NWAVES;
    constexpr int NITEMS = 268 * 16 + 3 * (16 * 16) + 16 * 32 + 32 * 16 * 16 + 32 * 16 * 8;
    int it = gw; if (it >= NITEMS) return;
    const float* W; int ldw, nv, K, k0; bf16_t* dst; f32x4 v[16];
    conv_decode(F, l, it, W, ldw, nv, dst, K, k0); conv_load(W, ldw, nv, k0, F.lane, v);
    for (;;) {
        const int nit = it + NGW; const bool has = nit < NITEMS;
        const float* W2 = W; int ldw2 = ldw, nv2 = 0, K2 = K, k02 = k0; bf16_t* dst2 = dst; f32x4 v2[16];
        if (has) { conv_decode(F, l, nit, W2, ldw2, nv2, dst2, K2, k02); conv_load(W2, ldw2, nv2, k02, F.lane, v2); }
        conv_store(v, dst, K, k0, scr, F.lane);
        if (!has) break;
        it = nit; dst = dst2; K = K2; k0 = k02;
#pragma unroll
        for (int i = 0; i < 16; ++i) v[i] = v2[i];
    }
}

__device__ __forceinline__ void ph_norm(Frame& F, const float* xs32, const bf16_t* xs16, const bf16_t* ys, const float* gt2, bf16_t* xd16, const float* g, const float* sc, const float* sh, bf16_t* hout, float* fout) {
    const int gw = F.bid * NWAVES + F.wave, NGW = F.G * NWAVES;
    f32x4 gv[4];
#pragma unroll
    for (int j = 0; j < 4; ++j) gv[j] = *(const f32x4*)(g + 4 * F.lane + 256 * j);
    for (int row0 = gw; row0 < M; row0 += 2 * NGW) {
        f32x4 v[2][4], scv[2][4], shv[2][4]; float ss[2] = {0.f, 0.f};
#pragma unroll
        for (int q = 0; q < 2; ++q) { const int row = row0 + q * NGW, b = row >> 12;
#pragma unroll
            for (int j = 0; j < 4; ++j) { const int c = 4 * F.lane + 256 * j;
                if (sc) { scv[q][j] = *(const f32x4*)(sc + b * 6 * D + c); shv[q][j] = *(const f32x4*)(sh + b * 6 * D + c); }
                if (xs32) v[q][j] = *(const f32x4*)(xs32 + (size_t)row * D + c);
                else { const u32x2 xw = *(const u32x2*)(xs16 + (size_t)row * D + c); v[q][j] = (f32x4){bflo(xw.x), bfhi(xw.x), bflo(xw.y), bfhi(xw.y)}; }
                if (ys) { const u32x2 y0 = *(const u32x2*)(ys + ((size_t)row * 2) * D + c), y1 = *(const u32x2*)(ys + ((size_t)row * 2 + 1) * D + c); const f32x4 gg = *(const f32x4*)(gt2 + b * 6 * D + c);
                    v[q][j][0] += gg[0] * (bflo(y0.x) + bflo(y1.x)); v[q][j][1] += gg[1] * (bfhi(y0.x) + bfhi(y1.x)); v[q][j][2] += gg[2] * (bflo(y0.y) + bflo(y1.y)); v[q][j][3] += gg[3] * (bfhi(y0.y) + bfhi(y1.y)); } } }
#pragma unroll
        for (int q = 0; q < 2; ++q)
#pragma unroll
            for (int j = 0; j < 4; ++j) ss[q] += (v[q][j][0] * v[q][j][0] + v[q][j][1] * v[q][j][1]) + (v[q][j][2] * v[q][j][2] + v[q][j][3] * v[q][j][3]);
#pragma unroll
        for (int q = 0; q < 2; ++q) { const int row = row0 + q * NGW;
            const float r = rsqrtf(wave_sum(ss[q]) * (1.f / D) + EPS);
#pragma unroll
            for (int j = 0; j < 4; ++j) { const int c = 4 * F.lane + 256 * j;
                if (xd16) { u32x2 xw; xw.x = cvt_pk_bf16(v[q][j][0], v[q][j][1]); xw.y = cvt_pk_bf16(v[q][j][2], v[q][j][3]); *(u32x2*)(xd16 + (size_t)row * D + c) = xw; }
                f32x4 o = v[q][j] * r * gv[j];
                if (sc) o = o * (1.f + scv[q][j]) + shv[q][j];
                if (hout) { u32x2 w; w.x = cvt_pk_bf16(o[0], o[1]); w.y = cvt_pk_bf16(o[2], o[3]); *(u32x2*)(hout + (size_t)row * D + c) = w; }
                else *(f32x4*)(fout + (size_t)row * D + c) = o; } }
    }
}
namespace pg8 {
#define PG8_LAS __attribute__((address_space(3)))
typedef unsigned short bf16_t;
typedef short bf16x8 __attribute__((ext_vector_type(8)));
typedef float f32x4 __attribute__((ext_vector_type(4)));
typedef unsigned u32x4 __attribute__((ext_vector_type(4)));
constexpr int BM = 256, BK = 64, HALF = 128, HTB = HALF * BK * 2  , STAGE_BYTES = 8 * HTB, NXCD = 8, WGM = 8;

__host__ __device__ __forceinline__ int lds_byte(int r, int c) { const int st = (r >> 4) * 2 + (c >> 5), rr = r & 15, cc = c & 31, ob = rr * 64 + cc * 2; return st * 1024 + (ob ^ (((ob >> 9) & 1) << 5)); }
__host__ __device__ __forceinline__ void stage_rc(int b, int& R, int& C) { const int st = b / 1024, sb = b % 1024, swz = sb ^ (((sb >> 9) & 1) << 5); R = (st >> 1) * 16 + swz / 64; C = (st & 1) * 32 + (swz % 64) / 2; }
__host__ __device__ __forceinline__ int perm32(int rho) { const int n = rho >> 4, i = rho & 15; return 8 * (i >> 2) + 4 * n + (i & 3); }

struct Unit { int pm, pn; };
struct Gemm { const bf16_t* A; const bf16_t* Bt; int M, N, K; };

struct StaticOrder {
    static constexpr bool GATHER = false;
    int nM, nN, nwg, G, c;
    __host__ __device__ void init(int M, int N, int G_, int c_) { nM = M / BM; nN = N / BM; nwg = nM * nN; G = G_; c = c_; }
    __host__ __device__ bool next(int i, Unit& u) const {
        const long L = (long)i * G + c; if (L >= nwg) return false;
        int wgid = (int)L; { const int q = nwg / NXCD, r = nwg % NXCD, xcd = wgid % NXCD, off = wgid / NXCD; wgid = (xcd < r ? xcd * (q + 1) : r * (q + 1) + (xcd - r) * q) + off; }
        const int nig = WGM * nN, gid = wgid / nig, fm = gid * WGM, gsz = (nM - fm) < WGM ? (nM - fm) : WGM;
        u.pm = fm + ((wgid % nig) % gsz); u.pn = (wgid % nig) / gsz; return true;
    }
    __device__ __forceinline__ void a_ready(const Unit&) const {}
    __device__ __forceinline__ void done(const Unit&) const {}
};


__device__ __forceinline__ void st8(bf16_t* p, const float* x) { u32x4 w; w.x = cvt_pk_bf16(x[0], x[1]); w.y = cvt_pk_bf16(x[2], x[3]); w.z = cvt_pk_bf16(x[4], x[5]); w.w = cvt_pk_bf16(x[6], x[7]); *(u32x4*)p = w; }
enum { K_PLAIN = 0, K_LOGF = 1, K_SILU = 2, K_SIGM = 3, K_ROTQ = 4, K_ROTK = 5, K_IDX = 6 };
struct EpiProj {
    static constexpr bool PERM = true, AFTER_DRAIN = false, CHAIN = false;
    unsigned char* pb;
    const float* lb;
    const float2* rot;
    __device__ __forceinline__ void operator()(const f32x4 (&acc)[2][2][4][2], const Unit& u, int wr, int wc, int fr, int fq) const {
        const int pn = u.pn; size_t off; int ld, cb, kind, hd = 0;
        if (pn < 12) { off = P_QA + (size_t)(pn >> 2) * 32 * MiB; ld = 1024; cb = (pn & 3) * 256; kind = K_PLAIN; }
        else if (pn < 14) { off = P_IQ; ld = 512; cb = (pn - 12) * 256; kind = K_PLAIN; }
        else if (pn == 14) { off = P_IK; ld = 64; cb = 0; kind = K_IDX; }
        else if (pn < 31) { const int q = pn - 15, t = q >> 2; off = P_BQ + (size_t)t * 32 * MiB; ld = 1024; cb = (q & 3) * 256; kind = (t == 1) ? K_LOGF : (t == 3) ? K_SILU : K_PLAIN; }
        else if (pn < 39) { const int q = pn - 31, t = q >> 2; off = P_CQ + (size_t)t * 32 * MiB; ld = 1024; cb = (q & 3) * 256; kind = t ? K_ROTK : K_ROTQ; hd = q & 3; }
        else if (pn < 55) { const int q = pn - 39, t = q >> 3; off = P_CV + (size_t)t * 64 * MiB; ld = 2048; cb = (q & 7) * 256; kind = t ? K_SILU : K_PLAIN; }
        else { const int q = pn - 55, t = q >> 2; off = P_GA + (size_t)t * 32 * MiB; ld = 1024; cb = (q & 3) * 256; kind = K_SIGM; }
        bf16_t* base = (bf16_t*)(pb + off);
        const int row0 = u.pm * BM + wr * 64 + fr, cl0 = wc * 32 + 8 * fq;
        if (kind == K_IDX) {
            float* iw = (float*)(pb + P_IW);
#pragma unroll
            for (int ai = 0; ai < 2; ++ai)
#pragma unroll
                for (int m = 0; m < 4; ++m) { const int row = row0 + ai * HALF + m * 16;
                    if (cl0 < 64) { float x[8] = {acc[ai][0][m][0][0], acc[ai][0][m][0][1], acc[ai][0][m][0][2], acc[ai][0][m][0][3], acc[ai][0][m][1][0], acc[ai][0][m][1][1], acc[ai][0][m][1][2], acc[ai][0][m][1][3]};
                        st8(base + (size_t)row * 64 + cl0, x); }
                    else if (cl0 == 64) { *(f32x4*)(iw + (size_t)row * 8) = acc[ai][0][m][0]; *(f32x4*)(iw + (size_t)row * 8 + 4) = acc[ai][0][m][1]; } }
            return;
        }
        switch (kind) {
            case K_LOGF: body<K_LOGF>(acc, base, row0, ld, cb, cl0, hd); break;
            case K_SILU: body<K_SILU>(acc, base, row0, ld, cb, cl0, hd); break;
            case K_SIGM: body<K_SIGM>(acc, base, row0, ld, cb, cl0, hd); break;
            case K_ROTQ: body<K_ROTQ>(acc, base, row0, ld, cb, cl0, hd); break;
            case K_ROTK: body<K_ROTK>(acc, base, row0, ld, cb, cl0, hd); break;
            default:     body<K_PLAIN>(acc, base, row0, ld, cb, cl0, hd); break;
        }
    }
    template <int KIND>
    __device__ __forceinline__ void body(const f32x4 (&acc)[2][2][4][2], bf16_t* base, int row0, int ld, int cb, int cl0, int hd) const {
        const float l2g = __log2f(1.f - exp2f(-5.f - (float)hd));
        float lv[2][8];
        if constexpr (KIND == K_LOGF) {
#pragma unroll
            for (int bj = 0; bj < 2; ++bj) { const f32x4 l0 = *(const f32x4*)(lb + cb + bj * HALF + cl0), l1 = *(const f32x4*)(lb + cb + bj * HALF + cl0 + 4);
                lv[bj][0] = l0[0]; lv[bj][1] = l0[1]; lv[bj][2] = l0[2]; lv[bj][3] = l0[3]; lv[bj][4] = l1[0]; lv[bj][5] = l1[1]; lv[bj][6] = l1[2]; lv[bj][7] = l1[3]; } }
#pragma unroll
        for (int ai = 0; ai < 2; ++ai)
#pragma unroll
            for (int m = 0; m < 4; ++m) { const int row = row0 + ai * HALF + m * 16; bf16_t* rowp = base + (size_t)row * ld + cb + cl0;
                f32x4 rr[2][2];
                if constexpr (KIND == K_ROTQ || KIND == K_ROTK) { const int pos = row & (SEQ - 1);
#pragma unroll
                    for (int bj = 0; bj < 2; ++bj) { const int i0 = (bj * HALF + cl0) >> 1; rr[bj][0] = *(const f32x4*)(rot + (size_t)pos * 128 + i0); rr[bj][1] = *(const f32x4*)(rot + (size_t)pos * 128 + i0 + 2); } }
#pragma unroll
                for (int bj = 0; bj < 2; ++bj) {
                    float x[8] = {acc[ai][bj][m][0][0], acc[ai][bj][m][0][1], acc[ai][bj][m][0][2], acc[ai][bj][m][0][3], acc[ai][bj][m][1][0], acc[ai][bj][m][1][1], acc[ai][bj][m][1][2], acc[ai][bj][m][1][3]};
                    if constexpr (KIND == K_LOGF) {
#pragma unroll
                        for (int j = 0; j < 8; ++j) x[j] = fmaxf(__logf(lv[bj][j] + (1.f - lv[bj][j]) * sigmoid_f(x[j])), -60.f); }
                    else if constexpr (KIND == K_SILU) {
#pragma unroll
                        for (int j = 0; j < 8; ++j) x[j] = silu_f(x[j]); }
                    else if constexpr (KIND == K_SIGM) {
#pragma unroll
                        for (int j = 0; j < 8; ++j) x[j] = sigmoid_f(x[j]); }
                    else if constexpr (KIND == K_ROTQ || KIND == K_ROTK) {
                        const int pos = row & (SEQ - 1), e = pos & 127;
                        const f32x4 r0 = rr[bj][0], r1 = rr[bj][1];
                        const float s = (KIND == K_ROTQ) ? exp2f((float)(e + 1) * l2g) : 0.0625f * exp2f((float)(127 - e) * l2g);
                        const float cs[8] = {r0[0], r0[1], r0[2], r0[3], r1[0], r1[1], r1[2], r1[3]};
#pragma unroll
                        for (int j = 0; j < 4; ++j) { const float a = x[2 * j], b = x[2 * j + 1], c = cs[2 * j], sn = cs[2 * j + 1]; x[2 * j] = (a * c - b * sn) * s; x[2 * j + 1] = (b * c + a * sn) * s; } }
                    st8(rowp + bj * HALF, x); } }
    }
};
template <int STEP> struct EpiMerge {
    static constexpr bool PERM = false, AFTER_DRAIN = false, CHAIN = false;
    const bf16_t* gate; float* mg; bf16_t* mgb;
    __device__ __forceinline__ void operator()(const f32x4 (&acc)[2][2][4][2], const Unit& u, int wr, int wc, int fr, int fq) const {
        const int row0 = u.pm * BM + wr * 64 + fr, col0 = u.pn * BM + wc * 32 + 4 * fq;
#pragma unroll
        for (int ai = 0; ai < 2; ++ai)
#pragma unroll
            for (int m = 0; m < 4; ++m) { const size_t ro = (size_t)(row0 + ai * HALF + m * 16) * 1024 + col0;
#pragma unroll
                for (int bj = 0; bj < 2; ++bj)
#pragma unroll
                    for (int n = 0; n < 2; ++n) { const size_t o = ro + bj * HALF + n * 16; const u32x2 gw = *(const u32x2*)(gate + o);
                        f32x4 v = acc[ai][bj][m][n] * (f32x4){bflo(gw.x), bfhi(gw.x), bflo(gw.y), bfhi(gw.y)};
                        if (STEP > 0) v += *(const f32x4*)(mg + o);
                        if (STEP < 2) *(f32x4*)(mg + o) = v;
                        else { u32x2 w; w.x = cvt_pk_bf16(v[0], v[1]); w.y = cvt_pk_bf16(v[2], v[3]); *(u32x2*)(mgb + o) = w; } } }
    }
};
struct SegOrder {
    static constexpr bool GATHER = false;
    int pm0, pn0;
    __device__ __forceinline__ bool next(int i, Unit& u) const { if (i >= 4) return false; u.pm = i * 64 + pm0; u.pn = i * 4 + pn0; return true; }
    __device__ __forceinline__ void a_ready(const Unit&) const {}
    __device__ __forceinline__ void done(const Unit&) const {}
};
struct EpiMerge4 {
    static constexpr bool PERM = false, AFTER_DRAIN = false, CHAIN = true;
    const bf16_t* gate0; bf16_t* mgb;
    __device__ __forceinline__ void operator()(const f32x4 (&)[2][2][4][2], const Unit&, int, int, int, int) const {}
    __device__ __forceinline__ bool chain(f32x4 (&acc)[2][2][4][2], const Unit& u, int wr, int wc, int fr, int fq) const {
        const int seg = u.pm >> 6, pm = u.pm & 63, pn = u.pn & 3;
        if (seg == 2) return true;
        const bf16_t* gn = gate0 + (size_t)seg * (16 * MiB);
        const int row0 = pm * BM + wr * 64 + fr, col0 = pn * BM + wc * 32 + 4 * fq;
#pragma unroll
        for (int ai = 0; ai < 2; ++ai)
#pragma unroll
            for (int m = 0; m < 4; ++m) { const size_t ro = (size_t)(row0 + ai * HALF + m * 16) * 1024 + col0;
#pragma unroll
                for (int bj = 0; bj < 2; ++bj)
#pragma unroll
                    for (int n = 0; n < 2; ++n) { const size_t o = ro + bj * HALF + n * 16;
                        if (seg < 2) { const u32x2 a = *(const u32x2*)(gn + o), d = *(const u32x2*)(gn + (size_t)16 * MiB + o);
                            const float GMIN = 9.094947e-13f;
                            const f32x4 r = {fmaxf(bflo(a.x), GMIN) * __builtin_amdgcn_rcpf(fmaxf(bflo(d.x), GMIN)), fmaxf(bfhi(a.x), GMIN) * __builtin_amdgcn_rcpf(fmaxf(bfhi(d.x), GMIN)),
                                             fmaxf(bflo(a.y), GMIN) * __builtin_amdgcn_rcpf(fmaxf(bflo(d.y), GMIN)), fmaxf(bfhi(a.y), GMIN) * __builtin_amdgcn_rcpf(fmaxf(bfhi(d.y), GMIN))};
                            acc[ai][bj][m][n] *= r; }
                        else { const u32x2 a = *(const u32x2*)(gate0 + (size_t)32 * MiB + o);
                            const float GMIN = 9.094947e-13f;
                            const f32x4 v = acc[ai][bj][m][n] * (f32x4){fmaxf(bflo(a.x), GMIN), fmaxf(bfhi(a.x), GMIN), fmaxf(bflo(a.y), GMIN), fmaxf(bfhi(a.y), GMIN)};
                            u32x2 w; w.x = cvt_pk_bf16(v[0], v[1]); w.y = cvt_pk_bf16(v[2], v[3]); *(u32x2*)(mgb + o) = w; } } }
        return seg < 3;
    }
};
struct EpiRes {
    static constexpr bool PERM = false, AFTER_DRAIN = false, CHAIN = false;
    const float* xs32; const bf16_t* xs16; bf16_t* xd; const float* gt;
    __device__ __forceinline__ void operator()(const f32x4 (&acc)[2][2][4][2], const Unit& u, int wr, int wc, int fr, int fq) const {
        const int row0 = u.pm * BM + wr * 64 + fr, col0 = u.pn * BM + wc * 32 + 4 * fq; const int b = (u.pm * BM) >> 12;
#pragma unroll
        for (int ai = 0; ai < 2; ++ai)
#pragma unroll
            for (int m = 0; m < 4; ++m) { const size_t ro = (size_t)(row0 + ai * HALF + m * 16) * 1024 + col0;
#pragma unroll
                for (int bj = 0; bj < 2; ++bj)
#pragma unroll
                    for (int n = 0; n < 2; ++n) { const size_t o = ro + bj * HALF + n * 16; const f32x4 g = *(const f32x4*)(gt + b * 6 * D + col0 + bj * HALF + n * 16);
                        f32x4 x;
                        if (xs32) x = *(const f32x4*)(xs32 + o); else { const u32x2 xw = *(const u32x2*)(xs16 + o); x = (f32x4){bflo(xw.x), bfhi(xw.x), bflo(xw.y), bfhi(xw.y)}; }
                        x += g * acc[ai][bj][m][n];
                        u32x2 w; w.x = cvt_pk_bf16(x[0], x[1]); w.y = cvt_pk_bf16(x[2], x[3]); *(u32x2*)(xd + o) = w; } }
    }
};
struct EpiExpUp {
    static constexpr bool PERM = true, AFTER_DRAIN = false, CHAIN = false;
    bf16_t* act;
    __device__ __forceinline__ void operator()(const f32x4 (&acc)[2][2][4][2], const Unit& u, int wr, int wc, int fr, int fq) const {
        const int row0 = u.pm * BM + wr * 64 + fr, col0 = (u.pn & 3) * 128 + wc * 32 + 8 * fq;
#pragma unroll
        for (int ai = 0; ai < 2; ++ai)
#pragma unroll
            for (int m = 0; m < 4; ++m) { float x[8];
#pragma unroll
                for (int n = 0; n < 2; ++n)
#pragma unroll
                    for (int i = 0; i < 4; ++i) x[4 * n + i] = silu_f(acc[ai][0][m][n][i]) * acc[ai][1][m][n][i];
                st8(act + (size_t)(row0 + ai * HALF + m * 16) * DEXP + col0, x); }
    }
};
struct EpiExpDown {
    static constexpr bool PERM = true, AFTER_DRAIN = false, CHAIN = false;
    const int2* rinfo; bf16_t* ys;
    __device__ __forceinline__ void operator()(const f32x4 (&acc)[2][2][4][2], const Unit& u, int wr, int wc, int fr, int fq) const {
        const int row0 = u.pm * BM + wr * 64 + fr, col0 = (u.pn & 3) * 256 + wc * 32 + 8 * fq;
#pragma unroll
        for (int ai = 0; ai < 2; ++ai)
#pragma unroll
            for (int m = 0; m < 4; ++m) { const int2 ri = rinfo[row0 + ai * HALF + m * 16];
                if (ri.x >= 0) { const float w = __int_as_float(ri.y);
#pragma unroll
                    for (int bj = 0; bj < 2; ++bj) { float x[8];
#pragma unroll
                        for (int n = 0; n < 2; ++n)
#pragma unroll
                            for (int i = 0; i < 4; ++i) x[4 * n + i] = w * acc[ai][bj][m][n][i];
                        st8(ys + (size_t)ri.x * D + col0 + bj * HALF, x); } } }
    }
};
struct ListOrder {
    static constexpr bool GATHER = false;
    const LAS int* tab; int n;
    __device__ __forceinline__ bool next(int i, Unit& u) const { if (i >= n) return false; const int v = tab[i]; u.pm = v >> 8; u.pn = v & 255; return true; }
    __device__ __forceinline__ void a_ready(const Unit&) const {}
    __device__ __forceinline__ void done(const Unit&) const {}
};

struct GatherOrder {
    static constexpr bool GATHER = true;
    const LAS int* tab; int n; const LAS unsigned* rows;
    __device__ __forceinline__ bool next(int i, Unit& u) const { if (i >= n) return false; const int v = tab[i]; u.pm = v >> 8; u.pn = v & 255; return true; }
    __device__ __forceinline__ void a_ready(const Unit&) const {}
    __device__ __forceinline__ void done(const Unit&) const {}
};

template <class Epi, class Sched, bool ALIGN_EPI = false, bool SP2 = false>
__device__ __forceinline__ void gemm_phase(PG8_LAS unsigned char* lds, const Gemm g, const Sched& S, const Epi& E) {
    int tid_ = threadIdx.x; asm volatile("" : "+v"(tid_));
    const int tid = tid_, wid = __builtin_amdgcn_readfirstlane(tid >> 6), lane = tid & 63, wr = wid >> 2, wc = wid & 3, fr = lane & 15, fq = lane >> 4;
    const int K = g.K, nt = K / BK;
    constexpr bool GA = Sched::GATHER; static_assert(!GA || SP2, "gathered A rows: SP2 loop only");
    unsigned voffA[2], voffB[2]; int gaR[2];
#pragma unroll
    for (int i = 0; i < 2; ++i) { int R, C; stage_rc(tid * 16 + i * 8192, R, C); const int Rb = Epi::PERM ? ((R & ~31) + perm32(R & 31)) : R;
        voffA[i] = GA ? (unsigned)C * 2u : (unsigned)(R * K + C) * 2u; voffB[i] = (unsigned)(Rb * K + C) * 2u; gaR[i] = R; }
    unsigned cv0[2], cv1[2], nv0[2], nv1[2];
#define PG8_GAV(d0, d1, u) do { if constexpr (GA) { _Pragma("unroll") for (int _i = 0; _i < 2; ++_i) { d0[_i] = S.rows[(u) * 256 + gaR[_i]] + voffA[_i]; d1[_i] = S.rows[(u) * 256 + 128 + gaR[_i]] + voffA[_i]; } } \
        else { _Pragma("unroll") for (int _i = 0; _i < 2; ++_i) { d0[_i] = voffA[_i]; d1[_i] = voffA[_i]; } } } while (0)
    const size_t kstep = (size_t)(BK * 2);
    const size_t hstep = (size_t)HALF * K * 2;
    const size_t hstA = GA ? (size_t)0 : hstep;
    const size_t tstep = 2 * hstep;
    const unsigned ldsw = (unsigned)wid * 1024u;
    const int aoff = lds_byte(wr * 64 + fr, fq * 8), boff = lds_byte(wc * 32 + fr, fq * 8);
#define PG8_SA(b, h) (((b) * 2 + (h)) * HTB)
#define PG8_SB(b, h) ((4 + (b) * 2 + (h)) * HTB)
#define PG8_STAGE(bufoff, gbase, voff) do { _Pragma("unroll") for (int _i = 0; _i < 2; ++_i) \
        __builtin_amdgcn_global_load_lds((const unsigned*)((const char*)(gbase) + (voff)[_i]), (PG8_LAS unsigned*)(lds + (bufoff) + ldsw + _i * 8192), 16, 0, 0); } while (0)
#define PG8_LDA(dst, b, h) do { _Pragma("unroll") for (int m = 0; m < 4; ++m) _Pragma("unroll") for (int k = 0; k < 2; ++k) dst[m][k] = *(const PG8_LAS bf16x8*)(lds + PG8_SA(b, h) + aoff + m * 2048 + k * 1024); } while (0)
#define PG8_LDB(dst, b, h) do { _Pragma("unroll") for (int n = 0; n < 2; ++n) _Pragma("unroll") for (int k = 0; k < 2; ++k) dst[n][k] = *(const PG8_LAS bf16x8*)(lds + PG8_SB(b, h) + boff + n * 2048 + k * 1024); } while (0)
#define PG8_MMA(ai, bj, At, Bt) do { __builtin_amdgcn_s_setprio(1); _Pragma("unroll") for (int m = 0; m < 4; ++m) _Pragma("unroll") for (int n = 0; n < 2; ++n) _Pragma("unroll") for (int k = 0; k < 2; ++k) \
        acc[ai][bj][m][n] = __builtin_amdgcn_mfma_f32_16x16x32_bf16(Bt[n][k], At[m][k], acc[ai][bj][m][n], 0, 0, 0); __builtin_amdgcn_s_setprio(0); } while (0)
#define PG8_WAIT_V(n) asm volatile("s_waitcnt vmcnt(" #n ")" ::: "memory")
#define PG8_WAIT_L(n) asm volatile("s_waitcnt lgkmcnt(" #n ")" ::: "memory")
#define PG8_BAR __builtin_amdgcn_s_barrier()
#define PG8_SCHED __builtin_amdgcn_sched_barrier(0)
    Unit cur, nxt; int ui = 0;
    if (!S.next(0, cur)) return;
    f32x4 acc[2][2][4][2];
#pragma unroll
    for (int a = 0; a < 2; ++a)
#pragma unroll
        for (int b = 0; b < 2; ++b)
#pragma unroll
            for (int m = 0; m < 4; ++m)
#pragma unroll
                for (int n = 0; n < 2; ++n) acc[a][b][m][n] = (f32x4){0.f, 0.f, 0.f, 0.f};
    bf16x8 At[4][2], B0[2][2], B1[2][2];
    const char* cA = (const char*)g.A + (GA ? (size_t)0 : (size_t)cur.pm * tstep); const char* cB = (const char*)g.Bt + (size_t)cur.pn * tstep;
    S.a_ready(cur);
    PG8_GAV(cv0, cv1, 0);
    if constexpr (SP2) {
        PG8_STAGE(PG8_SB(0, 0), cB, voffB); PG8_STAGE(PG8_SB(0, 1), cB + hstep, voffB); PG8_STAGE(PG8_SA(0, 0), cA, cv0); PG8_STAGE(PG8_SA(0, 1), cA + hstA, cv1);
        if (wr == 1) PG8_BAR;
        PG8_WAIT_V(2); PG8_BAR;
        PG8_STAGE(PG8_SB(1, 0), cB + kstep, voffB); PG8_STAGE(PG8_SA(1, 0), cA + kstep, cv0); PG8_STAGE(PG8_SB(1, 1), cB + hstep + kstep, voffB);
        PG8_WAIT_V(6); PG8_BAR;
    } else {
        PG8_STAGE(PG8_SB(0, 0), cB, voffB); PG8_STAGE(PG8_SA(0, 0), cA, voffA); PG8_STAGE(PG8_SB(0, 1), cB + hstep, voffB); PG8_STAGE(PG8_SA(0, 1), cA + hstep, voffA);
        if (wr == 1) PG8_BAR;
        PG8_WAIT_V(4); PG8_BAR;
        PG8_STAGE(PG8_SB(1, 0), cB + kstep, voffB); PG8_STAGE(PG8_SA(1, 0), cA + kstep, voffA); PG8_STAGE(PG8_SB(1, 1), cB + hstep + kstep, voffB);
        PG8_WAIT_V(6); PG8_BAR;
    }
    for (;;) {
        const bool has_next = S.next(ui + 1, nxt);
        const char* nA = (has_next && !GA) ? (const char*)g.A + (size_t)nxt.pm * tstep : cA; const char* nB = has_next ? (const char*)g.Bt + (size_t)nxt.pn * tstep : cB;
        if constexpr (GA) { if (has_next) PG8_GAV(nv0, nv1, ui + 1); else { nv0[0] = cv0[0]; nv0[1] = cv0[1]; nv1[0] = cv1[0]; nv1[1] = cv1[1]; } }
        for (int t = 0; t < nt; t += 2) {
            const bool last = (t == nt - 2);
            const char* a1 = cA + (size_t)(t + 1) * kstep;
            const char* a2 = last ? nA : cA + (size_t)(t + 2) * kstep; const char* b2 = last ? nB : cB + (size_t)(t + 2) * kstep;
            const char* a3 = a2 + kstep; const char* b3 = b2 + kstep;
            if (last && has_next) S.a_ready(nxt);
            if constexpr (SP2) {
            unsigned s0[2], s1[2];
            if constexpr (GA) { s0[0] = last ? nv0[0] : cv0[0]; s0[1] = last ? nv0[1] : cv0[1]; s1[0] = last ? nv1[0] : cv1[0]; s1[1] = last ? nv1[1] : cv1[1]; }
            else { s0[0] = voffA[0]; s0[1] = voffA[1]; s1[0] = voffA[0]; s1[1] = voffA[1]; }
            PG8_LDB(B0, 0, 0); PG8_LDB(B1, 0, 1); PG8_SCHED; PG8_LDA(At, 0, 0); PG8_STAGE(PG8_SA(1, 1), a1 + hstA, cv1);
            PG8_WAIT_V(8); PG8_WAIT_L(0); PG8_BAR; PG8_MMA(0, 0, At, B0); PG8_MMA(0, 1, At, B1); PG8_BAR; PG8_SCHED;
            PG8_LDA(At, 0, 1); PG8_STAGE(PG8_SB(0, 0), b2, voffB); PG8_STAGE(PG8_SB(0, 1), b2 + hstep, voffB); PG8_STAGE(PG8_SA(0, 0), a2, s0);
            PG8_WAIT_V(8); PG8_WAIT_L(0); PG8_BAR; PG8_MMA(1, 0, At, B0); PG8_MMA(1, 1, At, B1); PG8_BAR; PG8_SCHED;
            PG8_LDB(B0, 1, 0); PG8_LDB(B1, 1, 1); PG8_SCHED; PG8_LDA(At, 1, 0); PG8_STAGE(PG8_SA(0, 1), a2 + hstA, s1);
            PG8_WAIT_V(8); PG8_WAIT_L(0); PG8_BAR; PG8_MMA(0, 0, At, B0); PG8_MMA(0, 1, At, B1); PG8_BAR; PG8_SCHED;
            PG8_LDA(At, 1, 1); PG8_STAGE(PG8_SB(1, 0), b3, voffB); PG8_STAGE(PG8_SB(1, 1), b3 + hstep, voffB); PG8_STAGE(PG8_SA(1, 0), a3, s0);
            PG8_WAIT_V(8); PG8_WAIT_L(0); PG8_BAR; PG8_MMA(1, 0, At, B0); PG8_MMA(1, 1, At, B1); PG8_BAR; PG8_SCHED;
            } else {
            PG8_LDB(B0, 0, 0); PG8_SCHED; PG8_LDA(At, 0, 0); PG8_STAGE(PG8_SA(1, 1), a1 + hstep, voffA);
            PG8_WAIT_L(8); PG8_BAR; PG8_WAIT_L(0); PG8_MMA(0, 0, At, B0); PG8_BAR; PG8_SCHED;
            PG8_LDB(B1, 0, 1); PG8_STAGE(PG8_SB(0, 0), b2, voffB);
            PG8_BAR; PG8_WAIT_L(0); PG8_MMA(0, 1, At, B1); PG8_BAR;
            PG8_LDA(At, 0, 1); PG8_STAGE(PG8_SA(0, 0), a2, voffA);
            PG8_BAR; PG8_WAIT_L(0); PG8_MMA(1, 0, At, B0); PG8_BAR; PG8_SCHED;
            PG8_STAGE(PG8_SB(0, 1), b2 + hstep, voffB);
            PG8_WAIT_V(6); PG8_BAR; PG8_MMA(1, 1, At, B1); PG8_BAR;
            PG8_LDB(B0, 1, 0); PG8_SCHED; PG8_LDA(At, 1, 0); PG8_STAGE(PG8_SA(0, 1), a2 + hstep, voffA);
            PG8_WAIT_L(8); PG8_BAR; PG8_WAIT_L(0); PG8_MMA(0, 0, At, B0); PG8_BAR; PG8_SCHED;
            PG8_LDB(B1, 1, 1); PG8_STAGE(PG8_SB(1, 0), b3, voffB);
            PG8_BAR; PG8_WAIT_L(0); PG8_MMA(0, 1, At, B1); PG8_BAR;
            PG8_LDA(At, 1, 1); PG8_STAGE(PG8_SA(1, 0), a3, voffA);
            PG8_BAR; PG8_WAIT_L(0); PG8_MMA(1, 0, At, B0); PG8_BAR; PG8_SCHED;
            PG8_STAGE(PG8_SB(1, 1), b3 + hstep, voffB);
            PG8_WAIT_V(6); PG8_BAR; PG8_MMA(1, 1, At, B1); PG8_BAR;
            }
        }
        if constexpr (ALIGN_EPI) { if (wr == 0) PG8_BAR; }
        bool keep_acc = false;
        if constexpr (Epi::CHAIN) { keep_acc = E.chain(acc, cur, wr, wc, fr, fq); S.done(cur); }
        else if constexpr (!Epi::AFTER_DRAIN) { E(acc, cur, wr, wc, fr, fq); S.done(cur); }
        if (!has_next) break;
        if (!keep_acc) {
#pragma unroll
        for (int a = 0; a < 2; ++a)
#pragma unroll
            for (int b = 0; b < 2; ++b)
#pragma unroll
                for (int m = 0; m < 4; ++m)
#pragma unroll
                    for (int n = 0; n < 2; ++n) acc[a][b][m][n] = (f32x4){0.f, 0.f, 0.f, 0.f};
        }
        cur = nxt; cA = nA; cB = nB; ++ui;
        if constexpr (GA) { cv0[0] = nv0[0]; cv0[1] = nv0[1]; cv1[0] = nv1[0]; cv1[1] = nv1[1]; }
        if constexpr (ALIGN_EPI) { if (wr == 1) PG8_BAR; }
    }
    PG8_WAIT_V(0);
    if constexpr (!ALIGN_EPI) { if (wr == 0) PG8_BAR; }
    PG8_BAR;
    if constexpr (Epi::AFTER_DRAIN) { E.fused(acc, cur, wr, wc, fr, fq, lds, wid, lane); S.done(cur); }
#undef PG8_SA
#undef PG8_SB
#undef PG8_STAGE
#undef PG8_LDA
#undef PG8_LDB
#undef PG8_MMA
#undef PG8_WAIT_V
#undef PG8_WAIT_L
#undef PG8_BAR
#undef PG8_SCHED
#undef PG8_GAV
}
}

#define XB_TMO      128
#define XB_XCNT(j)  (256  + 64 * (j))
#define XB_XSUB(j)  (1280 + 64 * (j))
#define XB_XGEN(j)  (2304 + 64 * (j))
#define XB_TOP      3328
#define XB_TOPGEN   3392
#define XCD_BAR_WORDS 3456
#define XB_SPIN_CAP (1u << 18)

__device__ __forceinline__ unsigned xb_ld(unsigned* p)              { return __hip_atomic_load(p, __ATOMIC_RELAXED, __HIP_MEMORY_SCOPE_AGENT); }
__device__ __forceinline__ unsigned xb_add(unsigned* p, unsigned v) { return __hip_atomic_fetch_add(p, v, __ATOMIC_RELAXED, __HIP_MEMORY_SCOPE_AGENT); }
__device__ __forceinline__ unsigned xb_xcc_id() { return (unsigned)__builtin_amdgcn_s_getreg((3 << 11) | 20) & 0xFu; }
#define XB_SPIN(cond, bar) do { unsigned _sp = 0; while (cond) { __builtin_amdgcn_s_sleep(1); \
    if ((++_sp & 255u) == 0u) { if (xb_ld(&(bar)[XB_TMO])) break; if (_sp > XB_SPIN_CAP) { atomicAdd(&(bar)[XB_TMO], 1u); break; } } } } while (0)

struct XcdBarrier {
    unsigned* bar; unsigned x;
    volatile LAS unsigned* st;
};

__device__ __forceinline__ XcdBarrier xcd_barrier_post(unsigned* bar, volatile LAS unsigned* st) {
    XcdBarrier b; b.bar = bar; b.x = xb_xcc_id(); b.st = st;
    if (threadIdx.x == 0) (void)xb_add(&bar[XB_XCNT(b.x)], 1u);
    return b;
}
__device__ __forceinline__ void xcd_barrier_complete(unsigned* bar, unsigned x, unsigned& nloc, unsigned& nx) {
    const unsigned G = gridDim.x * gridDim.y * gridDim.z;
    unsigned sum, cnt, mine, sp = 0u;
    for (;;) {
        sum = 0u; cnt = 0u; mine = 0u;
#pragma unroll
        for (unsigned j = 0; j < 16; ++j) { const unsigned c = xb_ld(&bar[XB_XCNT(j)]); sum += c; cnt += (c > 0u) ? 1u : 0u; mine = (j == x) ? c : mine; }
        if (sum == G) break;
        __builtin_amdgcn_s_sleep(1);
        if ((++sp & 255u) == 0u) { if (xb_ld(&bar[XB_TMO])) break; if (sp > XB_SPIN_CAP) { atomicAdd(&bar[XB_TMO], 1u); break; } }
    }
    nloc = mine > 0u ? mine : 1u; nx = cnt > 0u ? cnt : 1u;
}

__device__ __forceinline__ void xcd_barrier(const XcdBarrier& b) {
    asm volatile("s_waitcnt vmcnt(0)" ::: "memory");
    __syncthreads();
    if (threadIdx.x == 0) {
        unsigned* bar = b.bar;
        __builtin_amdgcn_s_waitcnt(0);
        unsigned nloc = b.st[0], nx = b.st[1];
        if (nloc == 0u) { xcd_barrier_complete(bar, b.x, nloc, nx); b.st[0] = nloc; b.st[1] = nx; }
        const unsigned old = xb_add(&bar[XB_XSUB(b.x)], 1u);
        const unsigned gen = old / nloc;
        if (old + 1u == (gen + 1u) * nloc) {
            __builtin_amdgcn_fence(__ATOMIC_RELEASE, "agent");
            asm volatile("s_waitcnt vmcnt(0)" ::: "memory");
            const unsigned og = xb_add(&bar[XB_TOP], 1u);
            const unsigned tg = og / nx;
            if (og + 1u == (tg + 1u) * nx) xb_add(&bar[XB_TOPGEN], 1u);
            else XB_SPIN(xb_ld(&bar[XB_TOPGEN]) == tg, bar);
            __builtin_amdgcn_fence(__ATOMIC_ACQUIRE, "agent");
            xb_add(&bar[XB_XGEN(b.x)], 1u);
            asm volatile("s_waitcnt vmcnt(0)" ::: "memory");
        } else {
            XB_SPIN(xb_ld(&bar[XB_XGEN(b.x)]) == gen, bar);
            __builtin_amdgcn_fence(__ATOMIC_ACQUIRE, "agent");
            asm volatile("s_waitcnt vmcnt(0)" ::: "memory");
        }
    }
    __syncthreads();
}
__device__ __forceinline__ unsigned fkey(float f) { const unsigned u = __float_as_uint(f); return (u & 0x80000000u) ? ~u : (u | 0x80000000u); }
__device__ __forceinline__ void idx_item(Frame& F, int b, int rg, int flags = 0) {
    const bf16_t* IQ = (const bf16_t*)(F.ws + WS_P + P_IQ); const bf16_t* IK = (const bf16_t*)(F.ws + WS_P + P_IK); const float* IW = (const float*)(F.ws + WS_P + P_IW);
    u64* maskT = flags ? (u64*)(F.ws + WS_END) : (u64*)(F.ws + WS_MASK);
    LAS unsigned* cnt = (LAS unsigned*)F.lds;
    LAS unsigned* mgt = (LAS unsigned*)(F.lds + 1024);
    LAS unsigned* meq = (LAS unsigned*)(F.lds + 1024 + 8192);
    const int t0 = rg * 16, wid = F.wave, lane = F.lane, qj = lane & 15, g4 = lane >> 4;
    const int n64 = ((t0 >> 8) + 1) * 4;
    if (rg < 16) {
        for (int idx = F.tid; idx < 16 * n64; idx += NTHR) { const int row = idx & 15, j64 = idx >> 4, t = t0 + row; const int rel = t - 64 * j64;
            const u64 mk = rel >= 63 ? ~0ull : (rel < 0 ? 0ull : ((1ull << (rel + 1)) - 1ull));
            maskT[((size_t)b * 64 + j64) * SEQ + t] = mk; }
        return;
    }
    for (int i = F.tid; i < 4096; i += NTHR) mgt[i] = 0u;
    LAS unsigned* cstep = (LAS unsigned*)(F.lds + 17408);
    cstep[F.tid] = 0u;
    __syncthreads();
    const size_t qrow = (size_t)b * SEQ + t0 + qj;
    float wq[8];
    { const f32x4 w0 = *(const f32x4*)(IW + qrow * 8), w1 = *(const f32x4*)(IW + qrow * 8 + 4); const float sc = 0.04419417382415922f;
      wq[0] = w0[0] * sc; wq[1] = w0[1] * sc; wq[2] = w0[2] * sc; wq[3] = w0[3] * sc; wq[4] = w1[0] * sc; wq[5] = w1[1] * sc; wq[6] = w1[2] * sc; wq[7] = w1[3] * sc; }
    const int ntile = rg + 1, nkeys = ntile * 16, nch = (ntile + 15) >> 4;
    LAS unsigned char* kst = F.lds + 20480 + wid * (3 * 4096);
    const char* kg = (const char*)IK + ((size_t)b * SEQ + wid * 16) * 128;
    const unsigned aofs = (unsigned)(qj * 128 + ((g4 ^ ((qj >> 1) & 7)) << 4));
#define KDMA(c, bufsel) do { int ln_ = lane; asm volatile("" : "+v"(ln_)); const unsigned o0_ = (unsigned)(((ln_ >> 3) << 7) + (((ln_ & 7) ^ (ln_ >> 4)) << 4)), o1_ = (o0_ ^ 64u) + 1024u; \
        _Pragma("unroll") for (int q_ = 0; q_ < 2; ++q_) { \
            __builtin_amdgcn_global_load_lds((const unsigned*)(kg + (size_t)(2 * (c) + q_) * 16384 + o0_), (LAS unsigned*)(kst + (bufsel) * 4096 + q_ * 2048), 16, 0, 0); \
            __builtin_amdgcn_global_load_lds((const unsigned*)(kg + (size_t)(2 * (c) + q_) * 16384 + o1_), (LAS unsigned*)(kst + (bufsel) * 4096 + q_ * 2048 + 1024), 16, 0, 0); } } while (0)
    unsigned sc[32][4];
#pragma unroll
    for (int j = 0; j < 32; ++j) { sc[j][0] = 0xff800000u; sc[j][1] = 0xff800000u; sc[j][2] = 0xff800000u; sc[j][3] = 0xff800000u; }
    if (!(flags & 1))
#pragma unroll
    for (int hp = 0; hp < 2; ++hp) {
        bf16x8 Bq[4][2];
#pragma unroll
        for (int h = 0; h < 4; ++h)
#pragma unroll
            for (int ks = 0; ks < 2; ++ks) Bq[h][ks] = *(const bf16x8*)(IQ + qrow * 512 + (4 * hp + h) * 64 + ks * 32 + g4 * 8);
        KDMA(0, 0); if (nch > 1) KDMA(1, 1);
#pragma unroll
        for (int c = 0; c < 16; ++c) {
            int nt_ = __builtin_amdgcn_readfirstlane(ntile), nch_ = __builtin_amdgcn_readfirstlane(nch); asm volatile("" : "+s"(nt_), "+s"(nch_));
            if (c < nch_) {
                if (c + 1 < nch_) asm volatile("s_waitcnt vmcnt(4) lgkmcnt(0)" ::: "memory"); else asm volatile("s_waitcnt vmcnt(0) lgkmcnt(0)" ::: "memory");
                if (c + 2 < nch_) KDMA(c + 2, (c + 2) % 3);
#pragma unroll
                for (int q = 0; q < 2; ++q) { const int j = 2 * c + q, tile = wid + 8 * j;
                    if (tile < nt_) {
                        const LAS unsigned char* ap = kst + (c % 3) * 4096 + q * 2048;
                        const bf16x8 A0 = *(const LAS bf16x8*)(ap + aofs), A1 = *(const LAS bf16x8*)(ap + (aofs ^ 64u));
                        f32x4 s = {0.f, 0.f, 0.f, 0.f};
                        if (hp) {
#pragma unroll
                            for (int i = 0; i < 4; ++i) s[i] = __uint_as_float(sc[j][i]); }
#pragma unroll
                        for (int h = 0; h < 4; ++h) { f32x4 a = __builtin_amdgcn_mfma_f32_16x16x32_bf16(A0, Bq[h][0], (f32x4){0.f, 0.f, 0.f, 0.f}, 0, 0, 0);
                            a = __builtin_amdgcn_mfma_f32_16x16x32_bf16(A1, Bq[h][1], a, 0, 0, 0);
#pragma unroll
                            for (int i = 0; i < 4; ++i) s[i] += wq[4 * hp + h] * __int_as_float(max(__float_as_int(a[i]), 0));   }
                        if (hp == 1) {
                            if (tile == nt_ - 1) {
#pragma unroll
                                for (int i = 0; i < 4; ++i) if (4 * g4 + i > qj) s[i] = -__builtin_inff(); }
#pragma unroll
                            for (int i = 0; i < 4; ++i) sc[j][i] = __float_as_uint(s[i]);
                        } else {
#pragma unroll
                            for (int i = 0; i < 4; ++i) sc[j][i] = __float_as_uint(s[i]);
                        }
                    } else {
#pragma unroll
                        for (int i = 0; i < 4; ++i) sc[j][i] = 0xff800000u;
                    } }
            } else {
#pragma unroll
                for (int q = 0; q < 2; ++q)
#pragma unroll
                    for (int i = 0; i < 4; ++i) sc[2 * c + q][i] = 0xff800000u;
            }
        }
    }
#undef KDMA
    const int nj = (ntile - wid + 7) >> 3;
    unsigned prefix = 0u; bool done = false;
    #define IDX_INVKEY(k) __uint_as_float(((k) & 0x80000000u) ? ((k) ^ 0x80000000u) : ~(k))
    if (!(flags & 2))
    for (int bit = 31; bit >= 0; --bit) {
        const unsigned cand = prefix | (1u << bit);
        const float cf = IDX_INVKEY(cand - 1u), ncb = -cf * 1.8446744e19f;
        const f32x2 big2 = {1.8446744e19f, 1.8446744e19f}, ncb2 = {ncb, ncb}; f32x2 acc2 = {0.f, 0.f};
        int nj_ = __builtin_amdgcn_readfirstlane(nj); asm volatile("" : "+s"(nj_));
#pragma unroll
        for (int jj = 0; jj < 8; ++jj) if (4 * jj < nj_) {
#pragma unroll
            for (int j = 4 * jj; j < 4 * jj + 4; ++j)
#pragma unroll
                for (int i = 0; i < 4; i += 2) { const f32x2 sv = {__uint_as_float(sc[j][i]), __uint_as_float(sc[j][i + 1])}; f32x2 d;
                    asm volatile("v_pk_fma_f32 %0, %1, %2, %3 clamp" : "=v"(d) : "v"(sv), "v"(big2), "v"(ncb2));
                    acc2 += d; } }
        unsigned c = (unsigned)(acc2[0] + acc2[1]);
        { auto r16 = __builtin_amdgcn_permlane16_swap(c, c, false, false); c = r16[0] + r16[1]; auto r32 = __builtin_amdgcn_permlane32_swap(c, c, false, false); c = r32[0] + r32[1]; }
        if (lane < 16) __hip_atomic_fetch_add(cstep + bit * 16 + lane, c, __ATOMIC_RELAXED, __HIP_MEMORY_SCOPE_WORKGROUP);
        __syncthreads();
        const unsigned tot = cstep[bit * 16 + qj];
        if (!done) { if (tot >= (unsigned)TOPK) prefix = cand; if (tot == (unsigned)TOPK) done = true; }
        if (__all(done)) break;
    }
    const float Tf = IDX_INVKEY(prefix);
    const float Tm = IDX_INVKEY(prefix - 1u);
    const bool alld = __all(done);
    LAS unsigned* mbase = mgt + qj * 128 + (wid >> 1); const int sh0 = (wid & 1) * 16 + 4 * g4;
    if (alld) {
#pragma unroll
        for (int j = 0; j < 32; ++j) {
            const int tile = wid + 8 * j;
            if (tile < ntile) {
                unsigned g = 0u;
#pragma unroll
                for (int i = 0; i < 4; ++i) g |= (__uint_as_float(sc[j][i]) > Tm ? 1u : 0u) << i;
                if (g) __hip_atomic_fetch_or(mbase + 4 * j, g << sh0, __ATOMIC_RELAXED, __HIP_MEMORY_SCOPE_WORKGROUP);
            }
        }
    } else {
        unsigned cg = 0u;
#pragma unroll
        for (int jj = 0; jj < 8; ++jj) if (4 * jj < nj) {
#pragma unroll
            for (int j = 4 * jj; j < 4 * jj + 4; ++j)
#pragma unroll
                for (int i = 0; i < 4; ++i) cg += (__uint_as_float(sc[j][i]) > Tf) ? 1u : 0u; }
        cg += __shfl_xor(cg, 16); cg += __shfl_xor(cg, 32);
        __syncthreads();
        if (lane < 16) cnt[wid * 16 + lane] = cg;
#pragma unroll
        for (int j = 0; j < 32; ++j) {
            const int tile = wid + 8 * j;
            if (tile < ntile) {
                unsigned g = 0u, e = 0u;
#pragma unroll
                for (int i = 0; i < 4; ++i) { const float sv = __uint_as_float(sc[j][i]); g |= (sv > Tf ? 1u : 0u) << i; e |= ((sv > Tm && !(sv > Tf)) ? 1u : 0u) << i; }
                if (g) __hip_atomic_fetch_or(mbase + 4 * j, g << sh0, __ATOMIC_RELAXED, __HIP_MEMORY_SCOPE_WORKGROUP);
                if (e) __hip_atomic_fetch_or(mbase + 2048 + 4 * j, e << sh0, __ATOMIC_RELAXED, __HIP_MEMORY_SCOPE_WORKGROUP);
            }
        }
    }
    __syncthreads();
    if (!alld && wid == 0 && lane < 16) {
        unsigned gt = 0u;
#pragma unroll
        for (int w = 0; w < 8; ++w) gt += cnt[w * 16 + lane];
        int need = TOPK - (int)gt, taken = 0; const int nw = (t0 + 16 + 31) >> 5;
        for (int wd = 0; wd < nw; ++wd) { unsigned e = meq[lane * 128 + wd]; if (!e) continue; int c = __popc(e);
            if (taken + c > need) { unsigned keep = 0u; int rem = need - taken; while (rem > 0) { const unsigned low = e & (0u - e); keep |= low; e ^= low; --rem; } e = keep; c = __popc(keep); }
            taken += c; mgt[lane * 128 + wd] |= e; }
    }
    __syncthreads();
    for (int idx = F.tid; idx < 16 * n64; idx += NTHR) { const int row = idx & 15, j64 = idx >> 4;
        const u64 mk = (u64)mgt[row * 128 + 2 * j64] | ((u64)mgt[row * 128 + 2 * j64 + 1] << 32);
        maskT[((size_t)b * 64 + j64) * SEQ + t0 + row] = mk; }
    __syncthreads();
}
__device__ __forceinline__ void ph_idx(Frame& F, int flags = 0) {
    for (int c = F.bid; c < 256; c += F.G) { const int b = c & 3, base = c >> 2;
        idx_item(F, b, 255 - base, flags); idx_item(F, b, 128 + base, flags); idx_item(F, b, 127 - base, flags); idx_item(F, b, base, flags); }
}
namespace att {
constexpr int HD = 128, RS = 1024;
constexpr float SCALE = 0.08838834764831845f, THR = 8.f;
constexpr int NW = 8, QBLK = 32, KVBLK = 64, QB = NW * QBLK;
constexpr int SHM_V = KVBLK * HD * 2, SHM_K = KVBLK * HD * 2;
constexpr int LDS_ATT = 2 * SHM_V + 2 * SHM_K + NW * 64 * 4;
constexpr int LDS_TB = LDS_ATT;
typedef float f32x16 __attribute__((ext_vector_type(16)));
#define KSWZ(row, colB) ((row) * 256 + ((colB) ^ (((row) & 7) << 4)))
#define SBAR() __builtin_amdgcn_sched_barrier(0)
__device__ __forceinline__ int v_st(int k, int c) { const int kk = (k & ~0xC) | ((k & 4) << 1) | ((k & 8) >> 1); return ((kk >> 3) * 4 + (c >> 5)) * 512 + ((kk & 7) * 32 + (c & 31)) * 2; }
__device__ __forceinline__ int v_rd_base(int lane) { return ((lane & 3) << 3) | (((lane >> 2) & 3) << 6) | (((lane >> 4) & 1) << 5) | (((lane >> 5) & 1) << 8); }
constexpr int v_rd_off(int d0, int ks, int half) { return d0 * 512 + ks * 4096 + half * 2048; }
__device__ __forceinline__ int crow(int r, int hi) { return (r & 3) + 8 * (r >> 2) + 4 * hi; }
__device__ __forceinline__ bf16x8 load8(const bf16_t* p) { return *reinterpret_cast<const bf16x8*>(p); }
__device__ __forceinline__ void mask_bits(f32x16& p0, f32x16& p1, u64 mk, int hi) {
    const unsigned lo = (unsigned)mk >> (4 * hi), hh = (unsigned)(mk >> 32) >> (4 * hi);
#pragma unroll
    for (int r = 0; r < 16; ++r) { const int c = (r & 3) + 8 * (r >> 2);
        const unsigned m0 = (unsigned)((int)(lo << (31 - c)) >> 31), m1 = (unsigned)((int)(hh << (31 - c)) >> 31);
        p0[r] = __uint_as_float((__float_as_uint(p0[r]) & m0) | (0xff800000u & ~m0));
        p1[r] = __uint_as_float((__float_as_uint(p1[r]) & m1) | (0xff800000u & ~m1)); }
}
__device__ __forceinline__ void add_bias(f32x16& p0, f32x16& p1, const LAS float* tbq) {
#pragma unroll
    for (int r = 0; r < 16; ++r) { const int c = (r & 3) + 8 * (r >> 2); p0[r] += tbq[-c]; p1[r] += tbq[-c - 32]; }
}
__device__ __forceinline__ void partialSM(f32x16& p0, f32x16& p1, float& m_reg, float& mn, float& alpha) {
    float pmax = p0[0]; for (int r = 1; r < 16; ++r) pmax = fmaxf(pmax, p0[r]); for (int r = 0; r < 16; ++r) pmax = fmaxf(pmax, p1[r]);
    { auto rr = __builtin_amdgcn_permlane32_swap(__float_as_uint(pmax), __float_as_uint(pmax), false, false);
      pmax = fmaxf(__uint_as_float(rr[0]), __uint_as_float(rr[1])); }
    constexpr float C2 = 1.4426950408889634f * SCALE;
    if (__builtin_expect(__all((pmax - m_reg) * SCALE <= THR), 1)) { mn = m_reg; alpha = 1.f; }
    else { mn = fmaxf(m_reg, pmax); alpha = __builtin_amdgcn_exp2f((m_reg - mn) * C2); m_reg = mn; }
    const float mnL = -mn * C2;
    for (int r = 0; r < 16; ++r) p0[r] = fmaf(p0[r], C2, mnL); for (int r = 0; r < 16; ++r) p1[r] = fmaf(p1[r], C2, mnL);
    for (int r = 0; r < 16; ++r) p0[r] = __builtin_amdgcn_exp2f(p0[r]);
}
__device__ __forceinline__ void finishSM(f32x16& p0, f32x16& p1, float alpha, float& l_reg, bf16x8& pa0, bf16x8& pa1, bf16x8& pa2, bf16x8& pa3) {
    for (int r = 0; r < 16; ++r) p1[r] = __builtin_amdgcn_exp2f(p1[r]);
    float ps = 0; for (int r = 0; r < 16; ++r) ps += p0[r]; for (int r = 0; r < 16; ++r) ps += p1[r];
    { auto rr = __builtin_amdgcn_permlane32_swap(__float_as_uint(ps), __float_as_uint(ps), false, false);
      ps = __uint_as_float(rr[0]) + __uint_as_float(rr[1]); }
    l_reg = l_reg * alpha + ps;
#define PK4(P, B_, OUT) do { unsigned a0 = cvt_pk_bf16(P[B_+0], P[B_+1]), a1 = cvt_pk_bf16(P[B_+2], P[B_+3]);                          \
        unsigned b0 = cvt_pk_bf16(P[B_+4], P[B_+5]), b1 = cvt_pk_bf16(P[B_+6], P[B_+7]);                                             \
        auto r0 = __builtin_amdgcn_permlane32_swap(a0, b0, false, false); auto r1 = __builtin_amdgcn_permlane32_swap(a1, b1, false, false); \
        u32x4 w = {r0[0], r1[0], r0[1], r1[1]}; OUT = *reinterpret_cast<bf16x8*>(&w); } while (0)
    PK4(p0, 0, pa0); PK4(p0, 8, pa1); PK4(p1, 0, pa2); PK4(p1, 8, pa3);
#undef PK4
}
template <int KB>
__device__ __forceinline__ void qkt(f32x16& p0, f32x16& p1, const char* K_lds, int r32, int hi, const bf16x8* qr) {
    p0 = f32x16{}; p1 = f32x16{};
    const char* kb[4];
#pragma unroll
    for (int dd = 0; dd < 4; ++dd) kb[dd] = K_lds + KB * SHM_K + KSWZ(r32, (dd * 16 + hi * 8) * 2);
#pragma unroll
    for (int d0 = 0; d0 < 8; ++d0) { const char* a = kb[d0 & 3] + (d0 >> 2) * 128;
        bf16x8 b0 = *reinterpret_cast<const bf16x8*>(a);
        bf16x8 b1 = *reinterpret_cast<const bf16x8*>(a + 32 * 256);
        p0 = __builtin_amdgcn_mfma_f32_32x32x16_bf16(b0, qr[d0], p0, 0, 0, 0);
        p1 = __builtin_amdgcn_mfma_f32_32x32x16_bf16(b1, qr[d0], p1, 0, 0, 0); }
}
template <int VB>
__device__ __forceinline__ void pv_tile(f32x16* o, int vb0, bf16x8 pa0, bf16x8 pa1, bf16x8 pa2, bf16x8 pa3) {
#define TRRD(dst, off) asm volatile("ds_read_b64_tr_b16 %0, %1 offset:%2" : "=&v"(dst) : "v"(vb0), "i"(off) : "memory")
#define PV_D0(d0) do { s16x4 l0, l1, h0, h1; constexpr int b_ = VB * SHM_V + v_rd_off(d0, 0, 0); \
        TRRD(l0, b_); TRRD(h0, b_ + 2048); TRRD(l1, b_ + 4096); TRRD(h1, b_ + 6144); \
        asm volatile("s_waitcnt lgkmcnt(0)" ::: "memory"); SBAR();   \
        o[d0] = __builtin_amdgcn_mfma_f32_32x32x16_bf16(pa0, (bf16x8){l0[0], l0[1], l0[2], l0[3], h0[0], h0[1], h0[2], h0[3]}, o[d0], 0, 0, 0);   \
        o[d0] = __builtin_amdgcn_mfma_f32_32x32x16_bf16(pa1, (bf16x8){l1[0], l1[1], l1[2], l1[3], h1[0], h1[1], h1[2], h1[3]}, o[d0], 0, 0, 0);   \
        SBAR(); TRRD(l0, b_ + 8192); TRRD(h0, b_ + 10240); TRRD(l1, b_ + 12288); TRRD(h1, b_ + 14336); \
        asm volatile("s_waitcnt lgkmcnt(0)" ::: "memory"); SBAR();   \
        o[d0] = __builtin_amdgcn_mfma_f32_32x32x16_bf16(pa2, (bf16x8){l0[0], l0[1], l0[2], l0[3], h0[0], h0[1], h0[2], h0[3]}, o[d0], 0, 0, 0);   \
        o[d0] = __builtin_amdgcn_mfma_f32_32x32x16_bf16(pa3, (bf16x8){l1[0], l1[1], l1[2], l1[3], h1[0], h1[1], h1[2], h1[3]}, o[d0], 0, 0, 0); } while (0)
    PV_D0(0); PV_D0(1); PV_D0(2); PV_D0(3);
#undef PV_D0
#undef TRRD
}
struct BlockRef { const bf16_t* Q; const bf16_t* K; const bf16_t* V; bf16_t* O; const u64* MK; int P0; int h; };
struct Seam { bf16x8 qr[8]; bf16x8 st_v0, st_v1, st_k0, st_k1; };
#define LD16U(base, off) (*(const bf16x8*)((const char*)(base) + (off)))
#define VMW() asm volatile("s_waitcnt vmcnt(0)" ::: "memory")
#define TIDL() ({ int t__ = threadIdx.x; asm volatile("" : "+v"(t__)); t__; })
#define SLOAD_H(Kp, Vp, k0) do { const int t_ = TIDL(); const unsigned klo_ = (unsigned)((t_ >> 4) * RS + (t_ & 15) * 8) * 2u;   \
        const char* kb_ = (const char*)(Kp) + (size_t)(k0) * (RS * 2); const char* vb_ = (const char*)(Vp) + (size_t)(k0) * (RS * 2);   \
        S.st_v0 = LD16U(vb_, klo_); S.st_v1 = LD16U(vb_ + 32 * RS * 2, klo_); S.st_k0 = LD16U(kb_, klo_); S.st_k1 = LD16U(kb_ + 32 * RS * 2, klo_); } while (0)
#define SWRITE_HK(bf) do { const int t_ = TIDL(); const int kws_ = KSWZ(t_ >> 4, (t_ & 15) * 16); *(bf16x8*)(K_lds + (bf) * SHM_K + kws_) = S.st_k0; *(bf16x8*)(K_lds + (bf) * SHM_K + kws_ + 32 * 256) = S.st_k1; } while (0)
#define SWRITE_HV(bf) do { const int t_ = TIDL(); const int sr_ = t_ >> 4, sc_ = (t_ & 15) * 8; *(bf16x8*)(V_lds + (bf) * SHM_V + v_st(sr_, sc_)) = S.st_v0; *(bf16x8*)(V_lds + (bf) * SHM_V + v_st(32 + sr_, sc_)) = S.st_v1; } while (0)
#define SWRITE_H(bf) do { SWRITE_HV(bf); SWRITE_HK(bf); } while (0)
#define QLOAD(Qp) do { const int t_ = TIDL(); const unsigned qlo_ = (unsigned)((t_ & 31) * RS + ((t_ >> 5) & 1) * 8) * 2u; const char* qb_ = (const char*)(Qp) + (size_t)(wid * QBLK) * (RS * 2); \
        _Pragma("unroll") for (int d0 = 0; d0 < 8; ++d0) S.qr[d0] = LD16U(qb_ + d0 * 32, qlo_); } while (0)
__device__ __forceinline__ void att_prime(const BlockRef& cur, char* lds, Seam& S) {
    const int tid = threadIdx.x, wid = __builtin_amdgcn_readfirstlane(tid >> 6); char* K_lds = lds + 2 * SHM_V;
    QLOAD(cur.Q);
    SLOAD_H(cur.K, cur.V, 0); VMW(); SWRITE_HK(0);
    __syncthreads();
}
__device__ __forceinline__ void att_block(const BlockRef& cur, const BlockRef& nxt, char* lds, const LAS float* tbl, Seam& S) {
    const int tid = TIDL(),
              wid = __builtin_amdgcn_readfirstlane(tid >> 6), lane = tid & 63, r32 = lane & 31, hi = lane >> 5;
    const int NT = cur.P0 / KVBLK + 4;
    const int qlo = cur.P0 + wid * QBLK;
    char* V_lds = lds; char* K_lds = lds + 2 * SHM_V;
    float* ws = (float*)(lds + 2 * SHM_V + 2 * SHM_K) + wid * 64; float* li_l = ws, * al_l = ws + 32;
    float m_reg = -1e30f, l_reg = 0; f32x16 o[4] = {};
    const int vb0 = (int)(uintptr_t)V_lds + v_rd_base(lane);
    const bf16_t* Kh = cur.K; const bf16_t* Vh = cur.V;
    const char* mkb = (const char*)(cur.MK + qlo);
#define LDMK(j) (*(const u64*)(mkb + (size_t)(j) * (SEQ * 8) + (unsigned)(TIDL() & 31) * 8u))
#define RESC(a) do { if (__any((a) < 1.f)) { if (hi == 0) al_l[r32] = (a); asm volatile("s_waitcnt lgkmcnt(0)" ::: "memory");              \
                     for (int d_ = 0; d_ < 4; ++d_) for (int r = 0; r < 16; ++r) o[d_][r] *= al_l[crow(r, hi)]; } } while (0)
#define KBASE(t) ((t) * KVBLK)
#define MASKT(P0_, P1_, t, MK_) do { const int kb_ = KBASE(t); if (kb_ + 176 > qlo) { const int t_ = TIDL(); add_bias(P0_, P1_, tbl + cur.h * 512 + 256 + (qlo + (t_ & 31) - 4 * ((t_ >> 5) & 1) - kb_)); } mask_bits(P0_, P1_, MK_, hi); } while (0)
#define VMWN8() asm volatile("s_waitcnt vmcnt(8)" ::: "memory")
#define SEAM_K0() do { VMWN8(); SWRITE_HK(0); SBAR(); } while (0)
    f32x16 pA0, pA1, pB0, pB1; float mnA, mnB, alA, alB; bf16x8 pa0, pa1, pa2, pa3;
    u64 mk_ = LDMK(0);
    SWRITE_HV(0); SBAR();
    SLOAD_H(Kh, Vh, KBASE(1));
    SBAR(); qkt<0>(pA0, pA1, K_lds, r32, hi, S.qr);
    MASKT(pA0, pA1, 0, mk_); partialSM(pA0, pA1, m_reg, mnA, alA);
    VMW(); SWRITE_H(1);
    __syncthreads();
#define HALF_STEP(PX0, PX1, mnX, alX, PY0, PY1, alY, t, KB, VB, SB) do {                                                      \
        mk_ = LDMK(t); SBAR(); qkt<KB>(PX0, PX1, K_lds, r32, hi, S.qr);                                                                      \
        finishSM(PY0, PY1, alY, l_reg, pa0, pa1, pa2, pa3); SBAR();                                                           \
        if ((t) + 1 < NT) { SLOAD_H(Kh, Vh, KBASE((t) + 1)); SBAR(); }                                                        \
        pv_tile<VB>(o, vb0, pa0, pa1, pa2, pa3); MASKT(PX0, PX1, (t), mk_);                                                   \
        partialSM(PX0, PX1, m_reg, mnX, alX);                                                                                 \
        __syncthreads();                                                                                                      \
        if ((t) + 1 < NT) { VMW(); SWRITE_H(SB); }                                                                            \
        RESC(alX); __syncthreads(); } while (0)
    for (int t = 1; t + 1 < NT; t += 2) {
        HALF_STEP(pB0, pB1, mnB, alB, pA0, pA1, alA, t, 1, 0, 0);
        HALF_STEP(pA0, pA1, mnA, alA, pB0, pB1, alB, t + 1, 0, 1, 1);
    }
    mk_ = LDMK(NT - 1); SBAR(); qkt<1>(pB0, pB1, K_lds, r32, hi, S.qr); SBAR();
    SLOAD_H(nxt.K, nxt.V, 0); SBAR();
    QLOAD(nxt.Q);
    SBAR();
    finishSM(pA0, pA1, alA, l_reg, pa0, pa1, pa2, pa3); SBAR();
    pv_tile<0>(o, vb0, pa0, pa1, pa2, pa3);
    MASKT(pB0, pB1, NT - 1, mk_); partialSM(pB0, pB1, m_reg, mnB, alB); __syncthreads(); RESC(alB);
    finishSM(pB0, pB1, alB, l_reg, pa0, pa1, pa2, pa3); SBAR(); pv_tile<1>(o, vb0, pa0, pa1, pa2, pa3);
    SBAR(); SEAM_K0();
    if (hi == 0) li_l[r32] = l_reg; asm volatile("s_waitcnt lgkmcnt(0)" ::: "memory");
    float rli[16];
#pragma unroll
    for (int r = 0; r < 16; ++r) rli[r] = __builtin_amdgcn_rcpf(li_l[crow(r, hi)]);
    char* Ow = (char*)cur.O + (size_t)(wid * QBLK) * (RS * 2); const unsigned olo = (unsigned)(4 * ((TIDL() >> 5) & 1) * RS + (TIDL() & 31)) * 2u;
#pragma unroll
    for (int r = 0; r < 16; ++r) { const int orow0 = (r & 3) + 8 * (r >> 2);
#pragma unroll
        for (int d0 = 0; d0 < 4; ++d0) { const float v = o[d0][r] * rli[r]; const float vn = __shfl_xor(v, 1);
            if ((r32 & 1) == 0) *(unsigned*)(Ow + (size_t)orow0 * (RS * 2) + d0 * 64 + olo) = cvt_pk_bf16(v, vn); } }
    __syncthreads();
#undef LDMK
#undef RESC
#undef KBASE
#undef MASKT
#undef VMWN8
#undef SEAM_K0
#undef HALF_STEP
}
#undef LD16U
#undef VMW
#undef SLOAD_H
#undef SWRITE_HK
#undef SWRITE_HV
#undef SWRITE_H
#undef QLOAD
#undef TIDL
}
__device__ __forceinline__ void ph_att(Frame& F, char* lds) {
    const bf16_t* QA = (const bf16_t*)(F.ws + WS_P + P_QA); const bf16_t* KA = (const bf16_t*)(F.ws + WS_P + P_KA); const bf16_t* VA = (const bf16_t*)(F.ws + WS_P + P_VA);
    bf16_t* OA = (bf16_t*)(F.ws + WS_OA); const u64* maskT = (const u64*)(F.ws + WS_MASK); const float* tbg = (const float*)(F.ws + WS_TB);
    LAS float* tbl = (LAS float*)(F.lds + att::LDS_TB);
    for (int i = F.tid; i < 8 * 512; i += NTHR) { const int rel = (i & 511) - 256; tbl[i] = (rel >= 0 && rel < 128) ? tbg[(i >> 9) * 128 + rel] : 0.f; }
    __syncthreads();
    for (int c = F.bid; c < 256; c += F.G) {
        const int r = c >> 3; int bhl, li;
        if (r < 16) { bhl = r >> 2; li = r & 3; } else if (r < 24) { bhl = (r - 16) >> 1; li = 4 + ((r - 16) & 1); } else { bhl = (r - 24) >> 1; li = 6 + ((r - 24) & 1); }
        const int bh = 4 * (c & 7) + bhl, b = bh >> 3, h = bh & 7;
        const unsigned code = li == 0 ? 0xF29u : li == 1 ? 0xF38u : li == 2 ? 0xF47u : li == 3 ? 0xF56u : li == 4 ? 0xF0Du : li == 5 ? 0xF1Cu : li == 6 ? 0xFAFu : 0xFBEu;
        const int x0 = code & 15, x1 = (code >> 4) & 15, x2 = (code >> 8) & 15, n = x1 == 15 ? 1 : (x2 == 15 ? 2 : 3);
        att::BlockRef r0, r1;
        { const size_t ro = ((size_t)b * SEQ + 256 * x0) * 1024 + h * 128;
          r0.Q = QA + ro; r0.O = OA + ro; r0.K = KA + (size_t)b * SEQ * 1024 + h * 128; r0.V = VA + (size_t)b * SEQ * 1024 + h * 128; r0.MK = maskT + (size_t)b * 64 * SEQ; r0.P0 = 256 * x0; r0.h = h; }
        att::Seam S;
        att::att_prime(r0, lds, S);
        for (int k = 0; k < n; ++k) {
            const int xn = (k + 1 < n) ? (k == 0 ? x1 : x2) : (r0.P0 >> 8);
            const size_t ro = ((size_t)b * SEQ + 256 * xn) * 1024 + h * 128;
            r1 = r0; r1.Q = QA + ro; r1.O = OA + ro; r1.P0 = 256 * xn;
            att::att_block(r0, r1, lds, tbl, S); r0 = r1; }
    }
}
__device__ __forceinline__ f32x4 mfma16(bf16x8 a, bf16x8 b, f32x4 c) { return __builtin_amdgcn_mfma_f32_16x16x32_bf16(a, b, c, 0, 0, 0); }
__device__ __forceinline__ void ph_hprep(Frame& F, unsigned char* dry) {
    bf16_t* BQ = (bf16_t*)(F.ws + WS_P + P_BQ); bf16_t* BG = (bf16_t*)(F.ws + WS_P + P_BG);
    bf16_t* BQo = dry ? (bf16_t*)dry : BQ; bf16_t* BGo = dry ? (bf16_t*)(dry + 32 * MiB) : BG;
    bf16_t* HA = dry ? (bf16_t*)(dry + 64 * MiB) : (bf16_t*)(F.ws + WS_HA); float* HDEC = dry ? (float*)(dry + 80 * MiB) : (float*)(F.ws + WS_HDEC);
    LAS float* wsum = (LAS float*)F.lds;
    LAS unsigned char* qt = F.lds + 4096;
    LAS unsigned char* kt = F.lds + 4096 + 64 * 272;
    const int w = F.wave, lane = F.lane, cp = lane;
    unsigned ngw[8], nqw[8];
#define HP_BASE(it_) ((((size_t)((it_) >> 9) * SEQ + ((it_) & 63) * 64 + 8 * w) * 1024) + (((it_) >> 6) & 7) * 128 + 2 * cp)
    if (F.bid < 2048) { const size_t nb = HP_BASE(F.bid);
#pragma unroll
        for (int r = 0; r < 8; ++r) { ngw[r] = *(const unsigned*)(BG + nb + (size_t)r * 1024); nqw[r] = *(const unsigned*)(BQ + nb + (size_t)r * 1024); } }
    for (int it = F.bid; it < 2048; it += F.G) {
        const int bh = it >> 6, ch = it & 63, b = bh >> 3, h = bh & 7;
        const size_t base = ((size_t)b * SEQ + ch * 64 + 8 * w) * 1024 + h * 128 + 2 * cp;
        float g0[8], g1[8], q0[8], q1[8];
#pragma unroll
        for (int r = 0; r < 8; ++r) { const unsigned gw = ngw[r], qw = nqw[r];
            g0[r] = bflo(gw); g1[r] = bfhi(gw); q0[r] = bflo(qw); q1[r] = bfhi(qw); }
        if (it + F.G < 2048) { const size_t nb = HP_BASE(it + F.G);
#pragma unroll
            for (int r = 0; r < 8; ++r) { ngw[r] = *(const unsigned*)(BG + nb + (size_t)r * 1024); nqw[r] = *(const unsigned*)(BQ + nb + (size_t)r * 1024); } }
        float c0 = 0.f, c1 = 0.f, bl0[8], bl1[8];
#pragma unroll
        for (int r = 0; r < 8; ++r) { c0 += g0[r]; c1 += g1[r]; bl0[r] = c0; bl1[r] = c1; }
        wsum[w * 128 + 2 * cp] = c0; wsum[w * 128 + 2 * cp + 1] = c1;
        __syncthreads();
        float off0 = 0.f, off1 = 0.f, mid0 = 0.f, mid1 = 0.f, last0 = 0.f, last1 = 0.f;
#pragma unroll
        for (int ww = 0; ww < 8; ++ww) { const float s0 = wsum[ww * 128 + 2 * cp], s1 = wsum[ww * 128 + 2 * cp + 1];
            if (ww < w) { off0 += s0; off1 += s1; } if (ww < 4) { mid0 += s0; mid1 += s1; } last0 += s0; last1 += s1; }
#pragma unroll
        for (int r = 0; r < 8; ++r) {
            const float b0 = bl0[r] + off0, b1 = bl1[r] + off1;
            const float k0 = 1.f - __expf(g0[r]), k1 = 1.f - __expf(g1[r]);
            *(unsigned*)(BQo + base + (size_t)r * 1024) = cvt_pk_bf16(q0[r] * __expf(b0), q1[r] * __expf(b1));
            *(unsigned*)(BGo + base + (size_t)r * 1024) = cvt_pk_bf16(k0 * __expf(last0 - b0), k1 * __expf(last1 - b1));
            *(LAS unsigned*)(qt + (8 * w + r) * 272 + 4 * cp) = cvt_pk_bf16(q0[r] * __expf(b0 - mid0), q1[r] * __expf(b1 - mid1));
            *(LAS unsigned*)(kt + (8 * w + r) * 272 + 4 * cp) = cvt_pk_bf16(k0 * __expf(mid0 - b0), k1 * __expf(mid1 - b1));
        }
        if (w == 0) { HDEC[(size_t)it * 128 + 2 * cp] = __expf(last0); HDEC[(size_t)it * 128 + 2 * cp + 1] = __expf(last1); }
        __syncthreads();
        { const int tt = w & 3, fr = lane & 15, g4 = lane >> 4;
          bf16x8 qf[4];
#pragma unroll
          for (int ks = 0; ks < 4; ++ks) qf[ks] = *(const LAS bf16x8*)(qt + (16 * tt + fr) * 272 + (32 * ks + 8 * g4) * 2);
#pragma unroll
          for (int si = 0; si < 2; ++si) { const int st = 2 * (w >> 2) + si; f32x4 acc = {0.f, 0.f, 0.f, 0.f};
#pragma unroll
              for (int ks = 0; ks < 4; ++ks) { const bf16x8 kf = *(const LAS bf16x8*)(kt + (16 * st + fr) * 272 + (32 * ks + 8 * g4) * 2); acc = mfma16(kf, qf[ks], acc); }
              const int t = 16 * tt + fr, s0 = 16 * st + 4 * g4;
              float x[4];
#pragma unroll
              for (int i = 0; i < 4; ++i) x[i] = (s0 + i <= t) ? acc[i] : 0.f;
              u32x2 o; o.x = cvt_pk_bf16(x[0], x[1]); o.y = cvt_pk_bf16(x[2], x[3]);
              *(u32x2*)(HA + ((size_t)it * 64 + t) * 64 + s0) = o; } }
        __syncthreads();
    }
}
__device__ __forceinline__ void ph_rprep(Frame& F) {
    const bf16_t* CQ = (const bf16_t*)(F.ws + WS_P + P_CQ); const bf16_t* CK = (const bf16_t*)(F.ws + WS_P + P_CK); bf16_t* RA = (bf16_t*)(F.ws + WS_RA);
    const int w = F.wave, lane = F.lane, fr = lane & 15, g4 = lane >> 4, v = w & 3, tA = v, tB = 7 - v;
    for (int pr = F.bid; pr < 256; pr += F.G) { const int it = 2 * pr + (w >> 2);
        const int bh = it >> 5, ch = it & 31, b = bh >> 2, h = bh & 3;
        const size_t base = ((size_t)b * SEQ + ch * 128) * 1024 + h * 256;
        const float gi = exp2f(-128.f * __log2f(1.f - exp2f(-5.f - (float)h)));
        bf16x8 qa[8], qb[8], kf[8], kn[8];
#pragma unroll
        for (int ks = 0; ks < 8; ++ks) { qa[ks] = *(const bf16x8*)(CQ + base + (size_t)(16 * tA + fr) * 1024 + 32 * ks + 8 * g4); qb[ks] = *(const bf16x8*)(CQ + base + (size_t)(16 * tB + fr) * 1024 + 32 * ks + 8 * g4); }
#pragma unroll
        for (int ks = 0; ks < 8; ++ks) kf[ks] = *(const bf16x8*)(CK + base + (size_t)fr * 1024 + 32 * ks + 8 * g4);
        bf16_t* ra = RA + ((size_t)it * 128 + fr) * 128 + 4 * g4;
        for (int st = 0; st < 8; ++st) {
            if (st < tB) {
#pragma unroll
                for (int ks = 0; ks < 8; ++ks) kn[ks] = *(const bf16x8*)(CK + base + (size_t)(16 * (st + 1) + fr) * 1024 + 32 * ks + 8 * g4); }
            const int s0 = 16 * st + 4 * g4;
            { u32x2 o = {0u, 0u};
              if (st <= tB) { f32x4 acc = {0.f, 0.f, 0.f, 0.f};
#pragma unroll
                  for (int ks = 0; ks < 8; ++ks) acc = mfma16(kf[ks], qb[ks], acc);
                  const int t = 16 * tB + fr; float x[4];
#pragma unroll
                  for (int i = 0; i < 4; ++i) x[i] = (s0 + i <= t) ? acc[i] * gi : 0.f;
                  o.x = cvt_pk_bf16(x[0], x[1]); o.y = cvt_pk_bf16(x[2], x[3]); }
              *(u32x2*)(ra + (size_t)(16 * tB) * 128 + 16 * st) = o; }
            { u32x2 o = {0u, 0u};
              if (st <= tA) { f32x4 acc = {0.f, 0.f, 0.f, 0.f};
#pragma unroll
                  for (int ks = 0; ks < 8; ++ks) acc = mfma16(kf[ks], qa[ks], acc);
                  const int t = 16 * tA + fr; float x[4];
#pragma unroll
                  for (int i = 0; i < 4; ++i) x[i] = (s0 + i <= t) ? acc[i] * gi : 0.f;
                  o.x = cvt_pk_bf16(x[0], x[1]); o.y = cvt_pk_bf16(x[2], x[3]); }
              *(u32x2*)(ra + (size_t)(16 * tA) * 128 + 16 * st) = o; }
            if (st < tB) {
#pragma unroll
                for (int ks = 0; ks < 8; ++ks) kf[ks] = kn[ks]; }
        }
    }
}
template <int OFF> __device__ __forceinline__ s16x4 trrd(unsigned addr) { s16x4 r; asm volatile("ds_read_b64_tr_b16 %0, %1 offset:%2" : "=&v"(r) : "v"(addr), "i"(OFF) : "memory"); return r; }
__device__ __forceinline__ bf16x8 cat8(s16x4 a, s16x4 b) { return (bf16x8){a[0], a[1], a[2], a[3], b[0], b[1], b[2], b[3]}; }
template <int C, int DK, int NCT, int LDQ, int LDV, int LDO, bool VEC>
__device__ __forceinline__ void scan_item(LAS unsigned char* lds, int tid, int w, int lane, const bf16_t* Q, const bf16_t* Kt, const bf16_t* V, const bf16_t* A, const float* dec, float cdec, bf16_t* O, int nchunk) {
    constexpr int RSK = DK * 2 + 32, RSV = NCT * 32 + 8, RST = DK * 2 + 16;
    constexpr int KL = 0, VL = C * RSK, ST0 = VL + C * RSV;
    constexpr int NPK = C * DK / 8 / NTHR;
    constexpr int PV = C * NCT * 2, NPV = (PV + NTHR - 1) / NTHR;
    constexpr int NKS_C = C / 32, NKS_D = DK / 32;
    constexpr int NDT = DK / 16 / 8;
    const int fr = lane & 15, g4 = lane >> 4, q4 = fr >> 2, p4 = lane & 3;
    const bool ow = w < C / 16;
    const int rt = ow ? w : 0;
    const unsigned ldsb = (unsigned)(uintptr_t)lds;
    const unsigned vtr = ldsb + VL + (8 * g4 + q4) * RSV + 8 * p4;
    const unsigned ktr = ldsb + KL + (8 * g4 + q4) * RSK + 8 * p4 + w * NDT * 32;
    LAS unsigned char* stb = lds + ST0;
    f32x4 S[NDT][NCT];
#pragma unroll
    for (int i = 0; i < NDT; ++i)
#pragma unroll
        for (int ct = 0; ct < NCT; ++ct) S[i][ct] = (f32x4){0.f, 0.f, 0.f, 0.f};
    u32x4 kst[NPK], vst[NPV]; bf16x8 qf[NKS_D], af[NKS_C];
    const unsigned klo = (unsigned)((tid / (DK / 8)) * LDQ + (tid % (DK / 8)) * 8) * 2u;
    const unsigned vlo = (unsigned)((tid / (NCT * 2)) * LDV + (tid % (NCT * 2)) * 8) * 2u, vlds = (unsigned)((tid / (NCT * 2)) * RSV + (tid % (NCT * 2)) * 16);
    const unsigned qlo = (unsigned)(fr * LDQ + 8 * g4) * 2u, alo = (unsigned)(fr * C + 8 * g4) * 2u, olo = (unsigned)(fr * LDO + 4 * g4) * 2u;
    const unsigned klds = (unsigned)((tid / (DK / 8)) * RSK + (tid % (DK / 8)) * 16);
    constexpr int KROWS = NTHR / (DK / 8), VROWS = NTHR / (NCT * 2);
#define SC_LOADK(cc) do { const char* kb_ = (const char*)Kt + (size_t)(cc) * (C * LDQ * 2); _Pragma("unroll") for (int i = 0; i < NPK; ++i) kst[i] = *(const u32x4*)(kb_ + (size_t)i * (KROWS * LDQ * 2) + klo); \
        const char* vb_ = (const char*)V + (size_t)(cc) * (C * LDV * 2); _Pragma("unroll") for (int i = 0; i < NPV; ++i) if (tid + NTHR * i < PV) vst[i] = *(const u32x4*)(vb_ + (size_t)i * (VROWS * LDV * 2) + vlo); } while (0)
#define SC_LOADQ(cc) do { const char* qb_ = (const char*)Q + ((size_t)(cc) * C + 16 * rt) * (LDQ * 2); const char* ab_ = (const char*)A + ((size_t)(cc) * C + 16 * rt) * (C * 2); \
        _Pragma("unroll") for (int ks = 0; ks < NKS_D; ++ks) qf[ks] = *(const bf16x8*)(qb_ + ks * 64 + qlo); \
        _Pragma("unroll") for (int ks = 0; ks < NKS_C; ++ks) af[ks] = *(const bf16x8*)(ab_ + ks * 64 + alo); } while (0)
#pragma unroll
    for (int i = 0; i < NPV; ++i) vst[i] = (u32x4){0u, 0u, 0u, 0u};
    SC_LOADK(0); SC_LOADQ(0);
    for (int c = 0; c < nchunk; ++c) {
#pragma unroll
        for (int i = 0; i < NDT; ++i)
#pragma unroll
            for (int ct = 0; ct < NCT; ++ct) { u32x2 o; o.x = cvt_pk_bf16(S[i][ct][0], S[i][ct][1]); o.y = cvt_pk_bf16(S[i][ct][2], S[i][ct][3]);
                *(LAS u32x2*)(stb + (16 * ct + fr) * RST + (16 * (w * NDT + i) + 4 * g4) * 2) = o; }
#pragma unroll
        for (int i = 0; i < NPK; ++i) *(LAS u32x4*)(lds + KL + klds + i * (KROWS * RSK)) = kst[i];
#pragma unroll
        for (int i = 0; i < NPV; ++i) if (tid + NTHR * i < PV) { LAS unsigned char* p = lds + VL + vlds + i * (VROWS * RSV); *(LAS u32x2*)p = (u32x2){vst[i].x, vst[i].y}; *(LAS u32x2*)(p + 8) = (u32x2){vst[i].z, vst[i].w}; }
        f32x4 dv[NDT];
#pragma unroll
        for (int i = 0; i < NDT; ++i) dv[i] = VEC ? *(const f32x4*)(dec + (size_t)c * DK + 16 * (w * NDT + i) + 4 * g4) : (f32x4){cdec, cdec, cdec, cdec};
        __syncthreads();
        if (c + 1 < nchunk) SC_LOADK(c + 1);
#pragma unroll
        for (int i = 0; i < NDT; ++i)
#pragma unroll
            for (int ct = 0; ct < NCT; ++ct) S[i][ct] *= dv[i];
        f32x4 acc[NCT];
#pragma unroll
        for (int ct = 0; ct < NCT; ++ct) acc[ct] = (f32x4){0.f, 0.f, 0.f, 0.f};
#pragma unroll
        for (int ks = 0; ks < NKS_C; ++ks) {
            bf16x8 vf[NCT], kf[NDT];
            static_assert(NCT == 4 && (NDT == 1 || NDT == 2), "scan_item: the batched fragment reads are written for 4 column tiles and 1 or 2 state d-tiles");
            { s16x4 v0, v1, v2, v3, v4, v5, v6, v7, k0, k1, k2, k3;
              if constexpr (NDT == 2) {
                  asm volatile("ds_read_b64_tr_b16 %0, %12 offset:%14\n\tds_read_b64_tr_b16 %1, %12 offset:%15\n\tds_read_b64_tr_b16 %2, %12 offset:%16\n\tds_read_b64_tr_b16 %3, %12 offset:%17\n\t"
                               "ds_read_b64_tr_b16 %4, %12 offset:%18\n\tds_read_b64_tr_b16 %5, %12 offset:%19\n\tds_read_b64_tr_b16 %6, %12 offset:%20\n\tds_read_b64_tr_b16 %7, %12 offset:%21\n\t"
                               "ds_read_b64_tr_b16 %8, %13 offset:0\n\tds_read_b64_tr_b16 %9, %13 offset:%22\n\tds_read_b64_tr_b16 %10, %13 offset:32\n\tds_read_b64_tr_b16 %11, %13 offset:%23\n\ts_waitcnt lgkmcnt(0)"
                               : "=&v"(v0), "=&v"(v1), "=&v"(v2), "=&v"(v3), "=&v"(v4), "=&v"(v5), "=&v"(v6), "=&v"(v7), "=&v"(k0), "=&v"(k1), "=&v"(k2), "=&v"(k3)
                               : "v"(vtr + ks * 32 * RSV), "v"(ktr + ks * 32 * RSK), "i"(0), "i"(4 * RSV), "i"(32), "i"(4 * RSV + 32), "i"(64), "i"(4 * RSV + 64), "i"(96), "i"(4 * RSV + 96), "i"(4 * RSK), "i"(4 * RSK + 32) : "memory");
                  kf[0] = cat8(k0, k1); kf[NDT - 1] = cat8(k2, k3);
              } else {
                  asm volatile("ds_read_b64_tr_b16 %0, %10 offset:%12\n\tds_read_b64_tr_b16 %1, %10 offset:%13\n\tds_read_b64_tr_b16 %2, %10 offset:%14\n\tds_read_b64_tr_b16 %3, %10 offset:%15\n\t"
                               "ds_read_b64_tr_b16 %4, %10 offset:%16\n\tds_read_b64_tr_b16 %5, %10 offset:%17\n\tds_read_b64_tr_b16 %6, %10 offset:%18\n\tds_read_b64_tr_b16 %7, %10 offset:%19\n\t"
                               "ds_read_b64_tr_b16 %8, %11 offset:0\n\tds_read_b64_tr_b16 %9, %11 offset:%20\n\ts_waitcnt lgkmcnt(0)"
                               : "=&v"(v0), "=&v"(v1), "=&v"(v2), "=&v"(v3), "=&v"(v4), "=&v"(v5), "=&v"(v6), "=&v"(v7), "=&v"(k0), "=&v"(k1)
                               : "v"(vtr + ks * 32 * RSV), "v"(ktr + ks * 32 * RSK), "i"(0), "i"(4 * RSV), "i"(32), "i"(4 * RSV + 32), "i"(64), "i"(4 * RSV + 64), "i"(96), "i"(4 * RSV + 96), "i"(4 * RSK) : "memory");
                  kf[0] = cat8(k0, k1);
              }
              vf[0] = cat8(v0, v1); vf[1] = cat8(v2, v3); vf[2] = cat8(v4, v5); vf[3] = cat8(v6, v7); }
#pragma unroll
            for (int i = 0; i < NDT; ++i)
#pragma unroll
                for (int ct = 0; ct < NCT; ++ct) S[i][ct] = mfma16(kf[i], vf[ct], S[i][ct]);
            if (ow) {
#pragma unroll
                for (int ct = 0; ct < NCT; ++ct) acc[ct] = mfma16(vf[ct], af[ks], acc[ct]); }
        }
        if (ow) {
#pragma unroll
            for (int ks = 0; ks < NKS_D; ++ks)
#pragma unroll
                for (int ct = 0; ct < NCT; ++ct) { const bf16x8 sf = *(const LAS bf16x8*)(stb + (16 * ct + fr) * RST + (32 * ks + 8 * g4) * 2); acc[ct] = mfma16(sf, qf[ks], acc[ct]); }
            char* op = (char*)O + ((size_t)c * C + 16 * rt) * (LDO * 2) + olo;
#pragma unroll
            for (int ct = 0; ct < NCT; ++ct) { u32x2 o; o.x = cvt_pk_bf16(acc[ct][0], acc[ct][1]); o.y = cvt_pk_bf16(acc[ct][2], acc[ct][3]); *(u32x2*)(op + 32 * ct) = o; }
            if (c + 1 < nchunk) SC_LOADQ(c + 1);
        }
        __syncthreads();
    }
#undef SC_LOADK
#undef SC_LOADQ
}
__device__ __forceinline__ void ph_scan_ret(Frame& F) {
    for (int c = F.bid; c < 256; c += F.G) { const int r = c >> 3; if (r >= 16) continue;
        const int bh = 2 * (c & 7) + (r >> 3), vs = r & 7, b = bh >> 2, h = bh & 3;
        const size_t tok = (size_t)b * SEQ;
        scan_item<128, 256, 4, 1024, 2048, 1024, false>(F.lds, F.tid, F.wave, F.lane, (const bf16_t*)(F.ws + WS_P + P_CQ) + tok * 1024 + h * 256, (const bf16_t*)(F.ws + WS_P + P_CK) + tok * 1024 + h * 256,
            (const bf16_t*)(F.ws + WS_P + P_CV) + tok * 2048 + h * 512 + vs * 64, (const bf16_t*)(F.ws + WS_RA) + (size_t)bh * 32 * 128 * 128, nullptr, exp2f(128.f * __log2f(1.f - exp2f(-5.f - (float)h))),
            (bf16_t*)(F.ws + WS_OC) + (size_t)(h >> 1) * M * 1024 + tok * 1024 + (h & 1) * 512 + vs * 64, 32); }
}
__device__ __forceinline__ void ph_scan_hgrn(Frame& F, unsigned char* dry = nullptr) {
    for (int c = F.bid; c < 256; c += F.G) { const int r = c >> 3; if (r < 16 || r >= 24) continue;
        const int bh = 4 * (c & 7) + ((r - 16) >> 1), vs = (r - 16) & 1, b = bh >> 3, h = bh & 7;
        const size_t tok = (size_t)b * SEQ;
        scan_item<64, 128, 4, 1024, 1024, 1024, true>(F.lds, F.tid, F.wave, F.lane, (const bf16_t*)(F.ws + WS_P + P_BQ) + tok * 1024 + h * 128, (const bf16_t*)(F.ws + WS_P + P_BG) + tok * 1024 + h * 128,
            (const bf16_t*)(F.ws + WS_P + P_BV) + tok * 1024 + h * 128 + vs * 64, (const bf16_t*)(F.ws + WS_HA) + (size_t)bh * 64 * 64 * 64, (const float*)(F.ws + WS_HDEC) + (size_t)bh * 64 * 128, 0.f,
            (bf16_t*)(F.ws + WS_OB) + tok * 1024 + h * 128 + vs * 64, 64); }
}
__device__ __forceinline__ void ph_post(Frame& F, const float* ng  , unsigned char* dry) {
    bf16_t* OB = (bf16_t*)(F.ws + WS_OB); bf16_t* OC = (bf16_t*)(F.ws + WS_OC); bf16_t* OBo = dry ? (bf16_t*)dry : OB; bf16_t* OCo = dry ? (bf16_t*)(dry + 32 * MiB) : OC; const bf16_t* BO = (const bf16_t*)(F.ws + WS_P + P_BO); const bf16_t* CG = (const bf16_t*)(F.ws + WS_P + P_CG);
    const int gw = F.bid * NWAVES + F.wave, NGW = F.G * NWAVES, lane = F.lane;
    float ngv[16];
    { const int d0_ = (16 * lane) & 127;
#pragma unroll
      for (int q = 0; q < 4; ++q) { const f32x4 t = *(const f32x4*)(ng + d0_ + 4 * q); ngv[4 * q] = t[0]; ngv[4 * q + 1] = t[1]; ngv[4 * q + 2] = t[2]; ngv[4 * q + 3] = t[3]; } }
    for (int row = gw; row < M; row += NGW) {
        const size_t ob_ = (size_t)row * 1024 + 16 * lane;
        u32x4 va[3][2], vg[3][2];
        va[0][0] = *(const u32x4*)(OB + ob_); va[0][1] = *(const u32x4*)(OB + ob_ + 8); vg[0][0] = *(const u32x4*)(BO + ob_); vg[0][1] = *(const u32x4*)(BO + ob_ + 8);
#pragma unroll
        for (int half = 0; half < 2; ++half) { const size_t o = (size_t)half * M * 1024 + ob_, og = (size_t)row * 2048 + 1024 * half + 16 * lane;
            va[1 + half][0] = *(const u32x4*)(OC + o); va[1 + half][1] = *(const u32x4*)(OC + o + 8); vg[1 + half][0] = *(const u32x4*)(CG + og); vg[1 + half][1] = *(const u32x4*)(CG + og + 8); }
#pragma unroll
        for (int p = 0; p < 3; ++p) {
            const u32x4 a0 = va[p][0], a1 = va[p][1], g0 = vg[p][0], g1 = vg[p][1];
            float x[16] = {bflo(a0.x), bfhi(a0.x), bflo(a0.y), bfhi(a0.y), bflo(a0.z), bfhi(a0.z), bflo(a0.w), bfhi(a0.w), bflo(a1.x), bfhi(a1.x), bflo(a1.y), bfhi(a1.y), bflo(a1.z), bfhi(a1.z), bflo(a1.w), bfhi(a1.w)};
            const float gg[16] = {bflo(g0.x), bfhi(g0.x), bflo(g0.y), bfhi(g0.y), bflo(g0.z), bfhi(g0.z), bflo(g0.w), bfhi(g0.w), bflo(g1.x), bfhi(g1.x), bflo(g1.y), bfhi(g1.y), bflo(g1.z), bfhi(g1.z), bflo(g1.w), bfhi(g1.w)};
            float ss = 0.f;
#pragma unroll
            for (int j = 0; j < 16; ++j) ss += x[j] * x[j];
            ss = sum8(ss);
            if (p) { ss += DPPF(ss, 0x140); ss = xadd16(ss); }
            const float r = rsqrtf(ss * (p ? (1.f / 512.f) : (1.f / 128.f)) + EPS);
#pragma unroll
            for (int j = 0; j < 16; ++j) x[j] = x[j] * r * gg[j] * (p ? 1.f : ngv[j]);
            bf16_t* dst = p ? OCo + (size_t)(p - 1) * M * 1024 + ob_ : OBo + ob_;
            pg8::st8(dst, x); pg8::st8(dst + 8, x + 8); }
    }
}
__device__ __forceinline__ void ph_norm2(Frame& F, int l, const float* g, const float* sc, const float* sh, unsigned char* dry) {
    const bf16_t* X = (const bf16_t*)(F.ws + WS_X); bf16_t* H = dry ? (bf16_t*)dry : (bf16_t*)(F.ws + WS_H); const bf16_t* RW = (const bf16_t*)(F.ws + WS_RW) + (size_t)l * 48 * 1024;
    const float* rgb = F.in(15) + l * 4; const float* reb = F.in(17) + l * 32;
    unsigned* ghist = F.ctl + CW_HIST + (dry ? 8192 : 0);
    LAS unsigned* hist = (LAS unsigned*)(F.lds + 8 * 4096);
    int* tok_e = dry ? (int*)(dry + 32 * MiB) : (int*)(F.ws + WS_TOK); int* tok_p = tok_e + 2 * M; float* tok_w = (float*)(tok_p + 2 * M);
    int2* rinfo = dry ? (int2*)(dry + 40 * MiB) : (int2*)(F.ws + WS_RINFO);
    LAS float* lg = (LAS float*)(F.lds + F.wave * 4096);
    const int lane = F.lane, fr = lane & 15, g4 = lane >> 4;
    if (F.tid < 32) hist[F.tid] = 0u;
    __syncthreads();
    { const int m1 = (F.tid >> 31) - 1;
      for (int i = F.bid * NTHR + F.tid; i < XG_ROWS; i += F.G * NTHR) rinfo[i] = make_int2(m1, 0); }
    { const int it = F.bid * 4 + (F.wave & 3), kh = F.wave >> 2;
        LAS float* ssx = (LAS float*)(F.lds + 8 * 4096 + 256);
        const int row = 16 * it + fr, b = row >> 12; const bf16_t* xr = X + (size_t)row * D;
        float ss = 0.f;
#pragma unroll 8
        for (int kk = 16 * kh; kk < 16 * kh + 16; ++kk) { const u32x4 xw = *(const u32x4*)(xr + 32 * kk + 8 * g4);
            const float a0 = bflo(xw.x), a1 = bfhi(xw.x), a2 = bflo(xw.y), a3 = bfhi(xw.y), c0_ = bflo(xw.z), c1 = bfhi(xw.z), c2 = bflo(xw.w), c3 = bfhi(xw.w);
            ss += (a0 * a0 + a1 * a1) + (a2 * a2 + a3 * a3) + (c0_ * c0_ + c1 * c1) + (c2 * c2 + c3 * c3); }
        ss = xadd32(xadd16(ss));
        if (lane < 16) ssx[F.wave * 16 + lane] = ss;
        __syncthreads();
        ss = ssx[(F.wave & 3) * 16 + fr] + ssx[((F.wave & 3) + 4) * 16 + fr];
        const float r = rsqrtf(ss * (1.f / D) + EPS);
        f32x4 acc[3] = {{0.f, 0.f, 0.f, 0.f}, {0.f, 0.f, 0.f, 0.f}, {0.f, 0.f, 0.f, 0.f}};
#pragma unroll 4
        for (int kk = 16 * kh; kk < 16 * kh + 16; ++kk) { const int c0 = 32 * kk + 8 * g4;
            float x[8]; { const u32x4 xw = *(const u32x4*)(xr + c0); x[0] = bflo(xw.x); x[1] = bfhi(xw.x); x[2] = bflo(xw.y); x[3] = bfhi(xw.y); x[4] = bflo(xw.z); x[5] = bfhi(xw.z); x[6] = bflo(xw.w); x[7] = bfhi(xw.w); }
            const f32x4 ga = *(const f32x4*)(g + c0), gb = *(const f32x4*)(g + c0 + 4), sa = *(const f32x4*)(sc + b * 6 * D + c0), sb = *(const f32x4*)(sc + b * 6 * D + c0 + 4), ha = *(const f32x4*)(sh + b * 6 * D + c0), hb = *(const f32x4*)(sh + b * 6 * D + c0 + 4);
#pragma unroll
            for (int j = 0; j < 4; ++j) { x[j] = x[j] * r * ga[j] * (1.f + sa[j]) + ha[j]; x[4 + j] = x[4 + j] * r * gb[j] * (1.f + sb[j]) + hb[j]; }
            u32x4 wv; wv.x = cvt_pk_bf16(x[0], x[1]); wv.y = cvt_pk_bf16(x[2], x[3]); wv.z = cvt_pk_bf16(x[4], x[5]); wv.w = cvt_pk_bf16(x[6], x[7]);
            *(u32x4*)(H + (size_t)row * D + c0) = wv;
            const bf16x8 af = *reinterpret_cast<const bf16x8*>(&wv);
#pragma unroll
            for (int nt = 0; nt < 3; ++nt) { const bf16x8 bfm = *(const bf16x8*)(RW + (size_t)(16 * nt + fr) * 1024 + c0); acc[nt] = mfma16(af, bfm, acc[nt]); } }
#pragma unroll
        for (int nt = 0; nt < 3; ++nt)
#pragma unroll
            for (int i = 0; i < 4; ++i) lg[(4 * g4 + i) * 48 + 16 * nt + fr] = acc[nt][i];
        __syncthreads();
        if (kh == 0 && lane < 16) { const int tk = 16 * it + lane; const LAS float* q = lg + lane * 48; const LAS float* q2 = q + 4 * 1024;
            float mx = -1e30f; int gs = 0;
#pragma unroll
            for (int i = 0; i < 4; ++i) { const float v = q[i] + q2[i] + rgb[i]; if (v > mx) { mx = v; gs = i; } }
            float s = 0.f;
#pragma unroll
            for (int i = 0; i < 4; ++i) s += __expf(q[i] + q2[i] + rgb[i] - mx);
            const float gp = __builtin_amdgcn_rcpf(s);
            float v0 = -1e30f, v1 = -1e30f; int i0 = 0, i1 = 0;
            for (int i = 0; i < 8; ++i) { const float e = q[4 + gs * 8 + i] + q2[4 + gs * 8 + i] + reb[gs * 8 + i];
                if (e > v0) { v1 = v0; i1 = i0; v0 = e; i0 = i; } else if (e > v1) { v1 = e; i1 = i; } }
            const int z_ = F.tid >> 31;
            const float one_ = __int_as_float(0x3f800000 + z_); const unsigned uone_ = 1u + (unsigned)z_;
            const float w1 = __expf(v1 - v0), den = one_ / (one_ + w1);
            const int e0 = gs * 8 + i0, e1 = gs * 8 + i1;
            const unsigned p0 = __hip_atomic_fetch_add(hist + e0, uone_, __ATOMIC_RELAXED, __HIP_MEMORY_SCOPE_WORKGROUP), p1 = __hip_atomic_fetch_add(hist + e1, uone_, __ATOMIC_RELAXED, __HIP_MEMORY_SCOPE_WORKGROUP);
            tok_e[2 * tk] = e0; tok_e[2 * tk + 1] = e1; tok_p[2 * tk] = (int)p0; tok_p[2 * tk + 1] = (int)p1; tok_w[2 * tk] = gp * den; tok_w[2 * tk + 1] = gp * w1 * den; }
        LDS_WAIT(); asm volatile("" ::: "memory");
    }
    __syncthreads();
    if (F.tid < 32) ghist[F.bid * 32 + F.tid] = hist[F.tid];
}
__device__ __forceinline__ void ph_gather(Frame& F, int l) {
    const unsigned* ghist = F.ctl + CW_HIST;
    const int* tok_e = (const int*)(F.ws + WS_TOK); const int* tok_p = tok_e + 2 * M; const float* tok_w = (const float*)(tok_p + 2 * M);
    int2* rinfo = (int2*)(F.ws + WS_RINFO); int* t2e = (int*)(F.ws + WS_T2E);
    LAS int* offs = (LAS int*)F.lds;
    LAS int* pre = (LAS int*)(F.lds + 1024);
    for (int i = F.tid; i < 256 * 32; i += NTHR) pre[i] = (int)ghist[i];
    __syncthreads();
    { LAS int* segs = (LAS int*)(F.lds + 1024 + 32768);
      const int e = F.tid & 31, sg = F.tid >> 5; int v[16], sum = 0;
#pragma unroll
      for (int i = 0; i < 16; ++i) { v[i] = pre[(sg * 16 + i) * 32 + e]; sum += v[i]; }
      segs[sg * 32 + e] = sum;
      __syncthreads();
      if (F.tid < 32) { int run = 0;
#pragma unroll
          for (int i = 0; i < 16; ++i) { const int c = segs[i * 32 + F.tid]; segs[i * 32 + F.tid] = run; run += c; }
          offs[F.tid] = run; }
      __syncthreads();
      int run = segs[sg * 32 + e];
#pragma unroll
      for (int i = 0; i < 16; ++i) { pre[(sg * 16 + i) * 32 + e] = run; run += v[i]; } }
    __syncthreads();
    if (F.tid == 0) { int o = 0; for (int e = 0; e < NE; ++e) { const int c = offs[e]; offs[e] = o; o += (c + 255) & ~255; } offs[NE] = o; }
    __syncthreads();
    if (F.bid == 0) { if (F.tid == 0) t2e[0] = offs[NE] >> 8;
        for (int e = F.tid; e < NE; e += NTHR) for (int rt = offs[e] >> 8; rt < (offs[e + 1] >> 8); ++rt) t2e[1 + rt] = e; }
    for (int ts = F.bid * NTHR + F.tid; ts < 2 * M; ts += F.G * NTHR) {
        const int e = tok_e[ts], p = tok_p[ts]; const int tk = ts >> 1; const int row = offs[e] + pre[(tk >> 6) * 32 + e] + p;
        rinfo[row] = make_int2(ts, __float_as_int(tok_w[ts]));
    }
}
__device__ __forceinline__ int build_units(Frame& F, LAS int* tab) {
    const int* t2e = (const int*)(F.ws + WS_T2E);
    const int L = F.tid * F.G + F.bid; int e = 0;
    if (F.tid < 8) e = t2e[1 + (L >> 2)];
    const int NT = t2e[0];
    if (F.tid < 8 && L < 4 * NT) tab[F.tid] = ((L >> 2) << 8) | (e * 4 + (L & 3));
    int n = (4 * NT - F.bid + F.G - 1) / F.G; n = n < 0 ? 0 : (n > 8 ? 8 : n);
    __syncthreads();
    return n;
}
#ifndef MK_ONE_LAUNCH
#define MK_ONE_LAUNCH 1
#endif
constexpr int NPHASE = 13;
__global__ void __launch_bounds__(NTHR, 2) mk_fwd(Args a) {
    extern __shared__ __attribute__((aligned(16))) unsigned char lds[];
    Frame F;
    F.lds = (LAS unsigned char*)lds; F.MISC = (volatile LAS unsigned*)(F.lds + MISC_OFF);
    F.tid = threadIdx.x; F.lane = F.tid & 63; F.wave = __builtin_amdgcn_readfirstlane(F.tid >> 6); F.G = gridDim.x; F.bid = blockIdx.x;
    F.ws = a.ws; F.ctl = (unsigned*)(a.ws + WS_CTL); F.out = a.out;
    for (int u = F.tid; u < 1024; u += NTHR) ((LAS unsigned*)(F.lds + MISC_OFF))[u] = 0u;
    __syncthreads();
#pragma unroll
    for (int i = 0; i < 22; ++i) if (F.tid == i) *(LAS u64*)(F.lds + MISC_OFF + 512 + 8 * i) = (u64)a.in[i];
    __syncthreads();
    XcdBarrier bar; bar.bar = F.ctl + CW_BAR; bar.x = 0; bar.st = F.MISC + 8;
    if (a.pad == 0) bar = xcd_barrier_post(F.ctl + CW_BAR, F.MISC + 8);
    const int lo = a.ph_lo, hi = a.ph_hi;
#ifndef SUB
#define SUB 7
#endif
#ifndef DBL
#define DBL 0
#endif
#define REP(k) _Pragma("nounroll") for (int rep_ = 0; rep_ < ((DBL == (k)) ? 2 : 1); ++rep_)
#ifndef PHSEL
#define PHSEL 0xffff
#endif
#define IN(k) (((PHSEL >> (k)) & 1) && lo <= (k) && (k) < hi)
#define GRID_BAR() do { if (a.pad == 0) xcd_barrier(bar); asm volatile("" : "+v"(F.tid), "+v"(F.lane), "+s"(F.wave) :: "memory"); } while (0)
    unsigned char* ws = a.ws; unsigned char* wb = ws + WS_W; unsigned char* pb = ws + WS_P;
    bf16_t* X = (bf16_t*)(ws + WS_X); bf16_t* H = (bf16_t*)(ws + WS_H); bf16_t* YS = (bf16_t*)(ws + WS_YS);
    const float* mod = (const float*)(ws + WS_MOD);
    LAS int* utab = (LAS int*)(F.lds + MISC_OFF + 256);
#ifdef MK_DRY
    unsigned char* dry = a.dry ? ws + WS_END : nullptr;
#define DRYP(T, normal, off) (dry ? (T)(dry + (off)) : (normal))
#else
#define DRYP(T, normal, off) (normal)
#endif
#ifdef MK_STAMP
    unsigned long long* ts_ = (unsigned long long*)(F.ctl + 210000);
#define STAMP(k) do { if (F.bid == 0 && F.tid == 0 && l == 1) ts_[k] = wall_clock64(); } while (0)
#else
#define STAMP(k) do {} while (0)
#endif

    if (IN(0) && a.lay_lo == 0) { ph_prologue(F); GRID_BAR(); }

    int nu_up = -1;
    for (int l = a.lay_lo; l < a.lay_hi; ++l) {
        const float* md = mod + (size_t)l * BATCH * 6 * D;
        if (IN(1)) {
            STAMP(0); REP(1) ph_conv(F, l); STAMP(1);
            if (l == 0) ph_norm(F, F.in(0), nullptr, nullptr, nullptr, nullptr, F.in(4) + l * D, md + 1 * D, md + 0 * D, DRYP(bf16_t*, H, 64 * MiB), nullptr);
            else ph_norm(F, nullptr, X, YS, md - (size_t)BATCH * 6 * D + 5 * D, DRYP(bf16_t*, X, 0), F.in(4) + l * D, md + 1 * D, md + 0 * D, DRYP(bf16_t*, H, 64 * MiB), nullptr);
            GRID_BAR(); STAMP(2);
        }
        if (IN(2)) REP(2) {
            pg8::Gemm g{H, (const bf16_t*)(wb + W_IN), M, NP, D}; pg8::StaticOrder S; S.init(M, NP, F.G, F.bid);
            pg8::EpiProj E{pb, (const float*)(ws + WS_LB) + l * 1024, (const float2*)(ws + WS_ROT)};
            pg8::gemm_phase<pg8::EpiProj, pg8::StaticOrder, true, true>(F.lds, g, S, E);
            if (rep_ == ((DBL == 2) ? 1 : 0)) GRID_BAR(); STAMP(3);
        }
        if (IN(3)) { if (SUB & 1) REP(3) ph_idx(F, a.dry >> 4); STAMP(4); if ((SUB & 2) && !(a.dry >> 4)) ph_hprep(F, DRYP(unsigned char*, nullptr, 0)); STAMP(5); if ((SUB & 4) && !(a.dry >> 4)) REP(4) ph_rprep(F); GRID_BAR(); STAMP(6); }
        if (IN(4)) { if (SUB & 1) REP(5) ph_att(F, (char*)lds); STAMP(7); if (SUB & 2) REP(6) ph_scan_ret(F);
#ifdef SCANX
            ph_scan_ret_light(F);
#endif
            STAMP(8); if (SUB & 4) REP(7) ph_scan_hgrn(F); GRID_BAR(); STAMP(9); }
        if (IN(5)) { ph_post(F, F.in(9) + l * 128, DRYP(unsigned char*, nullptr, 0)); GRID_BAR(); STAMP(10); }
        if (IN(6)) { REP(8) {
            pg8::SegOrder S; { const int w2 = (F.bid & 7) * 32 + (F.bid >> 3), gid = w2 >> 5, rr = w2 & 31; S.pm0 = gid * 8 + (rr & 7); S.pn0 = rr >> 3; }
            pg8::Gemm g{(const bf16_t*)(ws + WS_OA), (const bf16_t*)(wb + W_BA), 4 * M, 4 * D, 1024};
            pg8::EpiMerge4 E{(const bf16_t*)(pb + P_GA), (bf16_t*)(ws + WS_MGB)};
            if (F.bid < 256) pg8::gemm_phase<pg8::EpiMerge4, pg8::SegOrder, true, true>(F.lds, g, S, E); }
            GRID_BAR(); STAMP(11);
        }
        if (IN(7)) {
            pg8::Gemm g{(const bf16_t*)(ws + WS_MGB), (const bf16_t*)(wb + W_OUT), M, D, 1024}; pg8::StaticOrder S; S.init(M, D, F.G, F.bid);
            pg8::EpiRes E{l == 0 ? F.in(0) : (const float*)nullptr, X, DRYP(bf16_t*, X, 0), md + 2 * D};
            pg8::gemm_phase<pg8::EpiRes, pg8::StaticOrder, false, true>(F.lds, g, S, E);
            GRID_BAR(); STAMP(12);
        }
        if (IN(8)) { ph_norm2(F, l, F.in(5) + l * D, md + 4 * D, md + 3 * D, DRYP(unsigned char*, nullptr, 0)); GRID_BAR(); STAMP(13); }
        if (IN(9)) { ph_gather(F, l); GRID_BAR(); STAMP(14); }
        if (IN(10)) REP(9) {
            pg8::GatherOrder S; S.tab = utab; S.n = build_units(F, utab); nu_up = S.n;
            { LAS unsigned* rows = (LAS unsigned*)(F.lds + 131072);
              const int2* ri = (const int2*)(ws + WS_RINFO);
              for (int idx = F.tid; idx < S.n * 256; idx += NTHR) { const int ts = ri[(utab[idx >> 8] >> 8) * 256 + (idx & 255)].x; rows[idx] = ts < 0 ? 0u : (unsigned)(ts >> 1) * (unsigned)(D * 2); }
              __syncthreads(); S.rows = rows; }
            pg8::Gemm g{(const bf16_t*)(ws + WS_H), (const bf16_t*)(wb + W_E1), XG_ROWS, NE * 1024, 1024};
            pg8::EpiExpUp E{(bf16_t*)(ws + WS_ACT)};
            pg8::gemm_phase<pg8::EpiExpUp, pg8::GatherOrder, true, true>(F.lds, g, S, E);
            if (rep_ == ((DBL == 9) ? 1 : 0)) GRID_BAR(); STAMP(15);
        }
        if (IN(11)) REP(10) {
            pg8::ListOrder S; S.tab = utab; S.n = (a.pad == 0 && nu_up >= 0) ? nu_up : build_units(F, utab); nu_up = -1;
            pg8::Gemm g{(const bf16_t*)(ws + WS_ACT), (const bf16_t*)(wb + W_E2), XG_ROWS, NE * 1024, 512};
            pg8::EpiExpDown E{(const int2*)(ws + WS_RINFO), YS};
            pg8::gemm_phase<pg8::EpiExpDown, pg8::ListOrder, true, true>(F.lds, g, S, E);
            if (rep_ == ((DBL == 10) ? 1 : 0)) GRID_BAR(); STAMP(16);
        }
    }
    if (IN(12) && a.lay_hi == DEPTH) {
        const float* md3 = mod + (size_t)3 * BATCH * 6 * D;
        ph_norm(F, nullptr, X, YS, md3 + 5 * D, nullptr, F.in(21), nullptr, nullptr, nullptr, F.out);
    }
#undef IN
#undef GRID_BAR
}

#ifdef MK_DIAG
__global__ void k_nonfinite(const void* p, size_t n, int is_f32, unsigned* cnt, int slot) {
    size_t i = (size_t)blockIdx.x * blockDim.x + threadIdx.x; const size_t st = (size_t)gridDim.x * blockDim.x; unsigned c = 0;
    if (is_f32) { const unsigned* q = (const unsigned*)p; for (; i < n; i += st) c += ((q[i] & 0x7f800000u) == 0x7f800000u) ? 1u : 0u; }
    else { const unsigned short* q = (const unsigned short*)p; for (; i < n; i += st) c += ((q[i] & 0x7f80u) == 0x7f80u) ? 1u : 0u; }
    if (c) atomicAdd(cnt + slot, c);
}
__global__ void k_maskcheck(const u64* maskT, unsigned* cnt, int slot) {
    const int idx = blockIdx.x * blockDim.x + threadIdx.x; if (idx >= M) return; const int b = idx >> 12, t = idx & 4095; int pc = 0;
    for (int j = 0; j <= (t >> 6); ++j) pc += __popcll(maskT[((size_t)b * 64 + j) * SEQ + t]);
    const int want = (t + 1 < 256) ? t + 1 : 256;
    if (pc != want) atomicAdd(cnt + slot, 1u);
}
__global__ void k_emit(const float* x, const float* g, const unsigned* cnt, int nslots, float* out) {
    const int row = blockIdx.x, t = threadIdx.x; float v[4], ss = 0.f;
    for (int j = 0; j < 4; ++j) { v[j] = x[(size_t)row * D + t + 256 * j]; ss += v[j] * v[j]; }
    __shared__ float red[256]; red[t] = ss; __syncthreads();
    for (int o = 128; o > 0; o >>= 1) { if (t < o) red[t] += red[t + o]; __syncthreads(); }
    const float r = rsqrtf(red[0] / D + EPS); int code = 0;
    for (int s = nslots - 1; s >= 0; --s) if (cnt[s]) code = s + 1;
    for (int j = 0; j < 4; ++j) out[(size_t)row * D + t + 256 * j] = (1.f + code) * v[j] * r * g[t + 256 * j];
}
#endif

#ifdef MK_STAMP
__global__ void k_emit_ts(const float* x, const float* g, const unsigned long long* ts, float* out) {
    const int row = blockIdx.x, t = threadIdx.x; float v[4], ss = 0.f;
    for (int j = 0; j < 4; ++j) { v[j] = x[(size_t)row * D + t + 256 * j]; ss += v[j] * v[j]; }
    __shared__ float red[256]; red[t] = ss; __syncthreads();
    for (int o = 128; o > 0; o >>= 1) { if (t < o) red[t] += red[t + o]; __syncthreads(); }
    const float r = rsqrtf(red[0] / D + EPS);
    long long da = (long long)(ts[MK_STAMP_A] - ts[MK_STAMP_A - 1]) / 400, db = (long long)(ts[MK_STAMP_B] - ts[MK_STAMP_B - 1]) / 400;
    if (da < 0) da = 0; if (da > 98) da = 98; if (db < 0) db = 0; if (db > 89) db = 89;
    for (int j = 0; j < 4; ++j) out[(size_t)row * D + t + 256 * j] = (1.f + (float)da) * v[j] * r * g[t + 256 * j];
    __syncthreads();
    if (row == 0 && t == 0) out[0] = 1000.f + 100.f * (float)db;
}
#endif
extern "C" void kernel_launch(void* const* d_in, const int* in_sizes, int n_in, void* d_out, int out_size, void* d_ws, size_t ws_size, hipStream_t stream) {
    static int grid = 0;
    if (grid == 0) {
#ifdef MK_DRY
        if (ws_size < WS_END + 96 * MiB) { fprintf(stderr, "dry probe needs more ws\n"); grid = -1; return; }
#endif
        if (n_in != 22 || ws_size < WS_END) { fprintf(stderr, "kernel_launch: bad n_in %d / ws %zu (need %zu)\n", n_in, ws_size, (size_t)WS_END); grid = -1; return; }
        int dev = 0, cus = 0, per_cu = 0;
        if (hipGetDevice(&dev) != hipSuccess || hipDeviceGetAttribute(&cus, hipDeviceAttributeMultiprocessorCount, dev) != hipSuccess) { grid = -1; return; }
        if (hipFuncSetAttribute((const void*)mk_fwd, hipFuncAttributeMaxDynamicSharedMemorySize, LDS_BYTES) != hipSuccess) { fprintf(stderr, "kernel_launch: hipFuncSetAttribute failed\n"); grid = -1; return; }
        if (hipOccupancyMaxActiveBlocksPerMultiprocessor(&per_cu, (const void*)mk_fwd, NTHR, LDS_BYTES) != hipSuccess || per_cu < 1) fprintf(stderr, "kernel_launch: occupancy query says %d\n", per_cu);
        (void)hipGetLastError();
        grid = cus;
    }
    if (grid < 0) return;
    (void)hipMemsetAsync((char*)d_ws + WS_CTL, 0, CTL_ZERO_BYTES, stream);
    Args a{};
    for (int i = 0; i < 22; ++i) a.in[i] = (const float*)d_in[i];
    a.out = (float*)d_out; a.ws = (unsigned char*)d_ws; a.pad = MK_ONE_LAUNCH ? 0 : 1;
#ifdef MK_DIAG
    {
        unsigned* cnt = (unsigned*)((char*)d_ws + WS_CTL) + 200000;
        a.lay_lo = 0; a.lay_hi = 0; a.ph_lo = 0; a.ph_hi = 1;
        hipLaunchKernelGGL(mk_fwd, dim3(grid), dim3(NTHR), LDS_BYTES, stream, a);
        for (int p = 1; p <= MK_DIAG; ++p) { a.lay_lo = 0; a.lay_hi = 1; a.ph_lo = p; a.ph_hi = p + 1; hipLaunchKernelGGL(mk_fwd, dim3(grid), dim3(NTHR), LDS_BYTES, stream, a); }
        unsigned char* w = (unsigned char*)d_ws; int s = 0;
#define NF(off, n, f32) hipLaunchKernelGGL(k_nonfinite, dim3(1024), dim3(256), 0, stream, (const void*)(w + (off)), (size_t)(n), f32, cnt, s++)
        NF(WS_MOD, DEPTH * BATCH * 6 * D, 1);
        NF(WS_H, (size_t)M * D, 0);
        NF(WS_W + W_IN, (size_t)NP * D, 0);
        NF(WS_P + P_QA, (size_t)M * D * 3, 0);
        NF(WS_P + P_IQ, (size_t)M * 512, 0);
        NF(WS_P + P_IK, (size_t)M * 64, 0);
        NF(WS_P + P_IW, (size_t)M * 8, 1);
        NF(WS_P + P_BQ, (size_t)M * D * 4, 0);
        NF(WS_P + P_CQ, (size_t)M * D * 2, 0);
        NF(WS_P + P_CV, (size_t)M * 2048 * 2, 0);
        NF(WS_P + P_GA, (size_t)M * D * 3, 0);
        hipLaunchKernelGGL(k_maskcheck, dim3(M / 256), dim3(256), 0, stream, (const u64*)(w + WS_MASK), cnt, s++);
        NF(WS_HA, (size_t)2048 * 64 * 64, 0);
        NF(WS_HDEC, (size_t)2048 * 128, 1);
        NF(WS_RA, (size_t)512 * 128 * 128, 0);
        NF(WS_OA, (size_t)M * D, 0);
        NF(WS_OB, (size_t)M * D, 0);
        NF(WS_OC, (size_t)M * 2048, 0);
        NF(WS_MGB, (size_t)M * D, 0);
        NF(WS_X, (size_t)M * D, 1);
        hipLaunchKernelGGL(k_emit, dim3(M), dim3(256), 0, stream, (const float*)d_in[0], (const float*)d_in[21], cnt, s, (float*)d_out);
    }
#elif MK_ONE_LAUNCH
    a.lay_lo = 0; a.lay_hi = DEPTH; a.ph_lo = 0; a.ph_hi = NPHASE;
    hipLaunchKernelGGL(mk_fwd, dim3(grid), dim3(NTHR), LDS_BYTES, stream, a);
#ifdef MK_STAMP
    hipLaunchKernelGGL(k_emit_ts, dim3(M), dim3(256), 0, stream, (const float*)d_in[0], (const float*)d_in[21], (const unsigned long long*)((unsigned*)((char*)d_ws + WS_CTL) + 210000), (float*)d_out);
#endif
#else
#ifndef DBLH
#define DBLH 99
#endif
    a.lay_lo = 0; a.lay_hi = 0; a.ph_lo = 0; a.ph_hi = 1;
    for (int r = 0; r < (DBLH == 0 ? 2 : 1); ++r) hipLaunchKernelGGL(mk_fwd, dim3(grid), dim3(NTHR), LDS_BYTES, stream, a);
#ifndef DBLH
#define DBLH 0
#endif
#ifndef DRYV
#define DRYV 1
#endif
    for (int l = 0; l < DEPTH; ++l) for (int p = 1; p <= 11; ++p) { a.lay_lo = l; a.lay_hi = l + 1; a.ph_lo = p; a.ph_hi = p + 1; for (int r = 0; r < (p == DBLH ? 2 : 1); ++r) { a.dry = r ? DRYV : 0; hipLaunchKernelGGL(mk_fwd, dim3(grid), dim3(NTHR), LDS_BYTES, stream, a); } a.dry = 0;
    }
    a.lay_lo = DEPTH; a.lay_hi = DEPTH; a.ph_lo = 12; a.ph_hi = 13;
    hipLaunchKernelGGL(mk_fwd, dim3(grid), dim3(NTHR), LDS_BYTES, stream, a);
#endif
}
```

```cpp
#include <hip/hip_runtime.h>
#include <cstdio>
#include <cstdint>

constexpr int D = 1024, BATCH = 4, SEQ = 4096, DEPTH = 4, M = BATCH * SEQ;
constexpr int A_HEADS = 8, TOPK = 256;
constexpr int NE = 32, DEXP = 512;
constexpr int N_IN = 16968, NP = 17152;
constexpr float EPS = 1e-6f;
constexpr int O_AQ = 0, O_AK = 1024, O_AV = 2048, O_IQ = 3072, O_IK = 3584, O_IW = 3648, O_BQ = 3656, O_BF = 4680, O_BI = 5704, O_BG = 6728,
              O_CQ = 7752, O_CK = 8776, O_CV = 9800, O_CG = 11848, O_GA = 13896, O_GB = 14920, O_GC = 15944;

#define LAS __attribute__((address_space(3)))
#define GAS __attribute__((address_space(1)))
typedef unsigned short bf16_t;
typedef short bf16x8 __attribute__((ext_vector_type(8)));
typedef short s16x4 __attribute__((ext_vector_type(4)));
typedef float f32x4 __attribute__((ext_vector_type(4)));
typedef float f32x2 __attribute__((ext_vector_type(2)));
typedef unsigned u32x4 __attribute__((ext_vector_type(4)));
typedef unsigned u32x2 __attribute__((ext_vector_type(2)));
typedef unsigned long long u64;

constexpr size_t MiB = 1u << 20;
constexpr size_t WS_CTL = 0, CTL_ZERO_BYTES = 1 * MiB;
constexpr size_t WS_MOD = 1 * MiB;
constexpr size_t WS_LB = WS_MOD + 512 * 1024;
constexpr size_t WS_TB = WS_LB + 16 * 1024;
constexpr size_t WS_ROT = 2 * MiB;
constexpr size_t WS_RW = 6 * MiB;
constexpr size_t WS_X = 8 * MiB;
constexpr size_t WS_H = 72 * MiB;
constexpr size_t WS_W = 104 * MiB;
constexpr size_t W_IN = 0, W_BA = 34 * MiB, W_BB = 36 * MiB, W_BC = 38 * MiB, W_OUT = 42 * MiB, W_E1 = 44 * MiB, W_E2 = 108 * MiB;
constexpr size_t WS_P = 244 * MiB;
constexpr size_t P_QA = 0, P_KA = 32 * MiB, P_VA = 64 * MiB, P_IQ = 96 * MiB, P_IK = 112 * MiB, P_IW = 114 * MiB,
                 P_BQ = 116 * MiB, P_BG = 148 * MiB, P_BV = 180 * MiB, P_BO = 212 * MiB, P_CQ = 244 * MiB, P_CK = 276 * MiB,
                 P_CV = 308 * MiB, P_CG = 372 * MiB, P_GA = 436 * MiB, P_GB = 468 * MiB, P_GC = 500 * MiB;
constexpr size_t WS_MASK = 776 * MiB;
constexpr size_t WS_HA = 784 * MiB;
constexpr size_t WS_HDEC = 800 * MiB;
constexpr size_t WS_RA = 802 * MiB;
constexpr size_t WS_OA = 818 * MiB;
constexpr size_t WS_OB = 850 * MiB;
constexpr size_t WS_OC = 882 * MiB;
constexpr size_t WS_MG = 946 * MiB;
constexpr size_t WS_MGB = 1010 * MiB;
constexpr size_t WS_END = 1042 * MiB;
constexpr int XG_ROWS = 40960;
constexpr size_t WS_XG = WS_P, WS_ACT = WS_P + 80 * MiB, WS_YS = WS_P + 120 * MiB, WS_RINFO = WS_P + 184 * MiB, WS_TOK = WS_P + 186 * MiB, WS_T2E = WS_P + 190 * MiB;
constexpr int CW_BAR = 4096;
constexpr int CW_ECNT = 16384;
constexpr int CW_HIST = 32768;

typedef __bf16 bf16x2_n __attribute__((ext_vector_type(2)));
__device__ __forceinline__ unsigned cvt_pk_bf16(float lo, float hi) { const f32x2 v = {lo, hi}; const bf16x2_n r = __builtin_convertvector(v, bf16x2_n); return __builtin_bit_cast(unsigned, r); }
__device__ __forceinline__ float bf2f(unsigned short b) { return __uint_as_float(((unsigned)b) << 16); }
__device__ __forceinline__ float bflo(unsigned w) { return __uint_as_float(w << 16); }
__device__ __forceinline__ float bfhi(unsigned w) { return __uint_as_float(w & 0xffff0000u); }
__device__ __forceinline__ float sigmoid_f(float x) { return __builtin_amdgcn_rcpf(1.f + __expf(-x)); }
__device__ __forceinline__ float silu_f(float x) { return x * sigmoid_f(x); }
#define DPPF(v, ctrl) __int_as_float(__builtin_amdgcn_update_dpp(0, __float_as_int(v), (ctrl), 0xF, 0xF, true))
__device__ __forceinline__ float sum8(float v) { v += DPPF(v, 0xB1); v += DPPF(v, 0x4E); v += DPPF(v, 0x141); return v; }
__device__ __forceinline__ float sum16(float v) { v = sum8(v); v += DPPF(v, 0x140); return v; }
__device__ __forceinline__ float xadd16(float v) { auto r = __builtin_amdgcn_permlane16_swap(__float_as_uint(v), __float_as_uint(v), false, false); return __uint_as_float(r[0]) + __uint_as_float(r[1]); }
__device__ __forceinline__ float xadd32(float v) { auto r = __builtin_amdgcn_permlane32_swap(__float_as_uint(v), __float_as_uint(v), false, false); return __uint_as_float(r[0]) + __uint_as_float(r[1]); }
__device__ __forceinline__ float wave_sum(float v) { return xadd32(xadd16(sum16(v))); }
#define LDS_WAIT() asm volatile("s_waitcnt lgkmcnt(0)" ::: "memory")
#define VM_WAIT() asm volatile("s_waitcnt vmcnt(0)" ::: "memory")
constexpr int NWAVES = 8, NTHR = 512;
constexpr int RING_BYTES = 131072;
constexpr int MISC_OFF = 139264;
constexpr int LDS_BYTES = 147456;
struct Frame {
    LAS unsigned char* lds;
    volatile LAS unsigned* MISC;
    unsigned* ctl;
    unsigned char* ws;
    int tid, lane, wave, G, bid;
    float* out;
    __device__ __forceinline__ const float* in(int i) const { const LAS unsigned* p = (const LAS unsigned*)(lds + MISC_OFF + 512) + 2 * i;
        const unsigned lo = __builtin_amdgcn_readfirstlane(p[0]), hi = __builtin_amdgcn_readfirstlane(p[1]); return (const float*)(((u64)hi << 32) | lo); }
};
struct Args { const float* in[22]; float* out; unsigned char* ws; int lay_lo, lay_hi, ph_lo, ph_hi, dry, pad; };

__device__ __forceinline__ int t5_bucket(int rel) {
    if (rel < 16) return rel;
    int large = 16 + (int)(logf((float)rel / 16.f) / logf(8.f) * 16.f);
    return large < 31 ? large : 31;
}
__device__ __forceinline__ void ph_prologue(Frame& F) {
    const float* c = F.in(1); const float* rel_bias = F.in(2); const float* lb_raw = F.in(3); const float* ada_w = F.in(6); const float* ada_b = F.in(7);
    const float* rg_w = F.in(14); const float* re_w = F.in(16);
    float* mod = (float*)(F.ws + WS_MOD); float* lb = (float*)(F.ws + WS_LB); float* tb = (float*)(F.ws + WS_TB); float2* rot = (float2*)(F.ws + WS_ROT); bf16_t* rw = (bf16_t*)(F.ws + WS_RW);
    LAS float* sc = (LAS float*)F.lds;
    LAS float* red = (LAS float*)(F.lds + 16384);
    for (int i = F.tid; i < BATCH * D; i += NTHR) { const float v = c[i]; sc[i] = v / (1.f + __expf(-v)); }
    __syncthreads();
    for (int it = F.bid; it < DEPTH * 48; it += F.G) {
        const int l = it / 48, j0 = (it % 48) * 128, j4 = (F.tid & 31) * 4, kp = F.tid >> 5;
        const float* w = ada_w + (size_t)l * D * 6 * D + j0 + j4;
        f32x4 a0 = {0.f, 0.f, 0.f, 0.f}, a1 = a0, a2 = a0, a3 = a0;
#pragma unroll 16
        for (int k = kp * 64; k < kp * 64 + 64; ++k) { const f32x4 wv = *(const f32x4*)(w + (size_t)k * 6 * D); a0 += sc[k] * wv; a1 += sc[D + k] * wv; a2 += sc[2 * D + k] * wv; a3 += sc[3 * D + k] * wv; }
#pragma unroll
        for (int q = 0; q < 4; ++q) { LAS float* r = red + ((kp * 128 + j4 + q) * 4); r[0] = a0[q]; r[1] = a1[q]; r[2] = a2[q]; r[3] = a3[q]; }
        __syncthreads();
        { const int b = F.tid >> 7, jj = F.tid & 127;
          float s = 0.f;
#pragma unroll
          for (int p = 0; p < 16; ++p) s += red[(p * 128 + jj) * 4 + b];
          mod[((size_t)l * BATCH + b) * 6 * D + j0 + jj] = s + ada_b[l * 6 * D + j0 + jj]; }
        __syncthreads();
    }
    const int gt = F.bid * NTHR + F.tid, NT = F.G * NTHR;
    for (int d = gt; d < D; d += NT) {
        float v0 = lb_raw[d], v1 = lb_raw[D + d], v2 = lb_raw[2 * D + d], v3 = lb_raw[3 * D + d];
        const float mx = fmaxf(fmaxf(v0, v1), fmaxf(v2, v3));
        v0 = expf(v0 - mx); v1 = expf(v1 - mx); v2 = expf(v2 - mx); v3 = expf(v3 - mx);
        const float s = v0 + v1 + v2 + v3;
        lb[d] = 0.f; lb[D + d] = v1 / s; lb[2 * D + d] = (v1 + v2) / s; lb[3 * D + d] = (v1 + v2 + v3) / s;
    }
    { const double th = exp(-(double)(gt & 127) / 127.0 * 9.210340371976184);
      for (int idx = gt; idx < SEQ * 128; idx += NT) { const int t = idx >> 7;
          const double a = (double)t * th, k = rint(a * 0.15915494309189535), r = fma(-k, 6.283185307179586, a);
          const float rf = (float)r;
          rot[idx] = make_float2(cosf(rf), sinf(rf)); } }
    for (int idx = gt; idx < 8 * 128; idx += NT) { const int h = idx >> 7, rel = idx & 127;
        tb[idx] = (rel_bias[t5_bucket(rel) * A_HEADS + h] - rel_bias[31 * A_HEADS + h]) * 11.313708498984761f; }
    for (int idx = gt; idx < DEPTH * 48 * D; idx += NT) { const int l = idx / (48 * D), r = idx % (48 * D), n = r >> 10, k = r & 1023;
        float v = 0.f; if (n < 4) v = rg_w[((size_t)l * D + k) * 4 + n]; else if (n < 36) v = re_w[((size_t)l * D + k) * 32 + (n - 4)];
        rw[idx] = (bf16_t)(cvt_pk_bf16(v, 0.f) & 0xffffu); }
}

__device__ __forceinline__ void conv_tile(const float* W, int ldw, int nvalid, bf16_t* dst, int K, int k0, LAS float* scr, int lane) {
    const int nq = (lane & 15) * 4, kq = lane >> 4; const bool ok = nq < nvalid;
    f32x4 v[16];
#pragma unroll
    for (int i = 0; i < 16; ++i) v[i] = ok ? __builtin_nontemporal_load((const __attribute__((address_space(1))) f32x4*)(W + (size_t)(k0 + 4 * i + kq) * ldw + nq)) : (f32x4){0.f, 0.f, 0.f, 0.f};
#pragma unroll
    for (int i = 0; i < 16; ++i) { LAS float* p = scr + (4 * i + kq) * 65 + nq; p[0] = v[i][0]; p[1] = v[i][1]; p[2] = v[i][2]; p[3] = v[i][3]; }
    LDS_WAIT(); asm volatile("" ::: "memory");
    const int c = lane & 7;
#pragma unroll
    for (int j = 0; j < 8; ++j) { const int n = (lane >> 3) + 8 * j; const LAS float* s = scr + (8 * c) * 65 + n;
        u32x4 o; o.x = cvt_pk_bf16(s[0 * 65], s[1 * 65]); o.y = cvt_pk_bf16(s[2 * 65], s[3 * 65]); o.z = cvt_pk_bf16(s[4 * 65], s[5 * 65]); o.w = cvt_pk_bf16(s[6 * 65], s[7 * 65]);
        *(u32x4*)(dst + (size_t)n * K + k0 + 8 * c) = o; }
    LDS_WAIT(); asm volatile("" ::: "memory");
}
__device__ __forceinline__ void ph_conv(Frame& F, int l) {
    LAS float* scr = (LAS float*)(F.lds + F.wave * 16640);
    const int gw = F.bid * NWAVES + F.wave, NGW = F.G * NWAVES;
    unsigned char* wb = F.ws + WS_W;
    constexpr int I_IN = 268 * 16, I_B = 16 * 16, I_C = 16 * 32, I_E1 = 32 * 16 * 16, I_E2 = 32 * 16 * 8;
    constexpr int NITEMS = I_IN + 3 * I_B + I_C + I_E1 + I_E2;
    for (int it = gw; it < NITEMS; it += NGW) {
        int r = it;
        if (r < I_IN) { const int nb = r >> 4, kb = r & 15, n0 = nb * 64; int c0, nv;
            if (n0 + 64 <= 3656) { c0 = n0; nv = 64; } else if (n0 < 3656) { c0 = n0; nv = 3656 - n0; } else if (n0 < 3840) { c0 = 0; nv = 0; } else { c0 = n0 - 184; nv = 64; }
            conv_tile(F.in(8) + (size_t)l * D * N_IN + c0, N_IN, nv, (bf16_t*)(wb + W_IN) + (size_t)n0 * D, D, kb * 64, scr, F.lane); continue; }
        r -= I_IN;
        if (r < I_B) { conv_tile(F.in(10) + (size_t)l * 1024 * D + (r >> 4) * 64, D, 64, (bf16_t*)(wb + W_BA) + (size_t)(r >> 4) * 64 * 1024, 1024, (r & 15) * 64, scr, F.lane); continue; }
        r -= I_B;
        if (r < I_B) { conv_tile(F.in(11) + (size_t)l * 1024 * D + (r >> 4) * 64, D, 64, (bf16_t*)(wb + W_BB) + (size_t)(r >> 4) * 64 * 1024, 1024, (r & 15) * 64, scr, F.lane); continue; }
        r -= I_B;
        if (r < I_C) { const int nb = r >> 5, kb = r & 31;
            conv_tile(F.in(12) + ((size_t)l * 2048 + (kb >> 4) * 1024) * D + nb * 64, D, 64, (bf16_t*)(wb + W_BC + (size_t)(kb >> 4) * 2 * MiB) + (size_t)nb * 64 * 1024, 1024, (kb & 15) * 64, scr, F.lane); continue; }
        r -= I_C;
        if (r < I_B) { conv_tile(F.in(13) + (size_t)l * D * D + (r >> 4) * 64, D, 64, (bf16_t*)(wb + W_OUT) + (size_t)(r >> 4) * 64 * 1024, 1024, (r & 15) * 64, scr, F.lane); continue; }
        r -= I_B;
        if (r < I_E1) { const int e = r >> 8, q = r & 255, nb = q >> 4, kb = q & 15, n0 = nb * 64;
            const int pn = n0 >> 8, bj = (n0 >> 7) & 1, j0 = n0 & 127;
            const float* src = (bj ? F.in(19) : F.in(18)) + ((size_t)l * NE + e) * D * DEXP + 128 * pn + j0;
            conv_tile(src, DEXP, 64, (bf16_t*)(wb + W_E1) + ((size_t)e * 1024 + n0) * 1024, 1024, kb * 64, scr, F.lane); continue; }
        r -= I_E1;
        { const int e = r >> 7, q = r & 127, nb = q >> 3, kb = q & 7;
          conv_tile(F.in(20) + ((size_t)l * NE + e) * DEXP * D + nb * 64, D, 64, (bf16_t*)(wb + W_E2) + ((size_t)e * 1024 + nb * 64) * 512, 512, kb * 64, scr, F.lane); }
    }
}

__device__ __forceinline__ void ph_norm(Frame& F, const float* xs32, const bf16_t* xs16, const bf16_t* ys, const float* gt2, bf16_t* xd16, const float* g, const float* sc, const float* sh, bf16_t* hout, float* fout) {
    const int gw = F.bid * NWAVES + F.wave, NGW = F.G * NWAVES;
    f32x4 gv[4];
#pragma unroll
    for (int j = 0; j < 4; ++j) gv[j] = *(const f32x4*)(g + 4 * F.lane + 256 * j);
    for (int row0 = gw; row0 < M; row0 += 2 * NGW) {
        f32x4 v[2][4], scv[2][4], shv[2][4]; float ss[2] = {0.f, 0.f};
#pragma unroll
        for (int q = 0; q < 2; ++q) { const int row = row0 + q * NGW, b = row >> 12;
#pragma unroll
            for (int j = 0; j < 4; ++j) { const int c = 4 * F.lane + 256 * j;
                if (sc) { scv[q][j] = *(const f32x4*)(sc + b * 6 * D + c); shv[q][j] = *(const f32x4*)(sh + b * 6 * D + c); }
                if (xs32) v[q][j] = *(const f32x4*)(xs32 + (size_t)row * D + c);
                else { const u32x2 xw = *(const u32x2*)(xs16 + (size_t)row * D + c); v[q][j] = (f32x4){bflo(xw.x), bfhi(xw.x), bflo(xw.y), bfhi(xw.y)}; }
                if (ys) { const u32x2 y0 = *(const u32x2*)(ys + ((size_t)row * 2) * D + c), y1 = *(const u32x2*)(ys + ((size_t)row * 2 + 1) * D + c); const f32x4 gg = *(const f32x4*)(gt2 + b * 6 * D + c);
                    v[q][j][0] += gg[0] * (bflo(y0.x) + bflo(y1.x)); v[q][j][1] += gg[1] * (bfhi(y0.x) + bfhi(y1.x)); v[q][j][2] += gg[2] * (bflo(y0.y) + bflo(y1.y)); v[q][j][3] += gg[3] * (bfhi(y0.y) + bfhi(y1.y)); } } }
#pragma unroll
        for (int q = 0; q < 2; ++q)
#pragma unroll
            for (int j = 0; j < 4; ++j) ss[q] += (v[q][j][0] * v[q][j][0] + v[q][j][1] * v[q][j][1]) + (v[q][j][2] * v[q][j][2] + v[q][j][3] * v[q][j][3]);
#pragma unroll
        for (int q = 0; q < 2; ++q) { const int row = row0 + q * NGW;
            const float r = rsqrtf(wave_sum(ss[q]) * (1.f / D) + EPS);
#pragma unroll
            for (int j = 0; j < 4; ++j) { const int c = 4 * F.lane + 256 * j;
                if (xd16) { u32x2 xw; xw.x = cvt_pk_bf16(v[q][j][0], v[q][j][1]); xw.y = cvt_pk_bf16(v[q][j][2], v[q][j][3]); *(u32x2*)(xd16 + (size_t)row * D + c) = xw; }
                f32x4 o = v[q][j] * r * gv[j];
                if (sc) o = o * (1.f + scv[q][j]) + shv[q][j];
                if (hout) { u32x2 w; w.x = cvt_pk_bf16(o[0], o[1]); w.y = cvt_pk_bf16(o[2], o[3]); *(u32x2*)(hout + (size_t)row * D + c) = w; }
                else *(f32x4*)(fout + (size_t)row * D + c) = o; } }
    }
}
namespace pg8 {
#define PG8_LAS __attribute__((address_space(3)))
typedef unsigned short bf16_t;
typedef short bf16x8 __attribute__((ext_vector_type(8)));
typedef float f32x4 __attribute__((ext_vector_type(4)));
typedef unsigned u32x4 __attribute__((ext_vector_type(4)));
constexpr int BM = 256, BK = 64, HALF = 128, HTB = HALF * BK * 2  , STAGE_BYTES = 8 * HTB, NXCD = 8, WGM = 8;

__host__ __device__ __forceinline__ int lds_byte(int r, int c) { const int st = (r >> 4) * 2 + (c >> 5), rr = r & 15, cc = c & 31, ob = rr * 64 + cc * 2; return st * 1024 + (ob ^ (((ob >> 9) & 1) << 5)); }
__host__ __device__ __forceinline__ void stage_rc(int b, int& R, int& C) { const int st = b / 1024, sb = b % 1024, swz = sb ^ (((sb >> 9) & 1) << 5); R = (st >> 1) * 16 + swz / 64; C = (st & 1) * 32 + (swz % 64) / 2; }
__host__ __device__ __forceinline__ int perm32(int rho) { const int n = rho >> 4, i = rho & 15; return 8 * (i >> 2) + 4 * n + (i & 3); }

struct Unit { int pm, pn; };
struct Gemm { const bf16_t* A; const bf16_t* Bt; int M, N, K; };

struct StaticOrder {
    static constexpr bool GATHER = false;
    int nM, nN, nwg, G, c;
    __host__ __device__ void init(int M, int N, int G_, int c_) { nM = M / BM; nN = N / BM; nwg = nM * nN; G = G_; c = c_; }
    __host__ __device__ bool next(int i, Unit& u) const {
        const long L = (long)i * G + c; if (L >= nwg) return false;
        int wgid = (int)L; { const int q = nwg / NXCD, r = nwg % NXCD, xcd = wgid % NXCD, off = wgid / NXCD; wgid = (xcd < r ? xcd * (q + 1) : r * (q + 1) + (xcd - r) * q) + off; }
        const int nig = WGM * nN, gid = wgid / nig, fm = gid * WGM, gsz = (nM - fm) < WGM ? (nM - fm) : WGM;
        u.pm = fm + ((wgid % nig) % gsz); u.pn = (wgid % nig) / gsz; return true;
    }
    __device__ __forceinline__ void a_ready(const Unit&) const {}
    __device__ __forceinline__ void done(const Unit&) const {}
};


__device__ __forceinline__ void st8(bf16_t* p, const float* x) { u32x4 w; w.x = cvt_pk_bf16(x[0], x[1]); w.y = cvt_pk_bf16(x[2], x[3]); w.z = cvt_pk_bf16(x[4], x[5]); w.w = cvt_pk_bf16(x[6], x[7]); *(u32x4*)p = w; }
enum { K_PLAIN = 0, K_LOGF = 1, K_SILU = 2, K_SIGM = 3, K_ROTQ = 4, K_ROTK = 5, K_IDX = 6 };
struct EpiProj {
    static constexpr bool PERM = true, AFTER_DRAIN = false, CHAIN = false;
    unsigned char* pb;
    const float* lb;
    const float2* rot;
    __device__ __forceinline__ void operator()(const f32x4 (&acc)[2][2][4][2], const Unit& u, int wr, int wc, int fr, int fq) const {
        const int pn = u.pn; size_t off; int ld, cb, kind, hd = 0;
        if (pn < 12) { off = P_QA + (size_t)(pn >> 2) * 32 * MiB; ld = 1024; cb = (pn & 3) * 256; kind = K_PLAIN; }
        else if (pn < 14) { off = P_IQ; ld = 512; cb = (pn - 12) * 256; kind = K_PLAIN; }
        else if (pn == 14) { off = P_IK; ld = 64; cb = 0; kind = K_IDX; }
        else if (pn < 31) { const int q = pn - 15, t = q >> 2; off = P_BQ + (size_t)t * 32 * MiB; ld = 1024; cb = (q & 3) * 256; kind = (t == 1) ? K_LOGF : (t == 3) ? K_SILU : K_PLAIN; }
        else if (pn < 39) { const int q = pn - 31, t = q >> 2; off = P_CQ + (size_t)t * 32 * MiB; ld = 1024; cb = (q & 3) * 256; kind = t ? K_ROTK : K_ROTQ; hd = q & 3; }
        else if (pn < 55) { const int q = pn - 39, t = q >> 3; off = P_CV + (size_t)t * 64 * MiB; ld = 2048; cb = (q & 7) * 256; kind = t ? K_SILU : K_PLAIN; }
        else { const int q = pn - 55, t = q >> 2; off = P_GA + (size_t)t * 32 * MiB; ld = 1024; cb = (q & 3) * 256; kind = K_SIGM; }
        bf16_t* base = (bf16_t*)(pb + off);
        const int row0 = u.pm * BM + wr * 64 + fr, cl0 = wc * 32 + 8 * fq;
        if (kind == K_IDX) {
            float* iw = (float*)(pb + P_IW);
#pragma unroll
            for (int ai = 0; ai < 2; ++ai)
#pragma unroll
                for (int m = 0; m < 4; ++m) { const int row = row0 + ai * HALF + m * 16;
                    if (cl0 < 64) { float x[8] = {acc[ai][0][m][0][0], acc[ai][0][m][0][1], acc[ai][0][m][0][2], acc[ai][0][m][0][3], acc[ai][0][m][1][0], acc[ai][0][m][1][1], acc[ai][0][m][1][2], acc[ai][0][m][1][3]};
                        st8(base + (size_t)row * 64 + cl0, x); }
                    else if (cl0 == 64) { *(f32x4*)(iw + (size_t)row * 8) = acc[ai][0][m][0]; *(f32x4*)(iw + (size_t)row * 8 + 4) = acc[ai][0][m][1]; } }
            return;
        }
        switch (kind) {
            case K_LOGF: body<K_LOGF>(acc, base, row0, ld, cb, cl0, hd); break;
            case K_SILU: body<K_SILU>(acc, base, row0, ld, cb, cl0, hd); break;
            case K_SIGM: body<K_SIGM>(acc, base, row0, ld, cb, cl0, hd); break;
            case K_ROTQ: body<K_ROTQ>(acc, base, row0, ld, cb, cl0, hd); break;
            case K_ROTK: body<K_ROTK>(acc, base, row0, ld, cb, cl0, hd); break;
            default:     body<K_PLAIN>(acc, base, row0, ld, cb, cl0, hd); break;
        }
    }
    template <int KIND>
    __device__ __forceinline__ void body(const f32x4 (&acc)[2][2][4][2], bf16_t* base, int row0, int ld, int cb, int cl0, int hd) const {
        const float l2g = __log2f(1.f - exp2f(-5.f - (float)hd));
        float lv[2][8];
        if constexpr (KIND == K_LOGF) {
#pragma unroll
            for (int bj = 0; bj < 2; ++bj) { const f32x4 l0 = *(const f32x4*)(lb + cb + bj * HALF + cl0), l1 = *(const f32x4*)(lb + cb + bj * HALF + cl0 + 4);
                lv[bj][0] = l0[0]; lv[bj][1] = l0[1]; lv[bj][2] = l0[2]; lv[bj][3] = l0[3]; lv[bj][4] = l1[0]; lv[bj][5] = l1[1]; lv[bj][6] = l1[2]; lv[bj][7] = l1[3]; } }
#pragma unroll
        for (int ai = 0; ai < 2; ++ai)
#pragma unroll
            for (int m = 0; m < 4; ++m) { const int row = row0 + ai * HALF + m * 16; bf16_t* rowp = base + (size_t)row * ld + cb + cl0;
                f32x4 rr[2][2];
                if constexpr (KIND == K_ROTQ || KIND == K_ROTK) { const int pos = row & (SEQ - 1);
#pragma unroll
                    for (int bj = 0; bj < 2; ++bj) { const int i0 = (bj * HALF + cl0) >> 1; rr[bj][0] = *(const f32x4*)(rot + (size_t)pos * 128 + i0); rr[bj][1] = *(const f32x4*)(rot + (size_t)pos * 128 + i0 + 2); } }
#pragma unroll
                for (int bj = 0; bj < 2; ++bj) {
                    float x[8] = {acc[ai][bj][m][0][0], acc[ai][bj][m][0][1], acc[ai][bj][m][0][2], acc[ai][bj][m][0][3], acc[ai][bj][m][1][0], acc[ai][bj][m][1][1], acc[ai][bj][m][1][2], acc[ai][bj][m][1][3]};
                    if constexpr (KIND == K_LOGF) {
#pragma unroll
                        for (int j = 0; j < 8; ++j) x[j] = fmaxf(__logf(lv[bj][j] + (1.f - lv[bj][j]) * sigmoid_f(x[j])), -60.f); }
                    else if constexpr (KIND == K_SILU) {
#pragma unroll
                        for (int j = 0; j < 8; ++j) x[j] = silu_f(x[j]); }
                    else if constexpr (KIND == K_SIGM) {
#pragma unroll
                        for (int j = 0; j < 8; ++j) x[j] = sigmoid_f(x[j]); }
                    else if constexpr (KIND == K_ROTQ || KIND == K_ROTK) {
                        const int pos = row & (SEQ - 1), e = pos & 127;
                        const f32x4 r0 = rr[bj][0], r1 = rr[bj][1];
                        const float s = (KIND == K_ROTQ) ? exp2f((float)(e + 1) * l2g) : 0.0625f * exp2f((float)(127 - e) * l2g);
                        const float cs[8] = {r0[0], r0[1], r0[2], r0[3], r1[0], r1[1], r1[2], r1[3]};
#pragma unroll
                        for (int j = 0; j < 4; ++j) { const float a = x[2 * j], b = x[2 * j + 1], c = cs[2 * j], sn = cs[2 * j + 1]; x[2 * j] = (a * c - b * sn) * s; x[2 * j + 1] = (b * c + a * sn) * s; } }
                    st8(rowp + bj * HALF, x); } }
    }
};
template <int STEP> struct EpiMerge {
    static constexpr bool PERM = false, AFTER_DRAIN = false, CHAIN = false;
    const bf16_t* gate; float* mg; bf16_t* mgb;
    __device__ __forceinline__ void operator()(const f32x4 (&acc)[2][2][4][2], const Unit& u, int wr, int wc, int fr, int fq) const {
        const int row0 = u.pm * BM + wr * 64 + fr, col0 = u.pn * BM + wc * 32 + 4 * fq;
#pragma unroll
        for (int ai = 0; ai < 2; ++ai)
#pragma unroll
            for (int m = 0; m < 4; ++m) { const size_t ro = (size_t)(row0 + ai * HALF + m * 16) * 1024 + col0;
#pragma unroll
                for (int bj = 0; bj < 2; ++bj)
#pragma unroll
                    for (int n = 0; n < 2; ++n) { const size_t o = ro + bj * HALF + n * 16; const u32x2 gw = *(const u32x2*)(gate + o);
                        f32x4 v = acc[ai][bj][m][n] * (f32x4){bflo(gw.x), bfhi(gw.x), bflo(gw.y), bfhi(gw.y)};
                        if (STEP > 0) v += *(const f32x4*)(mg + o);
                        if (STEP < 2) *(f32x4*)(mg + o) = v;
                        else { u32x2 w; w.x = cvt_pk_bf16(v[0], v[1]); w.y = cvt_pk_bf16(v[2], v[3]); *(u32x2*)(mgb + o) = w; } } }
    }
};
struct SegOrder {
    static constexpr bool GATHER = false;
    int pm0, pn0;
    __device__ __forceinline__ bool next(int i, Unit& u) const { if (i >= 4) return false; u.pm = i * 64 + pm0; u.pn = i * 4 + pn0; return true; }
    __device__ __forceinline__ void a_ready(const Unit&) const {}
    __device__ __forceinline__ void done(const Unit&) const {}
};
struct EpiMerge4 {
    static constexpr bool PERM = false, AFTER_DRAIN = false, CHAIN = true;
    const bf16_t* gate0; bf16_t* mgb;
    __device__ __forceinline__ void operator()(const f32x4 (&)[2][2][4][2], const Unit&, int, int, int, int) const {}
    __device__ __forceinline__ bool chain(f32x4 (&acc)[2][2][4][2], const Unit& u, int wr, int wc, int fr, int fq) const {
        const int seg = u.pm >> 6, pm = u.pm & 63, pn = u.pn & 3;
        if (seg == 2) return true;
        const bf16_t* gn = gate0 + (size_t)seg * (16 * MiB);
        const int row0 = pm * BM + wr * 64 + fr, col0 = pn * BM + wc * 32 + 4 * fq;
#pragma unroll
        for (int ai = 0; ai < 2; ++ai)
#pragma unroll
            for (int m = 0; m < 4; ++m) { const size_t ro = (size_t)(row0 + ai * HALF + m * 16) * 1024 + col0;
#pragma unroll
                for (int bj = 0; bj < 2; ++bj)
#pragma unroll
                    for (int n = 0; n < 2; ++n) { const size_t o = ro + bj * HALF + n * 16;
                        if (seg < 2) { const u32x2 a = *(const u32x2*)(gn + o), d = *(const u32x2*)(gn + (size_t)16 * MiB + o);
                            const float GMIN = 9.094947e-13f;
                            const f32x4 r = {fmaxf(bflo(a.x), GMIN) * __builtin_amdgcn_rcpf(fmaxf(bflo(d.x), GMIN)), fmaxf(bfhi(a.x), GMIN) * __builtin_amdgcn_rcpf(fmaxf(bfhi(d.x), GMIN)),
                                             fmaxf(bflo(a.y), GMIN) * __builtin_amdgcn_rcpf(fmaxf(bflo(d.y), GMIN)), fmaxf(bfhi(a.y), GMIN) * __builtin_amdgcn_rcpf(fmaxf(bfhi(d.y), GMIN))};
                            acc[ai][bj][m][n] *= r; }
                        else { const u32x2 a = *(const u32x2*)(gate0 + (size_t)32 * MiB + o);
                            const float GMIN = 9.094947e-13f;
                            const f32x4 v = acc[ai][bj][m][n] * (f32x4){fmaxf(bflo(a.x), GMIN), fmaxf(bfhi(a.x), GMIN), fmaxf(bflo(a.y), GMIN), fmaxf(bfhi(a.y), GMIN)};
                            u32x2 w; w.x = cvt_pk_bf16(v[0], v[1]); w.y = cvt_pk_bf16(v[2], v[3]); *(u32x2*)(mgb + o) = w; } } }
        return seg < 3;
    }
};
struct EpiRes {
    static constexpr bool PERM = false, AFTER_DRAIN = false, CHAIN = false;
    const float* xs32; const bf16_t* xs16; bf16_t* xd; const float* gt;
    __device__ __forceinline__ void operator()(const f32x4 (&acc)[2][2][4][2], const Unit& u, int wr, int wc, int fr, int fq) const {
        const int row0 = u.pm * BM + wr * 64 + fr, col0 = u.pn * BM + wc * 32 + 4 * fq; const int b = (u.pm * BM) >> 12;
#pragma unroll
        for (int ai = 0; ai < 2; ++ai)
#pragma unroll
            for (int m = 0; m < 4; ++m) { const size_t ro = (size_t)(row0 + ai * HALF + m * 16) * 1024 + col0;
#pragma unroll
                for (int bj = 0; bj < 2; ++bj)
#pragma unroll
                    for (int n = 0; n < 2; ++n) { const size_t o = ro + bj * HALF + n * 16; const f32x4 g = *(const f32x4*)(gt + b * 6 * D + col0 + bj * HALF + n * 16);
                        f32x4 x;
                        if (xs32) x = *(const f32x4*)(xs32 + o); else { const u32x2 xw = *(const u32x2*)(xs16 + o); x = (f32x4){bflo(xw.x), bfhi(xw.x), bflo(xw.y), bfhi(xw.y)}; }
                        x += g * acc[ai][bj][m][n];
                        u32x2 w; w.x = cvt_pk_bf16(x[0], x[1]); w.y = cvt_pk_bf16(x[2], x[3]); *(u32x2*)(xd + o) = w; } }
    }
};
struct EpiExpUp {
    static constexpr bool PERM = true, AFTER_DRAIN = false, CHAIN = false;
    bf16_t* act;
    __device__ __forceinline__ void operator()(const f32x4 (&acc)[2][2][4][2], const Unit& u, int wr, int wc, int fr, int fq) const {
        const int row0 = u.pm * BM + wr * 64 + fr, col0 = (u.pn & 3) * 128 + wc * 32 + 8 * fq;
#pragma unroll
        for (int ai = 0; ai < 2; ++ai)
#pragma unroll
            for (int m = 0; m < 4; ++m) { float x[8];
#pragma unroll
                for (int n = 0; n < 2; ++n)
#pragma unroll
                    for (int i = 0; i < 4; ++i) x[4 * n + i] = silu_f(acc[ai][0][m][n][i]) * acc[ai][1][m][n][i];
                st8(act + (size_t)(row0 + ai * HALF + m * 16) * DEXP + col0, x); }
    }
};
struct EpiExpDown {
    static constexpr bool PERM = true, AFTER_DRAIN = false, CHAIN = false;
    const int2* rinfo; bf16_t* ys;
    __device__ __forceinline__ void operator()(const f32x4 (&acc)[2][2][4][2], const Unit& u, int wr, int wc, int fr, int fq) const {
        const int row0 = u.pm * BM + wr * 64 + fr, col0 = (u.pn & 3) * 256 + wc * 32 + 8 * fq;
#pragma unroll
        for (int ai = 0; ai < 2; ++ai)
#pragma unroll
            for (int m = 0; m < 4; ++m) { const int2 ri = rinfo[row0 + ai * HALF + m * 16];
                if (ri.x >= 0) { const float w = __int_as_float(ri.y);
#pragma unroll
                    for (int bj = 0; bj < 2; ++bj) { float x[8];
#pragma unroll
                        for (int n = 0; n < 2; ++n)
#pragma unroll
                            for (int i = 0; i < 4; ++i) x[4 * n + i] = w * acc[ai][bj][m][n][i];
                        st8(ys + (size_t)ri.x * D + col0 + bj * HALF, x); } } }
    }
};
struct ListOrder {
    static constexpr bool GATHER = false;
    const LAS int* tab; int n;
    __device__ __forceinline__ bool next(int i, Unit& u) const { if (i >= n) return false; const int v = tab[i]; u.pm = v >> 8; u.pn = v & 255; return true; }
    __device__ __forceinline__ void a_ready(const Unit&) const {}
    __device__ __forceinline__ void done(const Unit&) const {}
};

struct GatherOrder {
    static constexpr bool GATHER = true;
    const LAS int* tab; int n; const LAS unsigned* rows;
    __device__ __forceinline__ bool next(int i, Unit& u) const { if (i >= n) return false; const int v = tab[i]; u.pm = v >> 8; u.pn = v & 255; return true; }
    __device__ __forceinline__ void a_ready(const Unit&) const {}
    __device__ __forceinline__ void done(const Unit&) const {}
};

template <class Epi, class Sched, bool ALIGN_EPI = false, bool SP2 = false>
__device__ __forceinline__ void gemm_phase(PG8_LAS unsigned char* lds, const Gemm g, const Sched& S, const Epi& E) {
    int tid_ = threadIdx.x; asm volatile("" : "+v"(tid_));
    const int tid = tid_, wid = __builtin_amdgcn_readfirstlane(tid >> 6), lane = tid & 63, wr = wid >> 2, wc = wid & 3, fr = lane & 15, fq = lane >> 4;
    const int K = g.K, nt = K / BK;
    constexpr bool GA = Sched::GATHER; static_assert(!GA || SP2, "gathered A rows: SP2 loop only");
    unsigned voffA[2], voffB[2]; int gaR[2];
#pragma unroll
    for (int i = 0; i < 2; ++i) { int R, C; stage_rc(tid * 16 + i * 8192, R, C); const int Rb = Epi::PERM ? ((R & ~31) + perm32(R & 31)) : R;
        voffA[i] = GA ? (unsigned)C * 2u : (unsigned)(R * K + C) * 2u; voffB[i] = (unsigned)(Rb * K + C) * 2u; gaR[i] = R; }
    unsigned cv0[2], cv1[2], nv0[2], nv1[2];
#define PG8_GAV(d0, d1, u) do { if constexpr (GA) { _Pragma("unroll") for (int _i = 0; _i < 2; ++_i) { d0[_i] = S.rows[(u) * 256 + gaR[_i]] + voffA[_i]; d1[_i] = S.rows[(u) * 256 + 128 + gaR[_i]] + voffA[_i]; } } \
        else { _Pragma("unroll") for (int _i = 0; _i < 2; ++_i) { d0[_i] = voffA[_i]; d1[_i] = voffA[_i]; } } } while (0)
    const size_t kstep = (size_t)(BK * 2);
    const size_t hstep = (size_t)HALF * K * 2;
    const size_t hstA = GA ? (size_t)0 : hstep;
    const size_t tstep = 2 * hstep;
    const unsigned ldsw = (unsigned)wid * 1024u;
    const int aoff = lds_byte(wr * 64 + fr, fq * 8), boff = lds_byte(wc * 32 + fr, fq * 8);
#define PG8_SA(b, h) (((b) * 2 + (h)) * HTB)
#define PG8_SB(b, h) ((4 + (b) * 2 + (h)) * HTB)
#define PG8_STAGE(bufoff, gbase, voff) do { _Pragma("unroll") for (int _i = 0; _i < 2; ++_i) \
        __builtin_amdgcn_global_load_lds((const unsigned*)((const char*)(gbase) + (voff)[_i]), (PG8_LAS unsigned*)(lds + (bufoff) + ldsw + _i * 8192), 16, 0, 0); } while (0)
#define PG8_LDA(dst, b, h) do { _Pragma("unroll") for (int m = 0; m < 4; ++m) _Pragma("unroll") for (int k = 0; k < 2; ++k) dst[m][k] = *(const PG8_LAS bf16x8*)(lds + PG8_SA(b, h) + aoff + m * 2048 + k * 1024); } while (0)
#define PG8_LDB(dst, b, h) do { _Pragma("unroll") for (int n = 0; n < 2; ++n) _Pragma("unroll") for (int k = 0; k < 2; ++k) dst[n][k] = *(const PG8_LAS bf16x8*)(lds + PG8_SB(b, h) + boff + n * 2048 + k * 1024); } while (0)
#define PG8_MMA(ai, bj, At, Bt) do { __builtin_amdgcn_s_setprio(1); _Pragma("unroll") for (int m = 0; m < 4; ++m) _Pragma("unroll") for (int n = 0; n < 2; ++n) _Pragma("unroll") for (int k = 0; k < 2; ++k) \
        acc[ai][bj][m][n] = __builtin_amdgcn_mfma_f32_16x16x32_bf16(Bt[n][k], At[m][k], acc[ai][bj][m][n], 0, 0, 0); __builtin_amdgcn_s_setprio(0); } while (0)
#define PG8_WAIT_V(n) asm volatile("s_waitcnt vmcnt(" #n ")" ::: "memory")
#define PG8_WAIT_L(n) asm volatile("s_waitcnt lgkmcnt(" #n ")" ::: "memory")
#define PG8_BAR __builtin_amdgcn_s_barrier()
#define PG8_SCHED __builtin_amdgcn_sched_barrier(0)
    Unit cur, nxt; int ui = 0;
    if (!S.next(0, cur)) return;
    f32x4 acc[2][2][4][2];
#pragma unroll
    for (int a = 0; a < 2; ++a)
#pragma unroll
        for (int b = 0; b < 2; ++b)
#pragma unroll
            for (int m = 0; m < 4; ++m)
#pragma unroll
                for (int n = 0; n < 2; ++n) acc[a][b][m][n] = (f32x4){0.f, 0.f, 0.f, 0.f};
    bf16x8 At[4][2], B0[2][2], B1[2][2];
    const char* cA = (const char*)g.A + (GA ? (size_t)0 : (size_t)cur.pm * tstep); const char* cB = (const char*)g.Bt + (size_t)cur.pn * tstep;
    S.a_ready(cur);
    PG8_GAV(cv0, cv1, 0);
    if constexpr (SP2) {
        PG8_STAGE(PG8_SB(0, 0), cB, voffB); PG8_STAGE(PG8_SB(0, 1), cB + hstep, voffB); PG8_STAGE(PG8_SA(0, 0), cA, cv0); PG8_STAGE(PG8_SA(0, 1), cA + hstA, cv1);
        if (wr == 1) PG8_BAR;
        PG8_WAIT_V(2); PG8_BAR;
        PG8_STAGE(PG8_SB(1, 0), cB + kstep, voffB); PG8_STAGE(PG8_SA(1, 0), cA + kstep, cv0); PG8_STAGE(PG8_SB(1, 1), cB + hstep + kstep, voffB);
        PG8_WAIT_V(6); PG8_BAR;
    } else {
        PG8_STAGE(PG8_SB(0, 0), cB, voffB); PG8_STAGE(PG8_SA(0, 0), cA, voffA); PG8_STAGE(PG8_SB(0, 1), cB + hstep, voffB); PG8_STAGE(PG8_SA(0, 1), cA + hstep, voffA);
        if (wr == 1) PG8_BAR;
        PG8_WAIT_V(4); PG8_BAR;
        PG8_STAGE(PG8_SB(1, 0), cB + kstep, voffB); PG8_STAGE(PG8_SA(1, 0), cA + kstep, voffA); PG8_STAGE(PG8_SB(1, 1), cB + hstep + kstep, voffB);
        PG8_WAIT_V(6); PG8_BAR;
    }
    for (;;) {
        const bool has_next = S.next(ui + 1, nxt);
        const char* nA = (has_next && !GA) ? (const char*)g.A + (size_t)nxt.pm * tstep : cA; const char* nB = has_next ? (const char*)g.Bt + (size_t)nxt.pn * tstep : cB;
        if constexpr (GA) { if (has_next) PG8_GAV(nv0, nv1, ui + 1); else { nv0[0] = cv0[0]; nv0[1] = cv0[1]; nv1[0] = cv1[0]; nv1[1] = cv1[1]; } }
        for (int t = 0; t < nt; t += 2) {
            const bool last = (t == nt - 2);
            const char* a1 = cA + (size_t)(t + 1) * kstep;
            const char* a2 = last ? nA : cA + (size_t)(t + 2) * kstep; const char* b2 = last ? nB : cB + (size_t)(t + 2) * kstep;
            const char* a3 = a2 + kstep; const char* b3 = b2 + kstep;
            if (last && has_next) S.a_ready(nxt);
            if constexpr (SP2) {
            unsigned s0[2], s1[2];
            if constexpr (GA) { s0[0] = last ? nv0[0] : cv0[0]; s0[1] = last ? nv0[1] : cv0[1]; s1[0] = last ? nv1[0] : cv1[0]; s1[1] = last ? nv1[1] : cv1[1]; }
            else { s0[0] = voffA[0]; s0[1] = voffA[1]; s1[0] = voffA[0]; s1[1] = voffA[1]; }
            PG8_LDB(B0, 0, 0); PG8_LDB(B1, 0, 1); PG8_SCHED; PG8_LDA(At, 0, 0); PG8_STAGE(PG8_SA(1, 1), a1 + hstA, cv1);
            PG8_WAIT_V(8); PG8_WAIT_L(0); PG8_BAR; PG8_MMA(0, 0, At, B0); PG8_MMA(0, 1, At, B1); PG8_BAR; PG8_SCHED;
            PG8_LDA(At, 0, 1); PG8_STAGE(PG8_SB(0, 0), b2, voffB); PG8_STAGE(PG8_SB(0, 1), b2 + hstep, voffB); PG8_STAGE(PG8_SA(0, 0), a2, s0);
            PG8_WAIT_V(8); PG8_WAIT_L(0); PG8_BAR; PG8_MMA(1, 0, At, B0); PG8_MMA(1, 1, At, B1); PG8_BAR; PG8_SCHED;
            PG8_LDB(B0, 1, 0); PG8_LDB(B1, 1, 1); PG8_SCHED; PG8_LDA(At, 1, 0); PG8_STAGE(PG8_SA(0, 1), a2 + hstA, s1);
            PG8_WAIT_V(8); PG8_WAIT_L(0); PG8_BAR; PG8_MMA(0, 0, At, B0); PG8_MMA(0, 1, At, B1); PG8_BAR; PG8_SCHED;
            PG8_LDA(At, 1, 1); PG8_STAGE(PG8_SB(1, 0), b3, voffB); PG8_STAGE(PG8_SB(1, 1), b3 + hstep, voffB); PG8_STAGE(PG8_SA(1, 0), a3, s0);
            PG8_WAIT_V(8); PG8_WAIT_L(0); PG8_BAR; PG8_MMA(1, 0, At, B0); PG8_MMA(1, 1, At, B1); PG8_BAR; PG8_SCHED;
            } else {
            PG8_LDB(B0, 0, 0); PG8_SCHED; PG8_LDA(At, 0, 0); PG8_STAGE(PG8_SA(1, 1), a1 + hstep, voffA);
            PG8_WAIT_L(8); PG8_BAR; PG8_WAIT_L(0); PG8_MMA(0, 0, At, B0); PG8_BAR; PG8_SCHED;
            PG8_LDB(B1, 0, 1); PG8_STAGE(PG8_SB(0, 0), b2, voffB);
            PG8_BAR; PG8_WAIT_L(0); PG8_MMA(0, 1, At, B1); PG8_BAR;
            PG8_LDA(At, 0, 1); PG8_STAGE(PG8_SA(0, 0), a2, voffA);
            PG8_BAR; PG8_WAIT_L(0); PG8_MMA(1, 0, At, B0); PG8_BAR; PG8_SCHED;
            PG8_STAGE(PG8_SB(0, 1), b2 + hstep, voffB);
            PG8_WAIT_V(6); PG8_BAR; PG8_MMA(1, 1, At, B1); PG8_BAR;
            PG8_LDB(B0, 1, 0); PG8_SCHED; PG8_LDA(At, 1, 0); PG8_STAGE(PG8_SA(0, 1), a2 + hstep, voffA);
            PG8_WAIT_L(8); PG8_BAR; PG8_WAIT_L(0); PG8_MMA(0, 0, At, B0); PG8_BAR; PG8_SCHED;
            PG8_LDB(B1, 1, 1); PG8_STAGE(PG8_SB(1, 0), b3, voffB);
            PG8_BAR; PG8_WAIT_L(0); PG8_MMA(0, 1, At, B1); PG8_BAR;
            PG8_LDA(At, 1, 1); PG8_STAGE(PG8_SA(1, 0), a3, voffA);
            PG8_BAR; PG8_WAIT_L(0); PG8_MMA(1, 0, At, B0); PG8_BAR; PG8_SCHED;
            PG8_STAGE(PG8_SB(1, 1), b3 + hstep, voffB);
            PG8_WAIT_V(6); PG8_BAR; PG8_MMA(1, 1, At, B1); PG8_BAR;
            }
        }
        if constexpr (ALIGN_EPI) { if (wr == 0) PG8_BAR; }
        bool keep_acc = false;
        if constexpr (Epi::CHAIN) { keep_acc = E.chain(acc, cur, wr, wc, fr, fq); S.done(cur); }
        else if constexpr (!Epi::AFTER_DRAIN) { E(acc, cur, wr, wc, fr, fq); S.done(cur); }
        if (!has_next) break;
        if (!keep_acc) {
#pragma unroll
        for (int a = 0; a < 2; ++a)
#pragma unroll
            for (int b = 0; b < 2; ++b)
#pragma unroll
                for (int m = 0; m < 4; ++m)
#pragma unroll
                    for (int n = 0; n < 2; ++n) acc[a][b][m][n] = (f32x4){0.f, 0.f, 0.f, 0.f};
        }
        cur = nxt; cA = nA; cB = nB; ++ui;
        if constexpr (GA) { cv0[0] = nv0[0]; cv0[1] = nv0[1]; cv1[0] = nv1[0]; cv1[1] = nv1[1]; }
        if constexpr (ALIGN_EPI) { if (wr == 1) PG8_BAR; }
    }
    PG8_WAIT_V(0);
    if constexpr (!ALIGN_EPI) { if (wr == 0) PG8_BAR; }
    PG8_BAR;
    if constexpr (Epi::AFTER_DRAIN) { E.fused(acc, cur, wr, wc, fr, fq, lds, wid, lane); S.done(cur); }
#undef PG8_SA
#undef PG8_SB
#undef PG8_STAGE
#undef PG8_LDA
#undef PG8_LDB
#undef PG8_MMA
#undef PG8_WAIT_V
#undef PG8_WAIT_L
#undef PG8_BAR
#undef PG8_SCHED
#undef PG8_GAV
}
}

#define XB_TMO      128
#define XB_XCNT(j)  (256  + 64 * (j))
#define XB_XSUB(j)  (1280 + 64 * (j))
#define XB_XGEN(j)  (2304 + 64 * (j))
#define XB_TOP      3328
#define XB_TOPGEN   3392
#define XCD_BAR_WORDS 3456
#define XB_SPIN_CAP (1u << 18)

__device__ __forceinline__ unsigned xb_ld(unsigned* p)              { return __hip_atomic_load(p, __ATOMIC_RELAXED, __HIP_MEMORY_SCOPE_AGENT); }
__device__ __forceinline__ unsigned xb_add(unsigned* p, unsigned v) { return __hip_atomic_fetch_add(p, v, __ATOMIC_RELAXED, __HIP_MEMORY_SCOPE_AGENT); }
__device__ __forceinline__ unsigned xb_xcc_id() { return (unsigned)__builtin_amdgcn_s_getreg((3 << 11) | 20) & 0xFu; }
#define XB_SPIN(cond, bar) do { unsigned _sp = 0; while (cond) { __builtin_amdgcn_s_sleep(1); \
    if ((++_sp & 255u) == 0u) { if (xb_ld(&(bar)[XB_TMO])) break; if (_sp > XB_SPIN_CAP) { atomicAdd(&(bar)[XB_TMO], 1u); break; } } } } while (0)

struct XcdBarrier {
    unsigned* bar; unsigned x;
    volatile LAS unsigned* st;
};

__device__ __forceinline__ XcdBarrier xcd_barrier_post(unsigned* bar, volatile LAS unsigned* st) {
    XcdBarrier b; b.bar = bar; b.x = xb_xcc_id(); b.st = st;
    if (threadIdx.x == 0) (void)xb_add(&bar[XB_XCNT(b.x)], 1u);
    return b;
}
__device__ __forceinline__ void xcd_barrier_complete(unsigned* bar, unsigned x, unsigned& nloc, unsigned& nx) {
    const unsigned G = gridDim.x * gridDim.y * gridDim.z;
    unsigned sum, cnt, mine, sp = 0u;
    for (;;) {
        sum = 0u; cnt = 0u; mine = 0u;
#pragma unroll
        for (unsigned j = 0; j < 16; ++j) { const unsigned c = xb_ld(&bar[XB_XCNT(j)]); sum += c; cnt += (c > 0u) ? 1u : 0u; mine = (j == x) ? c : mine; }
        if (sum == G) break;
        __builtin_amdgcn_s_sleep(1);
        if ((++sp & 255u) == 0u) { if (xb_ld(&bar[XB_TMO])) break; if (sp > XB_SPIN_CAP) { atomicAdd(&bar[XB_TMO], 1u); break; } }
    }
    nloc = mine > 0u ? mine : 1u; nx = cnt > 0u ? cnt : 1u;
}

__device__ __forceinline__ void xcd_barrier(const XcdBarrier& b) {
    asm volatile("s_waitcnt vmcnt(0)" ::: "memory");
    __syncthreads();
    if (threadIdx.x == 0) {
        unsigned* bar = b.bar;
        __builtin_amdgcn_s_waitcnt(0);
        unsigned nloc = b.st[0], nx = b.st[1];
        if (nloc == 0u) { xcd_barrier_complete(bar, b.x, nloc, nx); b.st[0] = nloc; b.st[1] = nx; }
        const unsigned old = xb_add(&bar[XB_XSUB(b.x)], 1u);
        const unsigned gen = old / nloc;
        if (old + 1u == (gen + 1u) * nloc) {
            __builtin_amdgcn_fence(__ATOMIC_RELEASE, "agent");
            asm volatile("s_waitcnt vmcnt(0)" ::: "memory");
            const unsigned og = xb_add(&bar[XB_TOP], 1u);
            const unsigned tg = og / nx;
            if (og + 1u == (tg + 1u) * nx) xb_add(&bar[XB_TOPGEN], 1u);
            else XB_SPIN(xb_ld(&bar[XB_TOPGEN]) == tg, bar);
            __builtin_amdgcn_fence(__ATOMIC_ACQUIRE, "agent");
            xb_add(&bar[XB_XGEN(b.x)], 1u);
            asm volatile("s_waitcnt vmcnt(0)" ::: "memory");
        } else {
            XB_SPIN(xb_ld(&bar[XB_XGEN(b.x)]) == gen, bar);
            __builtin_amdgcn_fence(__ATOMIC_ACQUIRE, "agent");
            asm volatile("s_waitcnt vmcnt(0)" ::: "memory");
        }
    }
    __syncthreads();
}
__device__ __forceinline__ unsigned fkey(float f) { const unsigned u = __float_as_uint(f); return (u & 0x80000000u) ? ~u : (u | 0x80000000u); }
__device__ __forceinline__ void idx_item(Frame& F, int b, int rg, int flags = 0) {
    const bf16_t* IQ = (const bf16_t*)(F.ws + WS_P + P_IQ); const bf16_t* IK = (const bf16_t*)(F.ws + WS_P + P_IK); const float* IW = (const float*)(F.ws + WS_P + P_IW);
    u64* maskT = flags ? (u64*)(F.ws + WS_END) : (u64*)(F.ws + WS_MASK);
    LAS unsigned* cnt = (LAS unsigned*)F.lds;
    LAS unsigned* mgt = (LAS unsigned*)(F.lds + 1024);
    LAS unsigned* meq = (LAS unsigned*)(F.lds + 1024 + 8192);
    const int t0 = rg * 16, wid = F.wave, lane = F.lane, qj = lane & 15, g4 = lane >> 4;
    const int n64 = ((t0 >> 8) + 1) * 4;
    if (rg < 16) {
        for (int idx = F.tid; idx < 16 * n64; idx += NTHR) { const int row = idx & 15, j64 = idx >> 4, t = t0 + row; const int rel = t - 64 * j64;
            const u64 mk = rel >= 63 ? ~0ull : (rel < 0 ? 0ull : ((1ull << (rel + 1)) - 1ull));
            maskT[((size_t)b * 64 + j64) * SEQ + t] = mk; }
        return;
    }
    for (int i = F.tid; i < 4096; i += NTHR) mgt[i] = 0u;
    LAS unsigned* cstep = (LAS unsigned*)(F.lds + 17408);
    cstep[F.tid] = 0u;
    __syncthreads();
    const size_t qrow = (size_t)b * SEQ + t0 + qj;
    float wq[8];
    { const f32x4 w0 = *(const f32x4*)(IW + qrow * 8), w1 = *(const f32x4*)(IW + qrow * 8 + 4); const float sc = 0.04419417382415922f;
      wq[0] = w0[0] * sc; wq[1] = w0[1] * sc; wq[2] = w0[2] * sc; wq[3] = w0[3] * sc; wq[4] = w1[0] * sc; wq[5] = w1[1] * sc; wq[6] = w1[2] * sc; wq[7] = w1[3] * sc; }
    const int ntile = rg + 1, nkeys = ntile * 16, nch = (ntile + 15) >> 4;
    LAS unsigned char* kst = F.lds + 20480 + wid * (3 * 4096);
    const char* kg = (const char*)IK + ((size_t)b * SEQ + wid * 16) * 128;
    const unsigned aofs = (unsigned)(qj * 128 + ((g4 ^ ((qj >> 1) & 7)) << 4));
#define KDMA(c, bufsel) do { int ln_ = lane; asm volatile("" : "+v"(ln_)); const unsigned o0_ = (unsigned)(((ln_ >> 3) << 7) + (((ln_ & 7) ^ (ln_ >> 4)) << 4)), o1_ = (o0_ ^ 64u) + 1024u; \
        _Pragma("unroll") for (int q_ = 0; q_ < 2; ++q_) { \
            __builtin_amdgcn_global_load_lds((const unsigned*)(kg + (size_t)(2 * (c) + q_) * 16384 + o0_), (LAS unsigned*)(kst + (bufsel) * 4096 + q_ * 2048), 16, 0, 0); \
            __builtin_amdgcn_global_load_lds((const unsigned*)(kg + (size_t)(2 * (c) + q_) * 16384 + o1_), (LAS unsigned*)(kst + (bufsel) * 4096 + q_ * 2048 + 1024), 16, 0, 0); } } while (0)
    unsigned sc[32][4];
#pragma unroll
    for (int j = 0; j < 32; ++j) { sc[j][0] = 0xff800000u; sc[j][1] = 0xff800000u; sc[j][2] = 0xff800000u; sc[j][3] = 0xff800000u; }
    if (!(flags & 1))
#pragma unroll
    for (int hp = 0; hp < 2; ++hp) {
        bf16x8 Bq[4][2];
#pragma unroll
        for (int h = 0; h < 4; ++h)
#pragma unroll
            for (int ks = 0; ks < 2; ++ks) Bq[h][ks] = *(const bf16x8*)(IQ + qrow * 512 + (4 * hp + h) * 64 + ks * 32 + g4 * 8);
        KDMA(0, 0); if (nch > 1) KDMA(1, 1);
#pragma unroll
        for (int c = 0; c < 16; ++c) {
            int nt_ = __builtin_amdgcn_readfirstlane(ntile), nch_ = __builtin_amdgcn_readfirstlane(nch); asm volatile("" : "+s"(nt_), "+s"(nch_));
            if (c < nch_) {
                if (c + 1 < nch_) asm volatile("s_waitcnt vmcnt(4) lgkmcnt(0)" ::: "memory"); else asm volatile("s_waitcnt vmcnt(0) lgkmcnt(0)" ::: "memory");
                if (c + 2 < nch_) KDMA(c + 2, (c + 2) % 3);
#pragma unroll
                for (int q = 0; q < 2; ++q) { const int j = 2 * c + q, tile = wid + 8 * j;
                    if (tile < nt_) {
                        const LAS unsigned char* ap = kst + (c % 3) * 4096 + q * 2048;
                        const bf16x8 A0 = *(const LAS bf16x8*)(ap + aofs), A1 = *(const LAS bf16x8*)(ap + (aofs ^ 64u));
                        f32x4 s = {0.f, 0.f, 0.f, 0.f};
                        if (hp) {
#pragma unroll
                            for (int i = 0; i < 4; ++i) s[i] = __uint_as_float(sc[j][i]); }
#pragma unroll
                        for (int h = 0; h < 4; ++h) { f32x4 a = __builtin_amdgcn_mfma_f32_16x16x32_bf16(A0, Bq[h][0], (f32x4){0.f, 0.f, 0.f, 0.f}, 0, 0, 0);
                            a = __builtin_amdgcn_mfma_f32_16x16x32_bf16(A1, Bq[h][1], a, 0, 0, 0);
#pragma unroll
                            for (int i = 0; i < 4; ++i) s[i] += wq[4 * hp + h] * __int_as_float(max(__float_as_int(a[i]), 0));   }
                        if (hp == 1) {
                            if (tile == nt_ - 1) {
#pragma unroll
                                for (int i = 0; i < 4; ++i) if (4 * g4 + i > qj) s[i] = -__builtin_inff(); }
#pragma unroll
                            for (int i = 0; i < 4; ++i) sc[j][i] = __float_as_uint(s[i]);
                        } else {
#pragma unroll
                            for (int i = 0; i < 4; ++i) sc[j][i] = __float_as_uint(s[i]);
                        }
                    } else {
#pragma unroll
                        for (int i = 0; i < 4; ++i) sc[j][i] = 0xff800000u;
                    } }
            } else {
#pragma unroll
                for (int q = 0; q < 2; ++q)
#pragma unroll
                    for (int i = 0; i < 4; ++i) sc[2 * c + q][i] = 0xff800000u;
            }
        }
    }
#undef KDMA
    const int nj = (ntile - wid + 7) >> 3;
    unsigned prefix = 0u; bool done = false;
    #define IDX_INVKEY(k) __uint_as_float(((k) & 0x80000000u) ? ((k) ^ 0x80000000u) : ~(k))
    if (!(flags & 2))
    for (int bit = 31; bit >= 0; --bit) {
        const unsigned cand = prefix | (1u << bit);
        const float cf = IDX_INVKEY(cand - 1u), ncb = -cf * 1.8446744e19f;
        const f32x2 big2 = {1.8446744e19f, 1.8446744e19f}, ncb2 = {ncb, ncb}; f32x2 acc2 = {0.f, 0.f};
        int nj_ = __builtin_amdgcn_readfirstlane(nj); asm volatile("" : "+s"(nj_));
#pragma unroll
        for (int jj = 0; jj < 8; ++jj) if (4 * jj < nj_) {
#pragma unroll
            for (int j = 4 * jj; j < 4 * jj + 4; ++j)
#pragma unroll
                for (int i = 0; i < 4; i += 2) { const f32x2 sv = {__uint_as_float(sc[j][i]), __uint_as_float(sc[j][i + 1])}; f32x2 d;
                    asm volatile("v_pk_fma_f32 %0, %1, %2, %3 clamp" : "=v"(d) : "v"(sv), "v"(big2), "v"(ncb2));
                    acc2 += d; } }
        unsigned c = (unsigned)(acc2[0] + acc2[1]);
        { auto r16 = __builtin_amdgcn_permlane16_swap(c, c, false, false); c = r16[0] + r16[1]; auto r32 = __builtin_amdgcn_permlane32_swap(c, c, false, false); c = r32[0] + r32[1]; }
        if (lane < 16) __hip_atomic_fetch_add(cstep + bit * 16 + lane, c, __ATOMIC_RELAXED, __HIP_MEMORY_SCOPE_WORKGROUP);
        __syncthreads();
        const unsigned tot = cstep[bit * 16 + qj];
        if (!done) { if (tot >= (unsigned)TOPK) prefix = cand; if (tot == (unsigned)TOPK) done = true; }
        if (__all(done)) break;
    }
    const float Tf = IDX_INVKEY(prefix);
    const float Tm = IDX_INVKEY(prefix - 1u);
    const bool alld = __all(done);
    LAS unsigned* mbase = mgt + qj * 128 + (wid >> 1); const int sh0 = (wid & 1) * 16 + 4 * g4;
    if (alld) {
#pragma unroll
        for (int j = 0; j < 32; ++j) {
            const int tile = wid + 8 * j;
            if (tile < ntile) {
                unsigned g = 0u;
#pragma unroll
                for (int i = 0; i < 4; ++i) g |= (__uint_as_float(sc[j][i]) > Tm ? 1u : 0u) << i;
                if (g) __hip_atomic_fetch_or(mbase + 4 * j, g << sh0, __ATOMIC_RELAXED, __HIP_MEMORY_SCOPE_WORKGROUP);
            }
        }
    } else {
        unsigned cg = 0u;
#pragma unroll
        for (int jj = 0; jj < 8; ++jj) if (4 * jj < nj) {
#pragma unroll
            for (int j = 4 * jj; j < 4 * jj + 4; ++j)
#pragma unroll
                for (int i = 0; i < 4; ++i) cg += (__uint_as_float(sc[j][i]) > Tf) ? 1u : 0u; }
        cg += __shfl_xor(cg, 16); cg += __shfl_xor(cg, 32);
        __syncthreads();
        if (lane < 16) cnt[wid * 16 + lane] = cg;
#pragma unroll
        for (int j = 0; j < 32; ++j) {
            const int tile = wid + 8 * j;
            if (tile < ntile) {
                unsigned g = 0u, e = 0u;
#pragma unroll
                for (int i = 0; i < 4; ++i) { const float sv = __uint_as_float(sc[j][i]); g |= (sv > Tf ? 1u : 0u) << i; e |= ((sv > Tm && !(sv > Tf)) ? 1u : 0u) << i; }
                if (g) __hip_atomic_fetch_or(mbase + 4 * j, g << sh0, __ATOMIC_RELAXED, __HIP_MEMORY_SCOPE_WORKGROUP);
                if (e) __hip_atomic_fetch_or(mbase + 2048 + 4 * j, e << sh0, __ATOMIC_RELAXED, __HIP_MEMORY_SCOPE_WORKGROUP);
            }
        }
    }
    __syncthreads();
    if (!alld && wid == 0 && lane < 16) {
        unsigned gt = 0u;
#pragma unroll
        for (int w = 0; w < 8; ++w) gt += cnt[w * 16 + lane];
        int need = TOPK - (int)gt, taken = 0; const int nw = (t0 + 16 + 31) >> 5;
        for (int wd = 0; wd < nw; ++wd) { unsigned e = meq[lane * 128 + wd]; if (!e) continue; int c = __popc(e);
            if (taken + c > need) { unsigned keep = 0u; int rem = need - taken; while (rem > 0) { const unsigned low = e & (0u - e); keep |= low; e ^= low; --rem; } e = keep; c = __popc(keep); }
            taken += c; mgt[lane * 128 + wd] |= e; }
    }
    __syncthreads();
    for (int idx = F.tid; idx < 16 * n64; idx += NTHR) { const int row = idx & 15, j64 = idx >> 4;
        const u64 mk = (u64)mgt[row * 128 + 2 * j64] | ((u64)mgt[row * 128 + 2 * j64 + 1] << 32);
        maskT[((size_t)b * 64 + j64) * SEQ + t0 + row] = mk; }
    __syncthreads();
}
__device__ __forceinline__ void ph_idx(Frame& F, int flags = 0) {
    for (int c = F.bid; c < 256; c += F.G) { const int b = c & 3, base = c >> 2;
        idx_item(F, b, 255 - base, flags); idx_item(F, b, 128 + base, flags); idx_item(F, b, 127 - base, flags); idx_item(F, b, base, flags); }
}
namespace att {
constexpr int HD = 128, RS = 1024;
constexpr float SCALE = 0.08838834764831845f, THR = 8.f;
constexpr int NW = 8, QBLK = 32, KVBLK = 64, QB = NW * QBLK;
constexpr int SHM_V = KVBLK * HD * 2, SHM_K = KVBLK * HD * 2;
constexpr int LDS_ATT = 2 * SHM_V + 2 * SHM_K + NW * 64 * 4;
constexpr int LDS_TB = LDS_ATT;
typedef float f32x16 __attribute__((ext_vector_type(16)));
#define KSWZ(row, colB) ((row) * 256 + ((colB) ^ (((row) & 7) << 4)))
#define SBAR() __builtin_amdgcn_sched_barrier(0)
__device__ __forceinline__ int v_st(int k, int c) { const int kk = (k & ~0xC) | ((k & 4) << 1) | ((k & 8) >> 1); return ((kk >> 3) * 4 + (c >> 5)) * 512 + ((kk & 7) * 32 + (c & 31)) * 2; }
__device__ __forceinline__ int v_rd_base(int lane) { return ((lane & 3) << 3) | (((lane >> 2) & 3) << 6) | (((lane >> 4) & 1) << 5) | (((lane >> 5) & 1) << 8); }
constexpr int v_rd_off(int d0, int ks, int half) { return d0 * 512 + ks * 4096 + half * 2048; }
__device__ __forceinline__ int crow(int r, int hi) { return (r & 3) + 8 * (r >> 2) + 4 * hi; }
__device__ __forceinline__ bf16x8 load8(const bf16_t* p) { return *reinterpret_cast<const bf16x8*>(p); }
__device__ __forceinline__ void mask_bits(f32x16& p0, f32x16& p1, u64 mk, int hi) {
    const unsigned lo = (unsigned)mk >> (4 * hi), hh = (unsigned)(mk >> 32) >> (4 * hi);
#pragma unroll
    for (int r = 0; r < 16; ++r) { const int c = (r & 3) + 8 * (r >> 2);
        const unsigned m0 = (unsigned)((int)(lo << (31 - c)) >> 31), m1 = (unsigned)((int)(hh << (31 - c)) >> 31);
        p0[r] = __uint_as_float((__float_as_uint(p0[r]) & m0) | (0xff800000u & ~m0));
        p1[r] = __uint_as_float((__float_as_uint(p1[r]) & m1) | (0xff800000u & ~m1)); }
}
__device__ __forceinline__ void add_bias(f32x16& p0, f32x16& p1, const LAS float* tbq) {
#pragma unroll
    for (int r = 0; r < 16; ++r) { const int c = (r & 3) + 8 * (r >> 2); p0[r] += tbq[-c]; p1[r] += tbq[-c - 32]; }
}
__device__ __forceinline__ void partialSM(f32x16& p0, f32x16& p1, float& m_reg, float& mn, float& alpha) {
    float pmax = p0[0]; for (int r = 1; r < 16; ++r) pmax = fmaxf(pmax, p0[r]); for (int r = 0; r < 16; ++r) pmax = fmaxf(pmax, p1[r]);
    { auto rr = __builtin_amdgcn_permlane32_swap(__float_as_uint(pmax), __float_as_uint(pmax), false, false);
      pmax = fmaxf(__uint_as_float(rr[0]), __uint_as_float(rr[1])); }
    constexpr float C2 = 1.4426950408889634f * SCALE;
    if (__builtin_expect(__all((pmax - m_reg) * SCALE <= THR), 1)) { mn = m_reg; alpha = 1.f; }
    else { mn = fmaxf(m_reg, pmax); alpha = __builtin_amdgcn_exp2f((m_reg - mn) * C2); m_reg = mn; }
    const float mnL = -mn * C2;
    for (int r = 0; r < 16; ++r) p0[r] = fmaf(p0[r], C2, mnL); for (int r = 0; r < 16; ++r) p1[r] = fmaf(p1[r], C2, mnL);
    for (int r = 0; r < 16; ++r) p0[r] = __builtin_amdgcn_exp2f(p0[r]);
}
__device__ __forceinline__ void finishSM(f32x16& p0, f32x16& p1, float alpha, float& l_reg, bf16x8& pa0, bf16x8& pa1, bf16x8& pa2, bf16x8& pa3) {
    for (int r = 0; r < 16; ++r) p1[r] = __builtin_amdgcn_exp2f(p1[r]);
    float ps = 0; for (int r = 0; r < 16; ++r) ps += p0[r]; for (int r = 0; r < 16; ++r) ps += p1[r];
    { auto rr = __builtin_amdgcn_permlane32_swap(__float_as_uint(ps), __float_as_uint(ps), false, false);
      ps = __uint_as_float(rr[0]) + __uint_as_float(rr[1]); }
    l_reg = l_reg * alpha + ps;
#define PK4(P, B_, OUT) do { unsigned a0 = cvt_pk_bf16(P[B_+0], P[B_+1]), a1 = cvt_pk_bf16(P[B_+2], P[B_+3]);                          \
        unsigned b0 = cvt_pk_bf16(P[B_+4], P[B_+5]), b1 = cvt_pk_bf16(P[B_+6], P[B_+7]);                                             \
        auto r0 = __builtin_amdgcn_permlane32_swap(a0, b0, false, false); auto r1 = __builtin_amdgcn_permlane32_swap(a1, b1, false, false); \
        u32x4 w = {r0[0], r1[0], r0[1], r1[1]}; OUT = *reinterpret_cast<bf16x8*>(&w); } while (0)
    PK4(p0, 0, pa0); PK4(p0, 8, pa1); PK4(p1, 0, pa2); PK4(p1, 8, pa3);
#undef PK4
}
template <int KB>
__device__ __forceinline__ void qkt(f32x16& p0, f32x16& p1, const char* K_lds, int r32, int hi, const bf16x8* qr) {
    p0 = f32x16{}; p1 = f32x16{};
    const char* kb[4];
#pragma unroll
    for (int dd = 0; dd < 4; ++dd) kb[dd] = K_lds + KB * SHM_K + KSWZ(r32, (dd * 16 + hi * 8) * 2);
#pragma unroll
    for (int d0 = 0; d0 < 8; ++d0) { const char* a = kb[d0 & 3] + (d0 >> 2) * 128;
        bf16x8 b0 = *reinterpret_cast<const bf16x8*>(a);
        bf16x8 b1 = *reinterpret_cast<const bf16x8*>(a + 32 * 256);
        p0 = __builtin_amdgcn_mfma_f32_32x32x16_bf16(b0, qr[d0], p0, 0, 0, 0);
        p1 = __builtin_amdgcn_mfma_f32_32x32x16_bf16(b1, qr[d0], p1, 0, 0, 0); }
}
template <int VB>
__device__ __forceinline__ void pv_tile(f32x16* o, int vb0, bf16x8 pa0, bf16x8 pa1, bf16x8 pa2, bf16x8 pa3) {
#define TRRD(dst, off) asm volatile("ds_read_b64_tr_b16 %0, %1 offset:%2" : "=&v"(dst) : "v"(vb0), "i"(off) : "memory")
#define PV_D0(d0) do { s16x4 l0, l1, h0, h1; constexpr int b_ = VB * SHM_V + v_rd_off(d0, 0, 0); \
        TRRD(l0, b_); TRRD(h0, b_ + 2048); TRRD(l1, b_ + 4096); TRRD(h1, b_ + 6144); \
        asm volatile("s_waitcnt lgkmcnt(0)" ::: "memory"); SBAR();   \
        o[d0] = __builtin_amdgcn_mfma_f32_32x32x16_bf16(pa0, (bf16x8){l0[0], l0[1], l0[2], l0[3], h0[0], h0[1], h0[2], h0[3]}, o[d0], 0, 0, 0);   \
        o[d0] = __builtin_amdgcn_mfma_f32_32x32x16_bf16(pa1, (bf16x8){l1[0], l1[1], l1[2], l1[3], h1[0], h1[1], h1[2], h1[3]}, o[d0], 0, 0, 0);   \
        SBAR(); TRRD(l0, b_ + 8192); TRRD(h0, b_ + 10240); TRRD(l1, b_ + 12288); TRRD(h1, b_ + 14336); \
        asm volatile("s_waitcnt lgkmcnt(0)" ::: "memory"); SBAR();   \
        o[d0] = __builtin_amdgcn_mfma_f32_32x32x16_bf16(pa2, (bf16x8){l0[0], l0[1], l0[2], l0[3], h0[0], h0[1], h0[2], h0[3]}, o[d0], 0, 0, 0);   \
        o[d0] = __builtin_amdgcn_mfma_f32_32x32x16_bf16(pa3, (bf16x8){l1[0], l1[1], l1[2], l1[3], h1[0], h1[1], h1[2], h1[3]}, o[d0], 0, 0, 0); } while (0)
    PV_D0(0); PV_D0(1); PV_D0(2); PV_D0(3);
#undef PV_D0
#undef TRRD
}
struct BlockRef { const bf16_t* Q; const bf16_t* K; const bf16_t* V; bf16_t* O; const u64* MK; int P0; int h; };
struct Seam { bf16x8 qr[8]; bf16x8 st_v0, st_v1, st_k0, st_k1; };
#define LD16U(base, off) (*(const bf16x8*)((const char*)(base) + (off)))
#define VMW() asm volatile("s_waitcnt vmcnt(0)" ::: "memory")
#define TIDL() ({ int t__ = threadIdx.x; asm volatile("" : "+v"(t__)); t__; })
#define SLOAD_H(Kp, Vp, k0) do { const int t_ = TIDL(); const unsigned klo_ = (unsigned)((t_ >> 4) * RS + (t_ & 15) * 8) * 2u;   \
        const char* kb_ = (const char*)(Kp) + (size_t)(k0) * (RS * 2); const char* vb_ = (const char*)(Vp) + (size_t)(k0) * (RS * 2);   \
        S.st_v0 = LD16U(vb_, klo_); S.st_v1 = LD16U(vb_ + 32 * RS * 2, klo_); S.st_k0 = LD16U(kb_, klo_); S.st_k1 = LD16U(kb_ + 32 * RS * 2, klo_); } while (0)
#define SWRITE_HK(bf) do { const int t_ = TIDL(); const int kws_ = KSWZ(t_ >> 4, (t_ & 15) * 16); *(bf16x8*)(K_lds + (bf) * SHM_K + kws_) = S.st_k0; *(bf16x8*)(K_lds + (bf) * SHM_K + kws_ + 32 * 256) = S.st_k1; } while (0)
#define SWRITE_HV(bf) do { const int t_ = TIDL(); const int sr_ = t_ >> 4, sc_ = (t_ & 15) * 8; *(bf16x8*)(V_lds + (bf) * SHM_V + v_st(sr_, sc_)) = S.st_v0; *(bf16x8*)(V_lds + (bf) * SHM_V + v_st(32 + sr_, sc_)) = S.st_v1; } while (0)
#define SWRITE_H(bf) do { SWRITE_HV(bf); SWRITE_HK(bf); } while (0)
#define QLOAD(Qp) do { const int t_ = TIDL(); const unsigned qlo_ = (unsigned)((t_ & 31) * RS + ((t_ >> 5) & 1) * 8) * 2u; const char* qb_ = (const char*)(Qp) + (size_t)(wid * QBLK) * (RS * 2); \
        _Pragma("unroll") for (int d0 = 0; d0 < 8; ++d0) S.qr[d0] = LD16U(qb_ + d0 * 32, qlo_); } while (0)
__device__ __forceinline__ void att_prime(const BlockRef& cur, char* lds, Seam& S) {
    const int tid = threadIdx.x, wid = __builtin_amdgcn_readfirstlane(tid >> 6); char* K_lds = lds + 2 * SHM_V;
    QLOAD(cur.Q);
    SLOAD_H(cur.K, cur.V, 0); VMW(); SWRITE_HK(0);
    __syncthreads();
}
__device__ __forceinline__ void att_block(const BlockRef& cur, const BlockRef& nxt, char* lds, const LAS float* tbl, Seam& S) {
    const int tid = TIDL(),
              wid = __builtin_amdgcn_readfirstlane(tid >> 6), lane = tid & 63, r32 = lane & 31, hi = lane >> 5;
    const int NT = cur.P0 / KVBLK + 4;
    const int qlo = cur.P0 + wid * QBLK;
    char* V_lds = lds; char* K_lds = lds + 2 * SHM_V;
    float* ws = (float*)(lds + 2 * SHM_V + 2 * SHM_K) + wid * 64; float* li_l = ws, * al_l = ws + 32;
    float m_reg = -1e30f, l_reg = 0; f32x16 o[4] = {};
    const int vb0 = (int)(uintptr_t)V_lds + v_rd_base(lane);
    const bf16_t* Kh = cur.K; const bf16_t* Vh = cur.V;
    const char* mkb = (const char*)(cur.MK + qlo);
#define LDMK(j) (*(const u64*)(mkb + (size_t)(j) * (SEQ * 8) + (unsigned)(TIDL() & 31) * 8u))
#define RESC(a) do { if (__any((a) < 1.f)) { if (hi == 0) al_l[r32] = (a); asm volatile("s_waitcnt lgkmcnt(0)" ::: "memory");              \
                     for (int d_ = 0; d_ < 4; ++d_) for (int r = 0; r < 16; ++r) o[d_][r] *= al_l[crow(r, hi)]; } } while (0)
#define KBASE(t) ((t) * KVBLK)
#define MASKT(P0_, P1_, t, MK_) do { const int kb_ = KBASE(t); if (kb_ + 176 > qlo) { const int t_ = TIDL(); add_bias(P0_, P1_, tbl + cur.h * 512 + 256 + (qlo + (t_ & 31) - 4 * ((t_ >> 5) & 1) - kb_)); } mask_bits(P0_, P1_, MK_, hi); } while (0)
#define VMWN8() asm volatile("s_waitcnt vmcnt(8)" ::: "memory")
#define SEAM_K0() do { VMWN8(); SWRITE_HK(0); SBAR(); } while (0)
    f32x16 pA0, pA1, pB0, pB1; float mnA, mnB, alA, alB; bf16x8 pa0, pa1, pa2, pa3;
    u64 mk_ = LDMK(0);
    SWRITE_HV(0); SBAR();
    SLOAD_H(Kh, Vh, KBASE(1));
    SBAR(); qkt<0>(pA0, pA1, K_lds, r32, hi, S.qr);
    MASKT(pA0, pA1, 0, mk_); partialSM(pA0, pA1, m_reg, mnA, alA);
    VMW(); SWRITE_H(1);
    __syncthreads();
#define HALF_STEP(PX0, PX1, mnX, alX, PY0, PY1, alY, t, KB, VB, SB) do {                                                      \
        mk_ = LDMK(t); SBAR(); qkt<KB>(PX0, PX1, K_lds, r32, hi, S.qr);                                                                      \
        finishSM(PY0, PY1, alY, l_reg, pa0, pa1, pa2, pa3); SBAR();                                                           \
        if ((t) + 1 < NT) { SLOAD_H(Kh, Vh, KBASE((t) + 1)); SBAR(); }                                                        \
        pv_tile<VB>(o, vb0, pa0, pa1, pa2, pa3); MASKT(PX0, PX1, (t), mk_);                                                   \
        partialSM(PX0, PX1, m_reg, mnX, alX);                                                                                 \
        __syncthreads();                                                                                                      \
        if ((t) + 1 < NT) { VMW(); SWRITE_H(SB); }                                                                            \
        RESC(alX); __syncthreads(); } while (0)
    for (int t = 1; t + 1 < NT; t += 2) {
        HALF_STEP(pB0, pB1, mnB, alB, pA0, pA1, alA, t, 1, 0, 0);
        HALF_STEP(pA0, pA1, mnA, alA, pB0, pB1, alB, t + 1, 0, 1, 1);
    }
    mk_ = LDMK(NT - 1); SBAR(); qkt<1>(pB0, pB1, K_lds, r32, hi, S.qr); SBAR();
    SLOAD_H(nxt.K, nxt.V, 0); SBAR();
    QLOAD(nxt.Q);
    SBAR();
    finishSM(pA0, pA1, alA, l_reg, pa0, pa1, pa2, pa3); SBAR();
    pv_tile<0>(o, vb0, pa0, pa1, pa2, pa3);
    MASKT(pB0, pB1, NT - 1, mk_); partialSM(pB0, pB1, m_reg, mnB, alB); __syncthreads(); RESC(alB);
    finishSM(pB0, pB1, alB, l_reg, pa0, pa1, pa2, pa3); SBAR(); pv_tile<1>(o, vb0, pa0, pa1, pa2, pa3);
    SBAR(); SEAM_K0();
    if (hi == 0) li_l[r32] = l_reg; asm volatile("s_waitcnt lgkmcnt(0)" ::: "memory");
    float rli[16];
#pragma unroll
    for (int r = 0; r < 16; ++r) rli[r] = __builtin_amdgcn_rcpf(li_l[crow(r, hi)]);
    char* Ow = (char*)cur.O + (size_t)(wid * QBLK) * (RS * 2); const unsigned olo = (unsigned)(4 * ((TIDL() >> 5) & 1) * RS + (TIDL() & 31)) * 2u;
#pragma unroll
    for (int r = 0; r < 16; ++r) { const int orow0 = (r & 3) + 8 * (r >> 2);
#pragma unroll
        for (int d0 = 0; d0 < 4; ++d0) { const float v = o[d0][r] * rli[r]; const float vn = DPPF(v, 0xB1);
            if ((r32 & 1) == 0) *(unsigned*)(Ow + (size_t)orow0 * (RS * 2) + d0 * 64 + olo) = cvt_pk_bf16(v, vn); } }
    __syncthreads();
#undef LDMK
#undef RESC
#undef KBASE
#undef MASKT
#undef VMWN8
#undef SEAM_K0
#undef HALF_STEP
}
#undef LD16U
#undef VMW
#undef SLOAD_H
#undef SWRITE_HK
#undef SWRITE_HV
#undef SWRITE_H
#undef QLOAD
#undef TIDL
}
__device__ __forceinline__ void ph_att(Frame& F, char* lds) {
    const bf16_t* QA = (const bf16_t*)(F.ws + WS_P + P_QA); const bf16_t* KA = (const bf16_t*)(F.ws + WS_P + P_KA); const bf16_t* VA = (const bf16_t*)(F.ws + WS_P + P_VA);
    bf16_t* OA = (bf16_t*)(F.ws + WS_OA); const u64* maskT = (const u64*)(F.ws + WS_MASK); const float* tbg = (const float*)(F.ws + WS_TB);
    LAS float* tbl = (LAS float*)(F.lds + att::LDS_TB);
    for (int i = F.tid; i < 8 * 512; i += NTHR) { const int rel = (i & 511) - 256; tbl[i] = (rel >= 0 && rel < 128) ? tbg[(i >> 9) * 128 + rel] : 0.f; }
    __syncthreads();
    for (int c = F.bid; c < 256; c += F.G) {
        const int r = c >> 3; int bhl, li;
        if (r < 16) { bhl = r >> 2; li = r & 3; } else if (r < 24) { bhl = (r - 16) >> 1; li = 4 + ((r - 16) & 1); } else { bhl = (r - 24) >> 1; li = 6 + ((r - 24) & 1); }
        const int bh = 4 * (c & 7) + bhl, b = bh >> 3, h = bh & 7;
        const unsigned code = li == 0 ? 0xF29u : li == 1 ? 0xF38u : li == 2 ? 0xF47u : li == 3 ? 0xF56u : li == 4 ? 0xF0Du : li == 5 ? 0xF1Cu : li == 6 ? 0xFAFu : 0xFBEu;
        const int x0 = code & 15, x1 = (code >> 4) & 15, x2 = (code >> 8) & 15, n = x1 == 15 ? 1 : (x2 == 15 ? 2 : 3);
        att::BlockRef r0, r1;
        { const size_t ro = ((size_t)b * SEQ + 256 * x0) * 1024 + h * 128;
          r0.Q = QA + ro; r0.O = OA + ro; r0.K = KA + (size_t)b * SEQ * 1024 + h * 128; r0.V = VA + (size_t)b * SEQ * 1024 + h * 128; r0.MK = maskT + (size_t)b * 64 * SEQ; r0.P0 = 256 * x0; r0.h = h; }
        att::Seam S;
        att::att_prime(r0, lds, S);
        for (int k = 0; k < n; ++k) {
            const int xn = (k + 1 < n) ? (k == 0 ? x1 : x2) : (r0.P0 >> 8);
            const size_t ro = ((size_t)b * SEQ + 256 * xn) * 1024 + h * 128;
            r1 = r0; r1.Q = QA + ro; r1.O = OA + ro; r1.P0 = 256 * xn;
            att::att_block(r0, r1, lds, tbl, S); r0 = r1; }
    }
}
__device__ __forceinline__ f32x4 mfma16(bf16x8 a, bf16x8 b, f32x4 c) { return __builtin_amdgcn_mfma_f32_16x16x32_bf16(a, b, c, 0, 0, 0); }
__device__ __forceinline__ void ph_hprep(Frame& F, unsigned char* dry) {
    bf16_t* BQ = (bf16_t*)(F.ws + WS_P + P_BQ); bf16_t* BG = (bf16_t*)(F.ws + WS_P + P_BG);
    bf16_t* BQo = dry ? (bf16_t*)dry : BQ; bf16_t* BGo = dry ? (bf16_t*)(dry + 32 * MiB) : BG;
    bf16_t* HA = dry ? (bf16_t*)(dry + 64 * MiB) : (bf16_t*)(F.ws + WS_HA); float* HDEC = dry ? (float*)(dry + 80 * MiB) : (float*)(F.ws + WS_HDEC);
    LAS float* wsum = (LAS float*)F.lds;
    LAS unsigned char* qt = F.lds + 4096;
    LAS unsigned char* kt = F.lds + 4096 + 64 * 272;
    const int w = F.wave, lane = F.lane, cp = lane;
    unsigned ngw[8], nqw[8];
#define HP_BASE(it_) ((((size_t)((it_) >> 9) * SEQ + ((it_) & 63) * 64 + 8 * w) * 1024) + (((it_) >> 6) & 7) * 128 + 2 * cp)
    if (F.bid < 2048) { const size_t nb = HP_BASE(F.bid);
#pragma unroll
        for (int r = 0; r < 8; ++r) { ngw[r] = *(const unsigned*)(BG + nb + (size_t)r * 1024); nqw[r] = *(const unsigned*)(BQ + nb + (size_t)r * 1024); } }
    for (int it = F.bid; it < 2048; it += F.G) {
        const int bh = it >> 6, ch = it & 63, b = bh >> 3, h = bh & 7;
        const size_t base = ((size_t)b * SEQ + ch * 64 + 8 * w) * 1024 + h * 128 + 2 * cp;
        float g0[8], g1[8], q0[8], q1[8];
#pragma unroll
        for (int r = 0; r < 8; ++r) { const unsigned gw = ngw[r], qw = nqw[r];
            g0[r] = bflo(gw); g1[r] = bfhi(gw); q0[r] = bflo(qw); q1[r] = bfhi(qw); }
        if (it + F.G < 2048) { const size_t nb = HP_BASE(it + F.G);
#pragma unroll
            for (int r = 0; r < 8; ++r) { ngw[r] = *(const unsigned*)(BG + nb + (size_t)r * 1024); nqw[r] = *(const unsigned*)(BQ + nb + (size_t)r * 1024); } }
        float c0 = 0.f, c1 = 0.f, bl0[8], bl1[8];
#pragma unroll
        for (int r = 0; r < 8; ++r) { c0 += g0[r]; c1 += g1[r]; bl0[r] = c0; bl1[r] = c1; }
        wsum[w * 128 + 2 * cp] = c0; wsum[w * 128 + 2 * cp + 1] = c1;
        __syncthreads();
        float off0 = 0.f, off1 = 0.f, mid0 = 0.f, mid1 = 0.f, last0 = 0.f, last1 = 0.f;
#pragma unroll
        for (int ww = 0; ww < 8; ++ww) { const float s0 = wsum[ww * 128 + 2 * cp], s1 = wsum[ww * 128 + 2 * cp + 1];
            if (ww < w) { off0 += s0; off1 += s1; } if (ww < 4) { mid0 += s0; mid1 += s1; } last0 += s0; last1 += s1; }
#pragma unroll
        for (int r = 0; r < 8; ++r) {
            const float b0 = bl0[r] + off0, b1 = bl1[r] + off1;
            const float k0 = 1.f - __expf(g0[r]), k1 = 1.f - __expf(g1[r]);
            *(unsigned*)(BQo + base + (size_t)r * 1024) = cvt_pk_bf16(q0[r] * __expf(b0), q1[r] * __expf(b1));
            *(unsigned*)(BGo + base + (size_t)r * 1024) = cvt_pk_bf16(k0 * __expf(last0 - b0), k1 * __expf(last1 - b1));
            *(LAS unsigned*)(qt + (8 * w + r) * 272 + 4 * cp) = cvt_pk_bf16(q0[r] * __expf(b0 - mid0), q1[r] * __expf(b1 - mid1));
            *(LAS unsigned*)(kt + (8 * w + r) * 272 + 4 * cp) = cvt_pk_bf16(k0 * __expf(mid0 - b0), k1 * __expf(mid1 - b1));
        }
        if (w == 0) { HDEC[(size_t)it * 128 + 2 * cp] = __expf(last0); HDEC[(size_t)it * 128 + 2 * cp + 1] = __expf(last1); }
        __syncthreads();
        { const int tt = w & 3, fr = lane & 15, g4 = lane >> 4;
          bf16x8 qf[4];
#pragma unroll
          for (int ks = 0; ks < 4; ++ks) qf[ks] = *(const LAS bf16x8*)(qt + (16 * tt + fr) * 272 + (32 * ks + 8 * g4) * 2);
#pragma unroll
          for (int si = 0; si < 2; ++si) { const int st = 2 * (w >> 2) + si; f32x4 acc = {0.f, 0.f, 0.f, 0.f};
#pragma unroll
              for (int ks = 0; ks < 4; ++ks) { const bf16x8 kf = *(const LAS bf16x8*)(kt + (16 * st + fr) * 272 + (32 * ks + 8 * g4) * 2); acc = mfma16(kf, qf[ks], acc); }
              const int t = 16 * tt + fr, s0 = 16 * st + 4 * g4;
              float x[4];
#pragma unroll
              for (int i = 0; i < 4; ++i) x[i] = (s0 + i <= t) ? acc[i] : 0.f;
              u32x2 o; o.x = cvt_pk_bf16(x[0], x[1]); o.y = cvt_pk_bf16(x[2], x[3]);
              *(u32x2*)(HA + ((size_t)it * 64 + t) * 64 + s0) = o; } }
        __syncthreads();
    }
}
__device__ __forceinline__ void ph_rprep(Frame& F) {
    const bf16_t* CQ = (const bf16_t*)(F.ws + WS_P + P_CQ); const bf16_t* CK = (const bf16_t*)(F.ws + WS_P + P_CK); bf16_t* RA = (bf16_t*)(F.ws + WS_RA);
    const int w = F.wave, lane = F.lane, fr = lane & 15, g4 = lane >> 4, v = w & 3, tA = v, tB = 7 - v;
    for (int pr = F.bid; pr < 256; pr += F.G) { const int it = 2 * pr + (w >> 2);
        const int bh = it >> 5, ch = it & 31, b = bh >> 2, h = bh & 3;
        const size_t base = ((size_t)b * SEQ + ch * 128) * 1024 + h * 256;
        const float gi = exp2f(-128.f * __log2f(1.f - exp2f(-5.f - (float)h)));
        bf16x8 qa[8], qb[8], kf[8], kn[8];
#pragma unroll
        for (int ks = 0; ks < 8; ++ks) { qa[ks] = *(const bf16x8*)(CQ + base + (size_t)(16 * tA + fr) * 1024 + 32 * ks + 8 * g4); qb[ks] = *(const bf16x8*)(CQ + base + (size_t)(16 * tB + fr) * 1024 + 32 * ks + 8 * g4); }
#pragma unroll
        for (int ks = 0; ks < 8; ++ks) kf[ks] = *(const bf16x8*)(CK + base + (size_t)fr * 1024 + 32 * ks + 8 * g4);
        bf16_t* ra = RA + ((size_t)it * 128 + fr) * 128 + 4 * g4;
        for (int st = 0; st < 8; ++st) {
            if (st < tB) {
#pragma unroll
                for (int ks = 0; ks < 8; ++ks) kn[ks] = *(const bf16x8*)(CK + base + (size_t)(16 * (st + 1) + fr) * 1024 + 32 * ks + 8 * g4); }
            const int s0 = 16 * st + 4 * g4;
            { u32x2 o = {0u, 0u};
              if (st <= tB) { f32x4 acc = {0.f, 0.f, 0.f, 0.f};
#pragma unroll
                  for (int ks = 0; ks < 8; ++ks) acc = mfma16(kf[ks], qb[ks], acc);
                  const int t = 16 * tB + fr; float x[4];
#pragma unroll
                  for (int i = 0; i < 4; ++i) x[i] = (s0 + i <= t) ? acc[i] * gi : 0.f;
                  o.x = cvt_pk_bf16(x[0], x[1]); o.y = cvt_pk_bf16(x[2], x[3]); }
              *(u32x2*)(ra + (size_t)(16 * tB) * 128 + 16 * st) = o; }
            { u32x2 o = {0u, 0u};
              if (st <= tA) { f32x4 acc = {0.f, 0.f, 0.f, 0.f};
#pragma unroll
                  for (int ks = 0; ks < 8; ++ks) acc = mfma16(kf[ks], qa[ks], acc);
                  const int t = 16 * tA + fr; float x[4];
#pragma unroll
                  for (int i = 0; i < 4; ++i) x[i] = (s0 + i <= t) ? acc[i] * gi : 0.f;
                  o.x = cvt_pk_bf16(x[0], x[1]); o.y = cvt_pk_bf16(x[2], x[3]); }
              *(u32x2*)(ra + (size_t)(16 * tA) * 128 + 16 * st) = o; }
            if (st < tB) {
#pragma unroll
                for (int ks = 0; ks < 8; ++ks) kf[ks] = kn[ks]; }
        }
    }
}
template <int OFF> __device__ __forceinline__ s16x4 trrd(unsigned addr) { s16x4 r; asm volatile("ds_read_b64_tr_b16 %0, %1 offset:%2" : "=&v"(r) : "v"(addr), "i"(OFF) : "memory"); return r; }
__device__ __forceinline__ bf16x8 cat8(s16x4 a, s16x4 b) { return (bf16x8){a[0], a[1], a[2], a[3], b[0], b[1], b[2], b[3]}; }
template <int C, int DK, int NCT, int LDQ, int LDV, int LDO, bool VEC>
__device__ __forceinline__ void scan_item(LAS unsigned char* lds, int tid, int w, int lane, const bf16_t* Q, const bf16_t* Kt, const bf16_t* V, const bf16_t* A, const float* dec, float cdec, bf16_t* O, int nchunk) {
    constexpr int RSK = DK * 2 + 32, RSV = NCT * 32 + 8, RST = DK * 2 + 16;
    constexpr int KL = 0, VL = C * RSK, ST0 = VL + C * RSV;
    constexpr int NPK = C * DK / 8 / NTHR;
    constexpr int PV = C * NCT * 2, NPV = (PV + NTHR - 1) / NTHR;
    constexpr int NKS_C = C / 32, NKS_D = DK / 32;
    constexpr int NDT = DK / 16 / 8;
    const int fr = lane & 15, g4 = lane >> 4, q4 = fr >> 2, p4 = lane & 3;
    const bool ow = w < C / 16;
    const int rt = ow ? w : 0;
    const unsigned ldsb = (unsigned)(uintptr_t)lds;
    const unsigned vtr = ldsb + VL + (8 * g4 + q4) * RSV + 8 * p4;
    const unsigned ktr = ldsb + KL + (8 * g4 + q4) * RSK + 8 * p4 + w * NDT * 32;
    LAS unsigned char* stb = lds + ST0;
    f32x4 S[NDT][NCT];
#pragma unroll
    for (int i = 0; i < NDT; ++i)
#pragma unroll
        for (int ct = 0; ct < NCT; ++ct) S[i][ct] = (f32x4){0.f, 0.f, 0.f, 0.f};
    u32x4 kst[NPK], vst[NPV]; bf16x8 qf[NKS_D], af[NKS_C];
    const unsigned klo = (unsigned)((tid / (DK / 8)) * LDQ + (tid % (DK / 8)) * 8) * 2u;
    const unsigned vlo = (unsigned)((tid / (NCT * 2)) * LDV + (tid % (NCT * 2)) * 8) * 2u, vlds = (unsigned)((tid / (NCT * 2)) * RSV + (tid % (NCT * 2)) * 16);
    const unsigned qlo = (unsigned)(fr * LDQ + 8 * g4) * 2u, alo = (unsigned)(fr * C + 8 * g4) * 2u, olo = (unsigned)(fr * LDO + 4 * g4) * 2u;
    const unsigned klds = (unsigned)((tid / (DK / 8)) * RSK + (tid % (DK / 8)) * 16);
    constexpr int KROWS = NTHR / (DK / 8), VROWS = NTHR / (NCT * 2);
#define SC_LOADK(cc) do { const char* kb_ = (const char*)Kt + (size_t)(cc) * (C * LDQ * 2); _Pragma("unroll") for (int i = 0; i < NPK; ++i) kst[i] = *(const u32x4*)(kb_ + (size_t)i * (KROWS * LDQ * 2) + klo); \
        const char* vb_ = (const char*)V + (size_t)(cc) * (C * LDV * 2); _Pragma("unroll") for (int i = 0; i < NPV; ++i) if (tid + NTHR * i < PV) vst[i] = *(const u32x4*)(vb_ + (size_t)i * (VROWS * LDV * 2) + vlo); } while (0)
#define SC_LOADQ(cc) do { const char* qb_ = (const char*)Q + ((size_t)(cc) * C + 16 * rt) * (LDQ * 2); const char* ab_ = (const char*)A + ((size_t)(cc) * C + 16 * rt) * (C * 2); \
        _Pragma("unroll") for (int ks = 0; ks < NKS_D; ++ks) qf[ks] = *(const bf16x8*)(qb_ + ks * 64 + qlo); \
        _Pragma("unroll") for (int ks = 0; ks < NKS_C; ++ks) af[ks] = *(const bf16x8*)(ab_ + ks * 64 + alo); } while (0)
#pragma unroll
    for (int i = 0; i < NPV; ++i) vst[i] = (u32x4){0u, 0u, 0u, 0u};
    SC_LOADK(0); SC_LOADQ(0);
    for (int c = 0; c < nchunk; ++c) {
#pragma unroll
        for (int i = 0; i < NDT; ++i)
#pragma unroll
            for (int ct = 0; ct < NCT; ++ct) { u32x2 o; o.x = cvt_pk_bf16(S[i][ct][0], S[i][ct][1]); o.y = cvt_pk_bf16(S[i][ct][2], S[i][ct][3]);
                *(LAS u32x2*)(stb + (16 * ct + fr) * RST + (16 * (w * NDT + i) + 4 * g4) * 2) = o; }
#pragma unroll
        for (int i = 0; i < NPK; ++i) *(LAS u32x4*)(lds + KL + klds + i * (KROWS * RSK)) = kst[i];
#pragma unroll
        for (int i = 0; i < NPV; ++i) if (tid + NTHR * i < PV) { LAS unsigned char* p = lds + VL + vlds + i * (VROWS * RSV); *(LAS u32x2*)p = (u32x2){vst[i].x, vst[i].y}; *(LAS u32x2*)(p + 8) = (u32x2){vst[i].z, vst[i].w}; }
        f32x4 dv[NDT];
#pragma unroll
        for (int i = 0; i < NDT; ++i) dv[i] = VEC ? *(const f32x4*)(dec + (size_t)c * DK + 16 * (w * NDT + i) + 4 * g4) : (f32x4){cdec, cdec, cdec, cdec};
        __syncthreads();
        if (c + 1 < nchunk) SC_LOADK(c + 1);
#pragma unroll
        for (int i = 0; i < NDT; ++i)
#pragma unroll
            for (int ct = 0; ct < NCT; ++ct) S[i][ct] *= dv[i];
        f32x4 acc[NCT];
#pragma unroll
        for (int ct = 0; ct < NCT; ++ct) acc[ct] = (f32x4){0.f, 0.f, 0.f, 0.f};
#pragma unroll
        for (int ks = 0; ks < NKS_C; ++ks) {
            bf16x8 vf[NCT], kf[NDT];
            static_assert(NCT == 4 && (NDT == 1 || NDT == 2), "scan_item: the batched fragment reads are written for 4 column tiles and 1 or 2 state d-tiles");
            { s16x4 v0, v1, v2, v3, v4, v5, v6, v7, k0, k1, k2, k3;
              if constexpr (NDT == 2) {
                  asm volatile("ds_read_b64_tr_b16 %0, %12 offset:%14\n\tds_read_b64_tr_b16 %1, %12 offset:%15\n\tds_read_b64_tr_b16 %2, %12 offset:%16\n\tds_read_b64_tr_b16 %3, %12 offset:%17\n\t"
                               "ds_read_b64_tr_b16 %4, %12 offset:%18\n\tds_read_b64_tr_b16 %5, %12 offset:%19\n\tds_read_b64_tr_b16 %6, %12 offset:%20\n\tds_read_b64_tr_b16 %7, %12 offset:%21\n\t"
                               "ds_read_b64_tr_b16 %8, %13 offset:0\n\tds_read_b64_tr_b16 %9, %13 offset:%22\n\tds_read_b64_tr_b16 %10, %13 offset:32\n\tds_read_b64_tr_b16 %11, %13 offset:%23\n\ts_waitcnt lgkmcnt(0)"
                               : "=&v"(v0), "=&v"(v1), "=&v"(v2), "=&v"(v3), "=&v"(v4), "=&v"(v5), "=&v"(v6), "=&v"(v7), "=&v"(k0), "=&v"(k1), "=&v"(k2), "=&v"(k3)
                               : "v"(vtr + ks * 32 * RSV), "v"(ktr + ks * 32 * RSK), "i"(0), "i"(4 * RSV), "i"(32), "i"(4 * RSV + 32), "i"(64), "i"(4 * RSV + 64), "i"(96), "i"(4 * RSV + 96), "i"(4 * RSK), "i"(4 * RSK + 32) : "memory");
                  kf[0] = cat8(k0, k1); kf[NDT - 1] = cat8(k2, k3);
              } else {
                  asm volatile("ds_read_b64_tr_b16 %0, %10 offset:%12\n\tds_read_b64_tr_b16 %1, %10 offset:%13\n\tds_read_b64_tr_b16 %2, %10 offset:%14\n\tds_read_b64_tr_b16 %3, %10 offset:%15\n\t"
                               "ds_read_b64_tr_b16 %4, %10 offset:%16\n\tds_read_b64_tr_b16 %5, %10 offset:%17\n\tds_read_b64_tr_b16 %6, %10 offset:%18\n\tds_read_b64_tr_b16 %7, %10 offset:%19\n\t"
                               "ds_read_b64_tr_b16 %8, %11 offset:0\n\tds_read_b64_tr_b16 %9, %11 offset:%20\n\ts_waitcnt lgkmcnt(0)"
                               : "=&v"(v0), "=&v"(v1), "=&v"(v2), "=&v"(v3), "=&v"(v4), "=&v"(v5), "=&v"(v6), "=&v"(v7), "=&v"(k0), "=&v"(k1)
                               : "v"(vtr + ks * 32 * RSV), "v"(ktr + ks * 32 * RSK), "i"(0), "i"(4 * RSV), "i"(32), "i"(4 * RSV + 32), "i"(64), "i"(4 * RSV + 64), "i"(96), "i"(4 * RSV + 96), "i"(4 * RSK) : "memory");
                  kf[0] = cat8(k0, k1);
              }
              vf[0] = cat8(v0, v1); vf[1] = cat8(v2, v3); vf[2] = cat8(v4, v5); vf[3] = cat8(v6, v7); }
#pragma unroll
            for (int i = 0; i < NDT; ++i)
#pragma unroll
                for (int ct = 0; ct < NCT; ++ct) S[i][ct] = mfma16(kf[i], vf[ct], S[i][ct]);
            if (ow) {
#pragma unroll
                for (int ct = 0; ct < NCT; ++ct) acc[ct] = mfma16(vf[ct], af[ks], acc[ct]); }
        }
        if (ow) {
#pragma unroll
            for (int ks = 0; ks < NKS_D; ++ks)
#pragma unroll
                for (int ct = 0; ct < NCT; ++ct) { const bf16x8 sf = *(const LAS bf16x8*)(stb + (16 * ct + fr) * RST + (32 * ks + 8 * g4) * 2); acc[ct] = mfma16(sf, qf[ks], acc[ct]); }
            char* op = (char*)O + ((size_t)c * C + 16 * rt) * (LDO * 2) + olo;
#pragma unroll
            for (int ct = 0; ct < NCT; ++ct) { u32x2 o; o.x = cvt_pk_bf16(acc[ct][0], acc[ct][1]); o.y = cvt_pk_bf16(acc[ct][2], acc[ct][3]); *(u32x2*)(op + 32 * ct) = o; }
            if (c + 1 < nchunk) SC_LOADQ(c + 1);
        }
        __syncthreads();
    }
#undef SC_LOADK
#undef SC_LOADQ
}
__device__ __forceinline__ void ph_scan_ret(Frame& F) {
    for (int c = F.bid; c < 256; c += F.G) { const int r = c >> 3; if (r >= 16) continue;
        const int bh = 2 * (c & 7) + (r >> 3), vs = r & 7, b = bh >> 2, h = bh & 3;
        const size_t tok = (size_t)b * SEQ;
        scan_item<128, 256, 4, 1024, 2048, 1024, false>(F.lds, F.tid, F.wave, F.lane, (const bf16_t*)(F.ws + WS_P + P_CQ) + tok * 1024 + h * 256, (const bf16_t*)(F.ws + WS_P + P_CK) + tok * 1024 + h * 256,
            (const bf16_t*)(F.ws + WS_P + P_CV) + tok * 2048 + h * 512 + vs * 64, (const bf16_t*)(F.ws + WS_RA) + (size_t)bh * 32 * 128 * 128, nullptr, exp2f(128.f * __log2f(1.f - exp2f(-5.f - (float)h))),
            (bf16_t*)(F.ws + WS_OC) + (size_t)(h >> 1) * M * 1024 + tok * 1024 + (h & 1) * 512 + vs * 64, 32); }
}
__device__ __forceinline__ void ph_scan_hgrn(Frame& F, unsigned char* dry = nullptr) {
    for (int c = F.bid; c < 256; c += F.G) { const int r = c >> 3; if (r < 16 || r >= 24) continue;
        const int bh = 4 * (c & 7) + ((r - 16) >> 1), vs = (r - 16) & 1, b = bh >> 3, h = bh & 7;
        const size_t tok = (size_t)b * SEQ;
        scan_item<64, 128, 4, 1024, 1024, 1024, true>(F.lds, F.tid, F.wave, F.lane, (const bf16_t*)(F.ws + WS_P + P_BQ) + tok * 1024 + h * 128, (const bf16_t*)(F.ws + WS_P + P_BG) + tok * 1024 + h * 128,
            (const bf16_t*)(F.ws + WS_P + P_BV) + tok * 1024 + h * 128 + vs * 64, (const bf16_t*)(F.ws + WS_HA) + (size_t)bh * 64 * 64 * 64, (const float*)(F.ws + WS_HDEC) + (size_t)bh * 64 * 128, 0.f,
            (bf16_t*)(F.ws + WS_OB) + tok * 1024 + h * 128 + vs * 64, 64); }
}
__device__ __forceinline__ void ph_post(Frame& F, const float* ng  , unsigned char* dry) {
    bf16_t* OB = (bf16_t*)(F.ws + WS_OB); bf16_t* OC = (bf16_t*)(F.ws + WS_OC); bf16_t* OBo = dry ? (bf16_t*)dry : OB; bf16_t* OCo = dry ? (bf16_t*)(dry + 32 * MiB) : OC; const bf16_t* BO = (const bf16_t*)(F.ws + WS_P + P_BO); const bf16_t* CG = (const bf16_t*)(F.ws + WS_P + P_CG);
    const int gw = F.bid * NWAVES + F.wave, NGW = F.G * NWAVES, lane = F.lane;
    float ngv[16];
    { const int d0_ = (16 * lane) & 127;
#pragma unroll
      for (int q = 0; q < 4; ++q) { const f32x4 t = *(const f32x4*)(ng + d0_ + 4 * q); ngv[4 * q] = t[0]; ngv[4 * q + 1] = t[1]; ngv[4 * q + 2] = t[2]; ngv[4 * q + 3] = t[3]; } }
    for (int row = gw; row < M; row += NGW) {
        const size_t ob_ = (size_t)row * 1024 + 16 * lane;
        u32x4 va[3][2], vg[3][2];
        va[0][0] = *(const u32x4*)(OB + ob_); va[0][1] = *(const u32x4*)(OB + ob_ + 8); vg[0][0] = *(const u32x4*)(BO + ob_); vg[0][1] = *(const u32x4*)(BO + ob_ + 8);
#pragma unroll
        for (int half = 0; half < 2; ++half) { const size_t o = (size_t)half * M * 1024 + ob_, og = (size_t)row * 2048 + 1024 * half + 16 * lane;
            va[1 + half][0] = *(const u32x4*)(OC + o); va[1 + half][1] = *(const u32x4*)(OC + o + 8); vg[1 + half][0] = *(const u32x4*)(CG + og); vg[1 + half][1] = *(const u32x4*)(CG + og + 8); }
#pragma unroll
        for (int p = 0; p < 3; ++p) {
            const u32x4 a0 = va[p][0], a1 = va[p][1], g0 = vg[p][0], g1 = vg[p][1];
            float x[16] = {bflo(a0.x), bfhi(a0.x), bflo(a0.y), bfhi(a0.y), bflo(a0.z), bfhi(a0.z), bflo(a0.w), bfhi(a0.w), bflo(a1.x), bfhi(a1.x), bflo(a1.y), bfhi(a1.y), bflo(a1.z), bfhi(a1.z), bflo(a1.w), bfhi(a1.w)};
            const float gg[16] = {bflo(g0.x), bfhi(g0.x), bflo(g0.y), bfhi(g0.y), bflo(g0.z), bfhi(g0.z), bflo(g0.w), bfhi(g0.w), bflo(g1.x), bfhi(g1.x), bflo(g1.y), bfhi(g1.y), bflo(g1.z), bfhi(g1.z), bflo(g1.w), bfhi(g1.w)};
            float ss = 0.f;
#pragma unroll
            for (int j = 0; j < 16; ++j) ss += x[j] * x[j];
            ss = sum8(ss);
            if (p) { ss += DPPF(ss, 0x140); ss = xadd16(ss); }
            const float r = rsqrtf(ss * (p ? (1.f / 512.f) : (1.f / 128.f)) + EPS);
#pragma unroll
            for (int j = 0; j < 16; ++j) x[j] = x[j] * r * gg[j] * (p ? 1.f : ngv[j]);
            bf16_t* dst = p ? OCo + (size_t)(p - 1) * M * 1024 + ob_ : OBo + ob_;
            pg8::st8(dst, x); pg8::st8(dst + 8, x + 8); }
    }
}
__device__ __forceinline__ void ph_norm2(Frame& F, int l, const float* g, const float* sc, const float* sh, unsigned char* dry) {
    const bf16_t* X = (const bf16_t*)(F.ws + WS_X); bf16_t* H = dry ? (bf16_t*)dry : (bf16_t*)(F.ws + WS_H); const bf16_t* RW = (const bf16_t*)(F.ws + WS_RW) + (size_t)l * 48 * 1024;
    const float* rgb = F.in(15) + l * 4; const float* reb = F.in(17) + l * 32;
    unsigned* ghist = F.ctl + CW_HIST + (dry ? 8192 : 0);
    LAS unsigned* hist = (LAS unsigned*)(F.lds + 8 * 4096);
    int* tok_e = dry ? (int*)(dry + 32 * MiB) : (int*)(F.ws + WS_TOK); int* tok_p = tok_e + 2 * M; float* tok_w = (float*)(tok_p + 2 * M);
    int2* rinfo = dry ? (int2*)(dry + 40 * MiB) : (int2*)(F.ws + WS_RINFO);
    LAS float* lg = (LAS float*)(F.lds + F.wave * 4096);
    const int lane = F.lane, fr = lane & 15, g4 = lane >> 4;
    if (F.tid < 32) hist[F.tid] = 0u;
    __syncthreads();
    { const int m1 = (F.tid >> 31) - 1;
      for (int i = F.bid * NTHR + F.tid; i < XG_ROWS; i += F.G * NTHR) rinfo[i] = make_int2(m1, 0); }
    { const int it = F.bid * 4 + (F.wave & 3), kh = F.wave >> 2;
        LAS float* ssx = (LAS float*)(F.lds + 8 * 4096 + 256);
        const int row = 16 * it + fr, b = row >> 12; const bf16_t* xr = X + (size_t)row * D;
        float ss = 0.f;
#pragma unroll 8
        for (int kk = 16 * kh; kk < 16 * kh + 16; ++kk) { const u32x4 xw = *(const u32x4*)(xr + 32 * kk + 8 * g4);
            const float a0 = bflo(xw.x), a1 = bfhi(xw.x), a2 = bflo(xw.y), a3 = bfhi(xw.y), c0_ = bflo(xw.z), c1 = bfhi(xw.z), c2 = bflo(xw.w), c3 = bfhi(xw.w);
            ss += (a0 * a0 + a1 * a1) + (a2 * a2 + a3 * a3) + (c0_ * c0_ + c1 * c1) + (c2 * c2 + c3 * c3); }
        ss = xadd32(xadd16(ss));
        if (lane < 16) ssx[F.wave * 16 + lane] = ss;
        __syncthreads();
        ss = ssx[(F.wave & 3) * 16 + fr] + ssx[((F.wave & 3) + 4) * 16 + fr];
        const float r = rsqrtf(ss * (1.f / D) + EPS);
        f32x4 acc[3] = {{0.f, 0.f, 0.f, 0.f}, {0.f, 0.f, 0.f, 0.f}, {0.f, 0.f, 0.f, 0.f}};
#pragma unroll 4
        for (int kk = 16 * kh; kk < 16 * kh + 16; ++kk) { const int c0 = 32 * kk + 8 * g4;
            float x[8]; { const u32x4 xw = *(const u32x4*)(xr + c0); x[0] = bflo(xw.x); x[1] = bfhi(xw.x); x[2] = bflo(xw.y); x[3] = bfhi(xw.y); x[4] = bflo(xw.z); x[5] = bfhi(xw.z); x[6] = bflo(xw.w); x[7] = bfhi(xw.w); }
            const f32x4 ga = *(const f32x4*)(g + c0), gb = *(const f32x4*)(g + c0 + 4), sa = *(const f32x4*)(sc + b * 6 * D + c0), sb = *(const f32x4*)(sc + b * 6 * D + c0 + 4), ha = *(const f32x4*)(sh + b * 6 * D + c0), hb = *(const f32x4*)(sh + b * 6 * D + c0 + 4);
#pragma unroll
            for (int j = 0; j < 4; ++j) { x[j] = x[j] * r * ga[j] * (1.f + sa[j]) + ha[j]; x[4 + j] = x[4 + j] * r * gb[j] * (1.f + sb[j]) + hb[j]; }
            u32x4 wv; wv.x = cvt_pk_bf16(x[0], x[1]); wv.y = cvt_pk_bf16(x[2], x[3]); wv.z = cvt_pk_bf16(x[4], x[5]); wv.w = cvt_pk_bf16(x[6], x[7]);
            *(u32x4*)(H + (size_t)row * D + c0) = wv;
            const bf16x8 af = *reinterpret_cast<const bf16x8*>(&wv);
#pragma unroll
            for (int nt = 0; nt < 3; ++nt) { const bf16x8 bfm = *(const bf16x8*)(RW + (size_t)(16 * nt + fr) * 1024 + c0); acc[nt] = mfma16(af, bfm, acc[nt]); } }
#pragma unroll
        for (int nt = 0; nt < 3; ++nt)
#pragma unroll
            for (int i = 0; i < 4; ++i) lg[(4 * g4 + i) * 48 + 16 * nt + fr] = acc[nt][i];
        __syncthreads();
        if (kh == 0 && lane < 16) { const int tk = 16 * it + lane; const LAS float* q = lg + lane * 48; const LAS float* q2 = q + 4 * 1024;
            float mx = -1e30f; int gs = 0;
#pragma unroll
            for (int i = 0; i < 4; ++i) { const float v = q[i] + q2[i] + rgb[i]; if (v > mx) { mx = v; gs = i; } }
            float s = 0.f;
#pragma unroll
            for (int i = 0; i < 4; ++i) s += __expf(q[i] + q2[i] + rgb[i] - mx);
            const float gp = __builtin_amdgcn_rcpf(s);
            float v0 = -1e30f, v1 = -1e30f; int i0 = 0, i1 = 0;
            for (int i = 0; i < 8; ++i) { const float e = q[4 + gs * 8 + i] + q2[4 + gs * 8 + i] + reb[gs * 8 + i];
                if (e > v0) { v1 = v0; i1 = i0; v0 = e; i0 = i; } else if (e > v1) { v1 = e; i1 = i; } }
            const int z_ = F.tid >> 31;
            const float one_ = __int_as_float(0x3f800000 + z_); const unsigned uone_ = 1u + (unsigned)z_;
            const float w1 = __expf(v1 - v0), den = one_ / (one_ + w1);
            const int e0 = gs * 8 + i0, e1 = gs * 8 + i1;
            const unsigned p0 = __hip_atomic_fetch_add(hist + e0, uone_, __ATOMIC_RELAXED, __HIP_MEMORY_SCOPE_WORKGROUP), p1 = __hip_atomic_fetch_add(hist + e1, uone_, __ATOMIC_RELAXED, __HIP_MEMORY_SCOPE_WORKGROUP);
            tok_e[2 * tk] = e0; tok_e[2 * tk + 1] = e1; tok_p[2 * tk] = (int)p0; tok_p[2 * tk + 1] = (int)p1; tok_w[2 * tk] = gp * den; tok_w[2 * tk + 1] = gp * w1 * den; }
        LDS_WAIT(); asm volatile("" ::: "memory");
    }
    __syncthreads();
    if (F.tid < 32) ghist[F.bid * 32 + F.tid] = hist[F.tid];
}
__device__ __forceinline__ void ph_gather(Frame& F, int l) {
    const unsigned* ghist = F.ctl + CW_HIST;
    const int* tok_e = (const int*)(F.ws + WS_TOK); const int* tok_p = tok_e + 2 * M; const float* tok_w = (const float*)(tok_p + 2 * M);
    int2* rinfo = (int2*)(F.ws + WS_RINFO); int* t2e = (int*)(F.ws + WS_T2E);
    LAS int* offs = (LAS int*)F.lds;
    LAS int* pre = (LAS int*)(F.lds + 1024);
    for (int i = F.tid; i < 256 * 32; i += NTHR) pre[i] = (int)ghist[i];
    __syncthreads();
    { LAS int* segs = (LAS int*)(F.lds + 1024 + 32768);
      const int e = F.tid & 31, sg = F.tid >> 5; int v[16], sum = 0;
#pragma unroll
      for (int i = 0; i < 16; ++i) { v[i] = pre[(sg * 16 + i) * 32 + e]; sum += v[i]; }
      segs[sg * 32 + e] = sum;
      __syncthreads();
      if (F.tid < 32) { int run = 0;
#pragma unroll
          for (int i = 0; i < 16; ++i) { const int c = segs[i * 32 + F.tid]; segs[i * 32 + F.tid] = run; run += c; }
          offs[F.tid] = run; }
      __syncthreads();
      int run = segs[sg * 32 + e];
#pragma unroll
      for (int i = 0; i < 16; ++i) { pre[(sg * 16 + i) * 32 + e] = run; run += v[i]; } }
    __syncthreads();
    if (F.tid == 0) { int o = 0; for (int e = 0; e < NE; ++e) { const int c = offs[e]; offs[e] = o; o += (c + 255) & ~255; } offs[NE] = o; }
    __syncthreads();
    if (F.bid == 0) { if (F.tid == 0) t2e[0] = offs[NE] >> 8;
        for (int e = F.tid; e < NE; e += NTHR) for (int rt = offs[e] >> 8; rt < (offs[e + 1] >> 8); ++rt) t2e[1 + rt] = e; }
    for (int ts = F.bid * NTHR + F.tid; ts < 2 * M; ts += F.G * NTHR) {
        const int e = tok_e[ts], p = tok_p[ts]; const int tk = ts >> 1; const int row = offs[e] + pre[(tk >> 6) * 32 + e] + p;
        rinfo[row] = make_int2(ts, __float_as_int(tok_w[ts]));
    }
}
__device__ __forceinline__ int build_units(Frame& F, LAS int* tab) {
    const int* t2e = (const int*)(F.ws + WS_T2E);
    const int L = F.tid * F.G + F.bid; int e = 0;
    if (F.tid < 8) e = t2e[1 + (L >> 2)];
    const int NT = t2e[0];
    if (F.tid < 8 && L < 4 * NT) tab[F.tid] = ((L >> 2) << 8) | (e * 4 + (L & 3));
    int n = (4 * NT - F.bid + F.G - 1) / F.G; n = n < 0 ? 0 : (n > 8 ? 8 : n);
    __syncthreads();
    return n;
}
#ifndef MK_ONE_LAUNCH
#define MK_ONE_LAUNCH 1
#endif
constexpr int NPHASE = 13;
__global__ void __launch_bounds__(NTHR, 2) mk_fwd(Args a) {
    extern __shared__ __attribute__((aligned(16))) unsigned char lds[];
    Frame F;
    F.lds = (LAS unsigned char*)lds; F.MISC = (volatile LAS unsigned*)(F.lds + MISC_OFF);
    F.tid = threadIdx.x; F.lane = F.tid & 63; F.wave = __builtin_amdgcn_readfirstlane(F.tid >> 6); F.G = gridDim.x; F.bid = blockIdx.x;
    F.ws = a.ws; F.ctl = (unsigned*)(a.ws + WS_CTL); F.out = a.out;
    for (int u = F.tid; u < 1024; u += NTHR) ((LAS unsigned*)(F.lds + MISC_OFF))[u] = 0u;
    __syncthreads();
#pragma unroll
    for (int i = 0; i < 22; ++i) if (F.tid == i) *(LAS u64*)(F.lds + MISC_OFF + 512 + 8 * i) = (u64)a.in[i];
    __syncthreads();
    XcdBarrier bar; bar.bar = F.ctl + CW_BAR; bar.x = 0; bar.st = F.MISC + 8;
    if (a.pad == 0) bar = xcd_barrier_post(F.ctl + CW_BAR, F.MISC + 8);
    const int lo = a.ph_lo, hi = a.ph_hi;
#ifndef SUB
#define SUB 7
#endif
#ifndef DBL
#define DBL 0
#endif
#define REP(k) _Pragma("nounroll") for (int rep_ = 0; rep_ < ((DBL == (k)) ? 2 : 1); ++rep_)
#ifndef PHSEL
#define PHSEL 0xffff
#endif
#define IN(k) (((PHSEL >> (k)) & 1) && lo <= (k) && (k) < hi)
#define GRID_BAR() do { if (a.pad == 0) xcd_barrier(bar); asm volatile("" : "+v"(F.tid), "+v"(F.lane), "+s"(F.wave) :: "memory"); } while (0)
    unsigned char* ws = a.ws; unsigned char* wb = ws + WS_W; unsigned char* pb = ws + WS_P;
    bf16_t* X = (bf16_t*)(ws + WS_X); bf16_t* H = (bf16_t*)(ws + WS_H); bf16_t* YS = (bf16_t*)(ws + WS_YS);
    const float* mod = (const float*)(ws + WS_MOD);
    LAS int* utab = (LAS int*)(F.lds + MISC_OFF + 256);
#ifdef MK_DRY
    unsigned char* dry = a.dry ? ws + WS_END : nullptr;
#define DRYP(T, normal, off) (dry ? (T)(dry + (off)) : (normal))
#else
#define DRYP(T, normal, off) (normal)
#endif
#ifdef MK_STAMP
    unsigned long long* ts_ = (unsigned long long*)(F.ctl + 210000);
#define STAMP(k) do { if (F.bid == 0 && F.tid == 0 && l == 1) ts_[k] = wall_clock64(); } while (0)
#else
#define STAMP(k) do {} while (0)
#endif

    if (IN(0) && a.lay_lo == 0) { ph_prologue(F); GRID_BAR(); }

    int nu_up = -1;
    for (int l = a.lay_lo; l < a.lay_hi; ++l) {
        const float* md = mod + (size_t)l * BATCH * 6 * D;
        if (IN(1)) {
            STAMP(0); REP(1) ph_conv(F, l); STAMP(1);
            if (l == 0) ph_norm(F, F.in(0), nullptr, nullptr, nullptr, nullptr, F.in(4) + l * D, md + 1 * D, md + 0 * D, DRYP(bf16_t*, H, 64 * MiB), nullptr);
            else ph_norm(F, nullptr, X, YS, md - (size_t)BATCH * 6 * D + 5 * D, DRYP(bf16_t*, X, 0), F.in(4) + l * D, md + 1 * D, md + 0 * D, DRYP(bf16_t*, H, 64 * MiB), nullptr);
            GRID_BAR(); STAMP(2);
        }
        if (IN(2)) REP(2) {
            pg8::Gemm g{H, (const bf16_t*)(wb + W_IN), M, NP, D}; pg8::StaticOrder S; S.init(M, NP, F.G, F.bid);
            pg8::EpiProj E{pb, (const float*)(ws + WS_LB) + l * 1024, (const float2*)(ws + WS_ROT)};
            pg8::gemm_phase<pg8::EpiProj, pg8::StaticOrder, true, true>(F.lds, g, S, E);
            if (rep_ == ((DBL == 2) ? 1 : 0)) GRID_BAR(); STAMP(3);
        }
        if (IN(3)) { if (SUB & 1) REP(3) ph_idx(F, a.dry >> 4); STAMP(4); if ((SUB & 2) && !(a.dry >> 4)) ph_hprep(F, DRYP(unsigned char*, nullptr, 0)); STAMP(5); if ((SUB & 4) && !(a.dry >> 4)) REP(4) ph_rprep(F); GRID_BAR(); STAMP(6); }
        if (IN(4)) { if (SUB & 1) REP(5) ph_att(F, (char*)lds); STAMP(7); if (SUB & 2) REP(6) ph_scan_ret(F);
#ifdef SCANX
            ph_scan_ret_light(F);
#endif
            STAMP(8); if (SUB & 4) REP(7) ph_scan_hgrn(F); GRID_BAR(); STAMP(9); }
        if (IN(5)) { ph_post(F, F.in(9) + l * 128, DRYP(unsigned char*, nullptr, 0)); GRID_BAR(); STAMP(10); }
        if (IN(6)) { REP(8) {
            pg8::SegOrder S; { const int w2 = (F.bid & 7) * 32 + (F.bid >> 3), gid = w2 >> 5, rr = w2 & 31; S.pm0 = gid * 8 + (rr & 7); S.pn0 = rr >> 3; }
            pg8::Gemm g{(const bf16_t*)(ws + WS_OA), (const bf16_t*)(wb + W_BA), 4 * M, 4 * D, 1024};
            pg8::EpiMerge4 E{(const bf16_t*)(pb + P_GA), (bf16_t*)(ws + WS_MGB)};
            if (F.bid < 256) pg8::gemm_phase<pg8::EpiMerge4, pg8::SegOrder, true, true>(F.lds, g, S, E); }
            GRID_BAR(); STAMP(11);
        }
        if (IN(7)) {
            pg8::Gemm g{(const bf16_t*)(ws + WS_MGB), (const bf16_t*)(wb + W_OUT), M, D, 1024}; pg8::StaticOrder S; S.init(M, D, F.G, F.bid);
            pg8::EpiRes E{l == 0 ? F.in(0) : (const float*)nullptr, X, DRYP(bf16_t*, X, 0), md + 2 * D};
            pg8::gemm_phase<pg8::EpiRes, pg8::StaticOrder, false, true>(F.lds, g, S, E);
            GRID_BAR(); STAMP(12);
        }
        if (IN(8)) { ph_norm2(F, l, F.in(5) + l * D, md + 4 * D, md + 3 * D, DRYP(unsigned char*, nullptr, 0)); GRID_BAR(); STAMP(13); }
        if (IN(9)) { ph_gather(F, l); GRID_BAR(); STAMP(14); }
        if (IN(10)) REP(9) {
            pg8::GatherOrder S; S.tab = utab; S.n = build_units(F, utab); nu_up = S.n;
            { LAS unsigned* rows = (LAS unsigned*)(F.lds + 131072);
              const int2* ri = (const int2*)(ws + WS_RINFO);
              for (int idx = F.tid; idx < S.n * 256; idx += NTHR) { const int ts = ri[(utab[idx >> 8] >> 8) * 256 + (idx & 255)].x; rows[idx] = ts < 0 ? 0u : (unsigned)(ts >> 1) * (unsigned)(D * 2); }
              __syncthreads(); S.rows = rows; }
            pg8::Gemm g{(const bf16_t*)(ws + WS_H), (const bf16_t*)(wb + W_E1), XG_ROWS, NE * 1024, 1024};
            pg8::EpiExpUp E{(bf16_t*)(ws + WS_ACT)};
            pg8::gemm_phase<pg8::EpiExpUp, pg8::GatherOrder, true, true>(F.lds, g, S, E);
            if (rep_ == ((DBL == 9) ? 1 : 0)) GRID_BAR(); STAMP(15);
        }
        if (IN(11)) REP(10) {
            pg8::ListOrder S; S.tab = utab; S.n = (a.pad == 0 && nu_up >= 0) ? nu_up : build_units(F, utab); nu_up = -1;
            pg8::Gemm g{(const bf16_t*)(ws + WS_ACT), (const bf16_t*)(wb + W_E2), XG_ROWS, NE * 1024, 512};
            pg8::EpiExpDown E{(const int2*)(ws + WS_RINFO), YS};
            pg8::gemm_phase<pg8::EpiExpDown, pg8::ListOrder, true, true>(F.lds, g, S, E);
            if (rep_ == ((DBL == 10) ? 1 : 0)) GRID_BAR(); STAMP(16);
        }
    }
    if (IN(12) && a.lay_hi == DEPTH) {
        const float* md3 = mod + (size_t)3 * BATCH * 6 * D;
        ph_norm(F, nullptr, X, YS, md3 + 5 * D, nullptr, F.in(21), nullptr, nullptr, nullptr, F.out);
    }
#undef IN
#undef GRID_BAR
}

#ifdef MK_DIAG
__global__ void k_nonfinite(const void* p, size_t n, int is_f32, unsigned* cnt, int slot) {
    size_t i = (size_t)blockIdx.x * blockDim.x + threadIdx.x; const size_t st = (size_t)gridDim.x * blockDim.x; unsigned c = 0;
    if (is_f32) { const unsigned* q = (const unsigned*)p; for (; i < n; i += st) c += ((q[i] & 0x7f800000u) == 0x7f800000u) ? 1u : 0u; }
    else { const unsigned short* q = (const unsigned short*)p; for (; i < n; i += st) c += ((q[i] & 0x7f80u) == 0x7f80u) ? 1u : 0u; }
    if (c) atomicAdd(cnt + slot, c);
}
__global__ void k_maskcheck(const u64* maskT, unsigned* cnt, int slot) {
    const int idx = blockIdx.x * blockDim.x + threadIdx.x; if (idx >= M) return; const int b = idx >> 12, t = idx & 4095; int pc = 0;
    for (int j = 0; j <= (t >> 6); ++j) pc += __popcll(maskT[((size_t)b * 64 + j) * SEQ + t]);
    const int want = (t + 1 < 256) ? t + 1 : 256;
    if (pc != want) atomicAdd(cnt + slot, 1u);
}
__global__ void k_emit(const float* x, const float* g, const unsigned* cnt, int nslots, float* out) {
    const int row = blockIdx.x, t = threadIdx.x; float v[4], ss = 0.f;
    for (int j = 0; j < 4; ++j) { v[j] = x[(size_t)row * D + t + 256 * j]; ss += v[j] * v[j]; }
    __shared__ float red[256]; red[t] = ss; __syncthreads();
    for (int o = 128; o > 0; o >>= 1) { if (t < o) red[t] += red[t + o]; __syncthreads(); }
    const float r = rsqrtf(red[0] / D + EPS); int code = 0;
    for (int s = nslots - 1; s >= 0; --s) if (cnt[s]) code = s + 1;
    for (int j = 0; j < 4; ++j) out[(size_t)row * D + t + 256 * j] = (1.f + code) * v[j] * r * g[t + 256 * j];
}
#endif

#ifdef MK_STAMP
__global__ void k_emit_ts(const float* x, const float* g, const unsigned long long* ts, float* out) {
    const int row = blockIdx.x, t = threadIdx.x; float v[4], ss = 0.f;
    for (int j = 0; j < 4; ++j) { v[j] = x[(size_t)row * D + t + 256 * j]; ss += v[j] * v[j]; }
    __shared__ float red[256]; red[t] = ss; __syncthreads();
    for (int o = 128; o > 0; o >>= 1) { if (t < o) red[t] += red[t + o]; __syncthreads(); }
    const float r = rsqrtf(red[0] / D + EPS);
    long long da = (long long)(ts[MK_STAMP_A] - ts[MK_STAMP_A - 1]) / 400, db = (long long)(ts[MK_STAMP_B] - ts[MK_STAMP_B - 1]) / 400;
    if (da < 0) da = 0; if (da > 98) da = 98; if (db < 0) db = 0; if (db > 89) db = 89;
    for (int j = 0; j < 4; ++j) out[(size_t)row * D + t + 256 * j] = (1.f + (float)da) * v[j] * r * g[t + 256 * j];
    __syncthreads();
    if (row == 0 && t == 0) out[0] = 1000.f + 100.f * (float)db;
}
#endif
extern "C" void kernel_launch(void* const* d_in, const int* in_sizes, int n_in, void* d_out, int out_size, void* d_ws, size_t ws_size, hipStream_t stream) {
    static int grid = 0;
    if (grid == 0) {
#ifdef MK_DRY
        if (ws_size < WS_END + 96 * MiB) { fprintf(stderr, "dry probe needs more ws\n"); grid = -1; return; }
#endif
        if (n_in != 22 || ws_size < WS_END) { fprintf(stderr, "kernel_launch: bad n_in %d / ws %zu (need %zu)\n", n_in, ws_size, (size_t)WS_END); grid = -1; return; }
        int dev = 0, cus = 0, per_cu = 0;
        if (hipGetDevice(&dev) != hipSuccess || hipDeviceGetAttribute(&cus, hipDeviceAttributeMultiprocessorCount, dev) != hipSuccess) { grid = -1; return; }
        if (hipFuncSetAttribute((const void*)mk_fwd, hipFuncAttributeMaxDynamicSharedMemorySize, LDS_BYTES) != hipSuccess) { fprintf(stderr, "kernel_launch: hipFuncSetAttribute failed\n"); grid = -1; return; }
        if (hipOccupancyMaxActiveBlocksPerMultiprocessor(&per_cu, (const void*)mk_fwd, NTHR, LDS_BYTES) != hipSuccess || per_cu < 1) fprintf(stderr, "kernel_launch: occupancy query says %d\n", per_cu);
        (void)hipGetLastError();
        grid = cus;
    }
    if (grid < 0) return;
    (void)hipMemsetAsync((char*)d_ws + WS_CTL, 0, CTL_ZERO_BYTES, stream);
    Args a{};
    for (int i = 0; i < 22; ++i) a.in[i] = (const float*)d_in[i];
    a.out = (float*)d_out; a.ws = (unsigned char*)d_ws; a.pad = MK_ONE_LAUNCH ? 0 : 1;
#ifdef MK_DIAG
    {
        unsigned* cnt = (unsigned*)((char*)d_ws + WS_CTL) + 200000;
        a.lay_lo = 0; a.lay_hi = 0; a.ph_lo = 0; a.ph_hi = 1;
        hipLaunchKernelGGL(mk_fwd, dim3(grid), dim3(NTHR), LDS_BYTES, stream, a);
        for (int p = 1; p <= MK_DIAG; ++p) { a.lay_lo = 0; a.lay_hi = 1; a.ph_lo = p; a.ph_hi = p + 1; hipLaunchKernelGGL(mk_fwd, dim3(grid), dim3(NTHR), LDS_BYTES, stream, a); }
        unsigned char* w = (unsigned char*)d_ws; int s = 0;
#define NF(off, n, f32) hipLaunchKernelGGL(k_nonfinite, dim3(1024), dim3(256), 0, stream, (const void*)(w + (off)), (size_t)(n), f32, cnt, s++)
        NF(WS_MOD, DEPTH * BATCH * 6 * D, 1);
        NF(WS_H, (size_t)M * D, 0);
        NF(WS_W + W_IN, (size_t)NP * D, 0);
        NF(WS_P + P_QA, (size_t)M * D * 3, 0);
        NF(WS_P + P_IQ, (size_t)M * 512, 0);
        NF(WS_P + P_IK, (size_t)M * 64, 0);
        NF(WS_P + P_IW, (size_t)M * 8, 1);
        NF(WS_P + P_BQ, (size_t)M * D * 4, 0);
        NF(WS_P + P_CQ, (size_t)M * D * 2, 0);
        NF(WS_P + P_CV, (size_t)M * 2048 * 2, 0);
        NF(WS_P + P_GA, (size_t)M * D * 3, 0);
        hipLaunchKernelGGL(k_maskcheck, dim3(M / 256), dim3(256), 0, stream, (const u64*)(w + WS_MASK), cnt, s++);
        NF(WS_HA, (size_t)2048 * 64 * 64, 0);
        NF(WS_HDEC, (size_t)2048 * 128, 1);
        NF(WS_RA, (size_t)512 * 128 * 128, 0);
        NF(WS_OA, (size_t)M * D, 0);
        NF(WS_OB, (size_t)M * D, 0);
        NF(WS_OC, (size_t)M * 2048, 0);
        NF(WS_MGB, (size_t)M * D, 0);
        NF(WS_X, (size_t)M * D, 1);
        hipLaunchKernelGGL(k_emit, dim3(M), dim3(256), 0, stream, (const float*)d_in[0], (const float*)d_in[21], cnt, s, (float*)d_out);
    }
#elif MK_ONE_LAUNCH
    a.lay_lo = 0; a.lay_hi = DEPTH; a.ph_lo = 0; a.ph_hi = NPHASE;
    hipLaunchKernelGGL(mk_fwd, dim3(grid), dim3(NTHR), LDS_BYTES, stream, a);
#ifdef MK_STAMP
    hipLaunchKernelGGL(k_emit_ts, dim3(M), dim3(256), 0, stream, (const float*)d_in[0], (const float*)d_in[21], (const unsigned long long*)((unsigned*)((char*)d_ws + WS_CTL) + 210000), (float*)d_out);
#endif
#else
#ifndef DBLH
#define DBLH 99
#endif
    a.lay_lo = 0; a.lay_hi = 0; a.ph_lo = 0; a.ph_hi = 1;
    for (int r = 0; r < (DBLH == 0 ? 2 : 1); ++r) hipLaunchKernelGGL(mk_fwd, dim3(grid), dim3(NTHR), LDS_BYTES, stream, a);
#ifndef DBLH
#define DBLH 0
#endif
#ifndef DRYV
#define DRYV 1
#endif
    for (int l = 0; l < DEPTH; ++l) for (int p = 1; p <= 11; ++p) { a.lay_lo = l; a.lay_hi = l + 1; a.ph_lo = p; a.ph_hi = p + 1; for (int r = 0; r < (p == DBLH ? 2 : 1); ++r) { a.dry = r ? DRYV : 0; hipLaunchKernelGGL(mk_fwd, dim3(grid), dim3(NTHR), LDS_BYTES, stream, a); } a.dry = 0;
    }
    a.lay_lo = DEPTH; a.lay_hi = DEPTH; a.ph_lo = 12; a.ph_hi = 13;
    hipLaunchKernelGGL(mk_fwd, dim3(grid), dim3(NTHR), LDS_BYTES, stream, a);
#endif
}
```
